# Optimizing an MI355X kernel written in HIP

```python
import math
import jax, jax.numpy as jnp
from jax import lax
import numpy as np

D_MODEL = 2048
BATCH = 8
SEQ = 4096
DEPTH = 1

CHUNK = 64
A_HEADS = 8
A_HEAD_DIM = 128
A_LEFT_CHUNKS = 8
REL_CLIP_LEFT = 256
REL_CLIP_RIGHT = CHUNK - 1
REL_SIZE = REL_CLIP_LEFT + REL_CLIP_RIGHT + 1
B_HEADS = 8
Q_LORA = 512
KV_LORA = 512
QK_NOPE = 128
QK_ROPE = 64
V_HEAD = 128
ROPE_THETA = 10000.0
Q_BLOCK = 128
N_KEYS = 128
N_EXPERTS = N_KEYS * N_KEYS
PEER_HEADS = 8
PEER_TOPK = 16
PEER_QDIM = 256
PEER_HALF = PEER_QDIM // 2
TOKEN_BLOCK = 128
DN_ALPHA = (2 * DEPTH) ** 0.25
DN_BETA = (8 * DEPTH) ** -0.25
LN_EPS = 1e-5
RMS_EPS = 1e-6
NEG = -1e30

A_WIDTH = A_HEADS * A_HEAD_DIM
B_WIDTH = B_HEADS * V_HEAD
IN_SIZES = [A_WIDTH, A_WIDTH, A_WIDTH, Q_LORA, KV_LORA, QK_ROPE, D_MODEL, D_MODEL]
IN_COLS = sum(IN_SIZES)

kernel_name = "hybrid_chunkattn_mla_peer_deepnorm_adaln"


def layer_norm(x, g, b):
    xf = x.astype(jnp.float32)
    mu = jnp.mean(xf, axis=-1, keepdims=True)
    var = jnp.mean(jnp.square(xf - mu), axis=-1, keepdims=True)
    y = (xf - mu) * lax.rsqrt(var + LN_EPS)
    return (y * g.astype(jnp.float32) + b.astype(jnp.float32)).astype(x.dtype)


def rms_norm(x, g):
    xf = x.astype(jnp.float32)
    y = xf * lax.rsqrt(jnp.mean(jnp.square(xf), axis=-1, keepdims=True) + RMS_EPS)
    return (y * g.astype(jnp.float32)).astype(x.dtype)


def rope(x, cos, sin):
    half = x.shape[-1] // 2
    x1, x2 = x[..., :half], x[..., half:]
    return jnp.concatenate([x1 * cos - x2 * sin, x1 * sin + x2 * cos], axis=-1)


def chunk_band_attention(q, k, v, rel_bias):
    bsz, s, h, dh = q.shape
    nc = s // CHUNK
    nb = A_LEFT_CHUNKS + 1
    qc = q.reshape(bsz, nc, CHUNK, h, dh)
    pad = ((0, 0), (A_LEFT_CHUNKS, 0), (0, 0), (0, 0), (0, 0))
    kp = jnp.pad(k.reshape(bsz, nc, CHUNK, h, dh), pad)
    vp = jnp.pad(v.reshape(bsz, nc, CHUNK, h, dh), pad)
    band = jnp.arange(nc)[:, None] + jnp.arange(nb)[None, :]
    kb = kp[:, band].reshape(bsz, nc, nb * CHUNK, h, dh)
    vb = vp[:, band].reshape(bsz, nc, nb * CHUNK, h, dh)
    valid = jnp.repeat(band >= A_LEFT_CHUNKS, CHUNK, axis=1)
    t = jnp.arange(CHUNK)
    kpos = ((jnp.arange(nb)[:, None] - A_LEFT_CHUNKS) * CHUNK + t[None, :]).reshape(-1)
    rel = t[:, None] - kpos[None, :]
    ridx = jnp.clip(rel, -REL_CLIP_RIGHT, REL_CLIP_LEFT) + REL_CLIP_RIGHT
    bias = rel_bias[:, ridx].astype(jnp.float32)
    sc = jnp.einsum('bnqhd,bnkhd->bhnqk', qc, kb).astype(jnp.float32) * (dh ** -0.5)
    sc = sc + bias[None, :, None]
    sc = jnp.where(valid[None, None, :, None, :], sc, NEG)
    p = jax.nn.softmax(sc, axis=-1).astype(v.dtype)
    o = jnp.einsum('bhnqk,bnkhd->bnqhd', p, vb)
    return o.reshape(bsz, s, h * dh)


def chunk_causal_attention(q, k, v):
    bsz, s, h, dq = q.shape
    dv = v.shape[-1]
    nqb = s // Q_BLOCK
    qb = q.reshape(bsz, nqb, Q_BLOCK, h, dq).transpose(1, 0, 2, 3, 4)
    kchunk = jnp.arange(s) // CHUNK
    scale = dq ** -0.5

    def block(args):
        q_blk, i = args
        qchunk = (i * Q_BLOCK + jnp.arange(Q_BLOCK)) // CHUNK
        mask = kchunk[None, :] <= qchunk[:, None]
        sc = jnp.einsum('bqhd,bkhd->bhqk', q_blk, k).astype(jnp.float32) * scale
        sc = jnp.where(mask[None, None], sc, NEG)
        p = jax.nn.softmax(sc, axis=-1).astype(v.dtype)
        return jnp.einsum('bhqk,bkhd->bqhd', p, v)

    o = lax.map(block, (qb, jnp.arange(nqb)))
    return o.transpose(1, 0, 2, 3, 4).reshape(bsz, s, h * dv)


def peer(h, wq, keys, u_tab, v_tab):
    bsz, s, d = h.shape
    q = (h @ wq).reshape(bsz, s, PEER_HEADS, 2, PEER_HALF)
    sc = jnp.einsum('bshpc,hpnc->bshpn', q, keys).astype(jnp.float32)
    sv, si = lax.top_k(sc, PEER_TOPK)
    comb = (sv[..., 0, :, None] + sv[..., 1, None, :]).reshape(bsz, s, PEER_HEADS, PEER_TOPK * PEER_TOPK)
    fv, fi = lax.top_k(comb, PEER_TOPK)
    e1 = jnp.take_along_axis(si[..., 0, :], fi // PEER_TOPK, axis=-1)
    e2 = jnp.take_along_axis(si[..., 1, :], fi % PEER_TOPK, axis=-1)
    experts = e1 * N_KEYS + e2
    g = jax.nn.softmax(fv, axis=-1).astype(h.dtype)
    nblk = (bsz * s) // TOKEN_BLOCK
    hb = h.reshape(nblk, TOKEN_BLOCK, d)
    eb = experts.reshape(nblk, TOKEN_BLOCK, PEER_HEADS, PEER_TOPK)
    gb = g.reshape(nblk, TOKEN_BLOCK, PEER_HEADS, PEER_TOPK)

    def block(args):
        xt, et, gt = args
        a = jnp.einsum('td,thkd->thk', xt, u_tab[et])
        w = gt * jax.nn.gelu(a, approximate=False)
        return jnp.einsum('thk,thkd->td', w, v_tab[et])

    out = lax.map(block, (hb, eb, gb))
    return out.reshape(bsz, s, d)


def setup_inputs(seed: int = 0) -> dict:
    key = jax.random.key(seed)
    ks = jax.random.split(key, 24)
    f32 = jnp.float32
    L = DEPTH
    D = D_MODEL

    def nrm(k, shape, scale):
        return jax.random.normal(k, shape, f32) * scale

    x = nrm(ks[0], (BATCH, SEQ, D), 1.0)
    c = nrm(ks[1], (BATCH, D), 1.0)
    offset = jax.random.randint(ks[2], (BATCH, 1), 0, 4096, dtype=jnp.int32)
    positions = offset + jnp.arange(SEQ, dtype=jnp.int32)[None, :]
    return {
        "x": x,
        "c": c,
        "positions": positions,
        "w_ada": nrm(ks[3], (L, D, 6 * D), 0.5 * D ** -0.5),
        "b_ada": nrm(ks[4], (L, 6 * D), 0.02),
        "w_in": nrm(ks[5], (L, D, IN_COLS), D ** -0.5),
        "b_in": nrm(ks[6], (L, IN_COLS), 0.02),
        "rel_bias": nrm(ks[7], (L, A_HEADS, REL_SIZE), 0.5),
        "q_norm_g": 1.0 + nrm(ks[8], (L, Q_LORA), 0.02),
        "kv_norm_g": 1.0 + nrm(ks[9], (L, KV_LORA), 0.02),
        "w_uq": nrm(ks[10], (L, Q_LORA, B_HEADS * (QK_NOPE + QK_ROPE)), Q_LORA ** -0.5),
        "w_ukv": nrm(ks[11], (L, KV_LORA, B_HEADS * (QK_NOPE + V_HEAD)), KV_LORA ** -0.5),
        "w_pa": nrm(ks[12], (L, A_WIDTH, D), A_WIDTH ** -0.5),
        "w_pb": nrm(ks[13], (L, B_WIDTH, D), B_WIDTH ** -0.5),
        "w_o": nrm(ks[14], (L, D, D), DN_BETA * D ** -0.5),
        "ln1_g": 1.0 + nrm(ks[15], (L, D), 0.02),
        "ln1_b": nrm(ks[16], (L, D), 0.02),
        "peer_wq": nrm(ks[17], (L, D, PEER_HEADS * PEER_QDIM), D ** -0.5),
        "peer_keys": nrm(ks[18], (L, PEER_HEADS, 2, N_KEYS, PEER_HALF), PEER_HALF ** -0.5),
        "peer_u": nrm(ks[19], (L, N_EXPERTS, D), D ** -0.5),
        "peer_v": nrm(ks[20], (L, N_EXPERTS, D), DN_BETA),
        "ln2_g": 1.0 + nrm(ks[21], (L, D), 0.02),
        "ln2_b": nrm(ks[22], (L, D), 0.02),
    }


def reference(x, c, positions, w_ada, b_ada, w_in, b_in, rel_bias, q_norm_g, kv_norm_g, w_uq, w_ukv,
              w_pa, w_pb, w_o, ln1_g, ln1_b, peer_wq, peer_keys, peer_u, peer_v, ln2_g, ln2_b):
    bsz, s, d = x.shape
    split_at = [int(i) for i in np.cumsum(IN_SIZES)[:-1]]
    inv_freq = ROPE_THETA ** (-jnp.arange(0, QK_ROPE, 2, dtype=jnp.float32) / QK_ROPE)
    ang = positions.astype(jnp.float32)[..., None] * inv_freq
    cos = jnp.cos(ang).astype(x.dtype)[:, :, None, :]
    sin = jnp.sin(ang).astype(x.dtype)[:, :, None, :]
    cond = jax.nn.silu(c)
    for l in range(DEPTH):
        mod = (cond @ w_ada[l] + b_ada[l]).reshape(bsz, 6, d)
        sh1, sc1, g1 = mod[:, 0, None, :], mod[:, 1, None, :], mod[:, 2, None, :]
        sh2, sc2, g2 = mod[:, 3, None, :], mod[:, 4, None, :], mod[:, 5, None, :]

        h = x * (1.0 + sc1) + sh1
        z = h @ w_in[l] + b_in[l]
        qa, ka, va, cq, ckv, kr, gate_a, gate_b = jnp.split(z, split_at, axis=-1)

        a_shape = (bsz, s, A_HEADS, A_HEAD_DIM)
        ya = chunk_band_attention(qa.reshape(a_shape), ka.reshape(a_shape), va.reshape(a_shape), rel_bias[l])
        ya = ya @ w_pa[l]

        qb = (rms_norm(cq, q_norm_g[l]) @ w_uq[l]).reshape(bsz, s, B_HEADS, QK_NOPE + QK_ROPE)
        q_nope, q_rope = qb[..., :QK_NOPE], rope(qb[..., QK_NOPE:], cos, sin)
        kv = (rms_norm(ckv, kv_norm_g[l]) @ w_ukv[l]).reshape(bsz, s, B_HEADS, QK_NOPE + V_HEAD)
        k_nope, vb = kv[..., :QK_NOPE], kv[..., QK_NOPE:]
        k_rope = jnp.broadcast_to(rope(kr[:, :, None, :], cos, sin), (bsz, s, B_HEADS, QK_ROPE))
        yb = chunk_causal_attention(jnp.concatenate([q_nope, q_rope], axis=-1),
                                    jnp.concatenate([k_nope, k_rope], axis=-1), vb)
        yb = yb @ w_pb[l]

        y = (jax.nn.sigmoid(gate_a) * ya + jax.nn.sigmoid(gate_b) * yb) @ w_o[l]
        x = layer_norm(DN_ALPHA * x + g1 * y, ln1_g[l], ln1_b[l])

        h2 = x * (1.0 + sc2) + sh2
        p = peer(h2, peer_wq[l], peer_keys[l], peer_u[l], peer_v[l])
        x = layer_norm(DN_ALPHA * x + g2 * p, ln2_g[l], ln2_b[l])
    return x
```

```cpp
#include <hip/hip_runtime.h>
#include <cstdio>
#include <cstdint>
#include <cmath>
namespace pg8 {
#define PG8_LAS __attribute__((address_space(3)))
typedef unsigned short bf16_t;
typedef short bf16x8 __attribute__((ext_vector_type(8)));
typedef float f32x4 __attribute__((ext_vector_type(4)));
typedef unsigned u32x4 __attribute__((ext_vector_type(4)));
constexpr int BM = 256, BK = 64, HALF = 128, HTB = HALF * BK * 2  , STAGE_BYTES = 8 * HTB, NXCD = 8, WGM = 8;

__host__ __device__ __forceinline__ int lds_byte(int r, int c) { const int st = (r >> 4) * 2 + (c >> 5), rr = r & 15, cc = c & 31, ob = rr * 64 + cc * 2; return st * 1024 + (ob ^ (((ob >> 9) & 1) << 5)); }
__host__ __device__ __forceinline__ void stage_rc(int b, int& R, int& C) { const int st = b / 1024, sb = b % 1024, swz = sb ^ (((sb >> 9) & 1) << 5); R = (st >> 1) * 16 + swz / 64; C = (st & 1) * 32 + (swz % 64) / 2; }
__host__ __device__ __forceinline__ int perm32(int rho) { const int n = rho >> 4, i = rho & 15; return 8 * (i >> 2) + 4 * n + (i & 3); }

struct Unit { int pm, pn; };
struct Gemm { const bf16_t* A; const bf16_t* Bt; int M, N, K; };

struct StaticOrder {
    int nM, nN, nwg, G, c;
    __host__ __device__ void init(int M, int N, int G_, int c_) { nM = M / BM; nN = N / BM; nwg = nM * nN; G = G_; c = c_; }
    __host__ __device__ bool next(int i, Unit& u) const {
        const long L = (long)i * G + c; if (L >= nwg) return false;
        int wgid = (int)L; { const int q = nwg / NXCD, r = nwg % NXCD, xcd = wgid % NXCD, off = wgid / NXCD; wgid = (xcd < r ? xcd * (q + 1) : r * (q + 1) + (xcd - r) * q) + off; }
        const int nig = WGM * nN, gid = wgid / nig, fm = gid * WGM, gsz = (nM - fm) < WGM ? (nM - fm) : WGM;
        u.pm = fm + ((wgid % nig) % gsz); u.pn = (wgid % nig) / gsz; return true;
    }
    __device__ __forceinline__ void a_ready(const Unit&) const {}
    __device__ __forceinline__ void done(const Unit&) const {}
};

typedef float f32x2c_t __attribute__((ext_vector_type(2))); typedef __bf16 bf16x2c_t __attribute__((ext_vector_type(2)));
__device__ __forceinline__ unsigned cvt_pk_bf16(float lo, float hi) { const f32x2c_t v = {lo, hi}; const bf16x2c_t b = __builtin_convertvector(v, bf16x2c_t); return __builtin_bit_cast(unsigned, b); }
typedef float f32x2 __attribute__((ext_vector_type(2)));

constexpr int TOK = 32768;
__device__ __forceinline__ u32x4 pack8(const f32x4& v0, const f32x4& v1) { u32x4 w; w.x = cvt_pk_bf16(v0[0], v0[1]); w.y = cvt_pk_bf16(v0[2], v0[3]); w.z = cvt_pk_bf16(v1[0], v1[1]); w.w = cvt_pk_bf16(v1[2], v1[3]); return w; }
__device__ __forceinline__ float bf_lo(unsigned w) { return __uint_as_float(w << 16); }
__device__ __forceinline__ float bf_hi(unsigned w) { return __uint_as_float(w & 0xffff0000u); }
__device__ __forceinline__ float sigmoidf_fast(float v) { return __builtin_amdgcn_rcpf(1.0f + __builtin_amdgcn_exp2f(-1.4426950408889634f * v)); }

__device__ __forceinline__ unsigned pk4f8(float a, float b, float c, float d) { int w = __builtin_amdgcn_cvt_pk_fp8_f32(a, b, 0, false); w = __builtin_amdgcn_cvt_pk_fp8_f32(c, d, w, true); return (unsigned)w; }
struct EpiF32 {
    static constexpr bool PERM = false, AFTER_DRAIN = false;
    float* C; int ldc;
    __device__ __forceinline__ void operator()(const f32x4 (&acc)[2][2][4][2], const Unit& u, int wr, int wc, int fr, int fq) const {
        const int row0 = u.pm * BM + wr * 64 + fr, col0 = u.pn * BM + wc * 32 + 4 * fq;
#pragma unroll
        for (int ai = 0; ai < 2; ++ai)
#pragma unroll
            for (int m = 0; m < 4; ++m) { float* rowp = C + (size_t)(row0 + ai * HALF + m * 16) * ldc + col0;
#pragma unroll
                for (int bj = 0; bj < 2; ++bj)
#pragma unroll
                    for (int n = 0; n < 2; ++n) *(f32x4*)(rowp + bj * HALF + n * 16) = acc[ai][bj][m][n]; }
    }
};
struct EpiInProj {
    static constexpr bool PERM = true, AFTER_DRAIN = false;
    bf16_t* QKV;
    bf16_t* CQ; bf16_t* CKV;
    bf16_t* SG;
    float* SSQ;
    const float* bias;
    float qscale;
    const float* rowscale;
    const unsigned* wmaxbits;
    __device__ __forceinline__ void operator()(const f32x4 (&acc)[2][2][4][2], const Unit& u, int wr, int wc, int fr, int fq) const {
        const int row0 = u.pm * BM + wr * 64 + fr, cl = wc * 32 + 8 * fq, bcol0 = u.pn * BM + cl;
        f32x4 bv[2][2];
#pragma unroll
        for (int bj = 0; bj < 2; ++bj)
#pragma unroll
            for (int n = 0; n < 2; ++n) bv[bj][n] = *(const f32x4*)(bias + bcol0 + bj * HALF + 4 * n);
        const float wsc = __uint_as_float(*wmaxbits) * (1.0f / 440.0f); float rsc[2][4];
#pragma unroll
        for (int ai = 0; ai < 2; ++ai)
#pragma unroll
            for (int m = 0; m < 4; ++m) rsc[ai][m] = rowscale[row0 + ai * HALF + m * 16] * wsc;
        asm volatile("" :: "v"(bv[0][0]), "v"(bv[0][1]), "v"(bv[1][0]), "v"(bv[1][1]), "v"(rsc[0][0]), "v"(rsc[0][1]), "v"(rsc[0][2]), "v"(rsc[0][3]), "v"(rsc[1][0]), "v"(rsc[1][1]), "v"(rsc[1][2]), "v"(rsc[1][3]));
        if (u.pn < 12) {
            const int t = u.pn >> 2; bf16_t* base = QKV + (size_t)t * TOK * 1024 + (u.pn & 3) * 256 + cl; const float sc = (t == 0) ? qscale : 1.0f;
#pragma unroll
            for (int ai = 0; ai < 2; ++ai)
#pragma unroll
                for (int m = 0; m < 4; ++m) { bf16_t* rowp = base + (size_t)(row0 + ai * HALF + m * 16) * 1024;
#pragma unroll
                    for (int bj = 0; bj < 2; ++bj) { const f32x4 v0 = (acc[ai][bj][m][0] * rsc[ai][m] + bv[bj][0]) * sc, v1 = (acc[ai][bj][m][1] * rsc[ai][m] + bv[bj][1]) * sc; *(u32x4*)(rowp + bj * HALF) = pack8(v0, v1); } }
        } else if (u.pn < 16) {
            const int which = (u.pn - 12) >> 1, tl = (u.pn - 12) & 1; unsigned char* base = (unsigned char*)(which ? CKV : CQ) + tl * 256 + cl; float* sq = SSQ + (size_t)which * TOK * 8 + tl * 4 + wc;
#pragma unroll
            for (int ai = 0; ai < 2; ++ai)
#pragma unroll
                for (int m = 0; m < 4; ++m) { const int row = row0 + ai * HALF + m * 16; unsigned char* rowp = base + (size_t)row * 512; float ss = 0.f;
#pragma unroll
                    for (int bj = 0; bj < 2; ++bj) { const f32x4 v0 = acc[ai][bj][m][0] * rsc[ai][m] + bv[bj][0], v1 = acc[ai][bj][m][1] * rsc[ai][m] + bv[bj][1];
                        typedef unsigned u32x2c __attribute__((ext_vector_type(2))); u32x2c o; o.x = pk4f8(v0[0] * 16.0f, v0[1] * 16.0f, v0[2] * 16.0f, v0[3] * 16.0f); o.y = pk4f8(v1[0] * 16.0f, v1[1] * 16.0f, v1[2] * 16.0f, v1[3] * 16.0f);
                        *(u32x2c*)(rowp + bj * HALF) = o;
                        ss += (v0[0] * v0[0] + v0[1] * v0[1]) + (v0[2] * v0[2] + v0[3] * v0[3]) + (v1[0] * v1[0] + v1[1] * v1[1]) + (v1[2] * v1[2] + v1[3] * v1[3]); }
                    ss += __int_as_float(__builtin_amdgcn_ds_swizzle(__float_as_int(ss), 0x401F));
                    { auto rr_ = __builtin_amdgcn_permlane32_swap(__float_as_uint(ss), __float_as_uint(ss), false, false); ss = __uint_as_float(rr_[0]) + __uint_as_float(rr_[1]); }
                    if (fq == 0) sq[(size_t)row * 8] = ss; }
        } else {
            unsigned char* base = (unsigned char*)SG + (u.pn - 16) * 256 + cl;
#pragma unroll
            for (int ai = 0; ai < 2; ++ai)
#pragma unroll
                for (int m = 0; m < 4; ++m) { unsigned char* rowp = base + (size_t)(row0 + ai * HALF + m * 16) * 4096;
#pragma unroll
                    for (int bj = 0; bj < 2; ++bj) { f32x4 v0 = acc[ai][bj][m][0] * rsc[ai][m] + bv[bj][0], v1 = acc[ai][bj][m][1] * rsc[ai][m] + bv[bj][1];
#pragma unroll
                        for (int j = 0; j < 4; ++j) { v0[j] = sigmoidf_fast(v0[j]); v1[j] = sigmoidf_fast(v1[j]); }
                        typedef unsigned u32x2c __attribute__((ext_vector_type(2))); u32x2c o; o.x = pk4f8(v0[0], v0[1], v0[2], v0[3]); o.y = pk4f8(v1[0], v1[1], v1[2], v1[3]);
                        *(u32x2c*)(rowp + bj * HALF) = o; } }
        }
    }
};
__device__ __forceinline__ float row_rs(const float* ssq_row, float inv_n, float eps) {
    const f32x4 a = *(const f32x4*)ssq_row, b = *(const f32x4*)(ssq_row + 4);
    const float s = ((a[0] + a[1]) + (a[2] + a[3])) + ((b[0] + b[1]) + (b[2] + b[3]));
    return 1.0f / sqrtf(s * inv_n + eps);
}
__device__ __forceinline__ void rope8(f32x4& v0, f32x4& v1, const float* cs) {
    const f32x4 c0 = *(const f32x4*)cs, c1 = *(const f32x4*)(cs + 4);
    f32x4 o0, o1;
    o0[0] = v0[0] * c0[0] - v0[1] * c0[1]; o0[1] = v0[0] * c0[1] + v0[1] * c0[0]; o0[2] = v0[2] * c0[2] - v0[3] * c0[3]; o0[3] = v0[2] * c0[3] + v0[3] * c0[2];
    o1[0] = v1[0] * c1[0] - v1[1] * c1[1]; o1[1] = v1[0] * c1[1] + v1[1] * c1[0]; o1[2] = v1[2] * c1[2] - v1[3] * c1[3]; o1[3] = v1[2] * c1[3] + v1[3] * c1[2];
    v0 = o0; v1 = o1;
}
struct EpiQUp {
    static constexpr bool PERM = true, AFTER_DRAIN = false;
    bf16_t* Qn; bf16_t* Qr; const float* SSQ; const float* CS; float qscale; const unsigned* wmaxbits;
    __device__ __forceinline__ void operator()(const f32x4 (&acc)[2][2][4][2], const Unit& u, int wr, int wc, int fr, int fq) const {
        const int row0 = u.pm * BM + wr * 64 + fr, cl = wc * 32 + 8 * fq;
        float rs[2][4];
#pragma unroll
        for (int ai = 0; ai < 2; ++ai)
#pragma unroll
            for (int m = 0; m < 4; ++m) rs[ai][m] = row_rs(SSQ + (size_t)(row0 + ai * HALF + m * 16) * 8, 1.0f / 512.0f, 1e-6f) * (qscale * (1.0f / (440.0f * 16.0f)) * __uint_as_float(wmaxbits[fq >> 2]));
        asm volatile("" ::: "memory");
        if (u.pn < 4) {
#pragma unroll
            for (int ai = 0; ai < 2; ++ai)
#pragma unroll
                for (int m = 0; m < 4; ++m) { const int row = row0 + ai * HALF + m * 16; bf16_t* rowp = Qn + (size_t)row * 1024 + u.pn * 256 + cl;
#pragma unroll
                    for (int bj = 0; bj < 2; ++bj) *(u32x4*)(rowp + bj * HALF) = pack8(acc[ai][bj][m][0] * rs[ai][m], acc[ai][bj][m][1] * rs[ai][m]); }
        } else { const int rc = (u.pn - 4) * 256 + cl;
#pragma unroll
            for (int ai = 0; ai < 2; ++ai)
#pragma unroll
                for (int m = 0; m < 4; ++m) { const int row = row0 + ai * HALF + m * 16;
#pragma unroll
                    for (int bj = 0; bj < 2; ++bj) { const int c = rc + bj * HALF; f32x4 v0 = acc[ai][bj][m][0] * rs[ai][m], v1 = acc[ai][bj][m][1] * rs[ai][m];
                        rope8(v0, v1, (const float*)((const char*)CS + (unsigned)((row * 32 + ((c & 63) >> 1)) * 8))); *(u32x4*)((char*)Qr + (unsigned)((row * 512 + c) * 2)) = pack8(v0, v1); }
                    if (m & 1) asm volatile("" ::: "memory"); }
        }
    }
};
struct EpiKvUp {
    static constexpr bool PERM = true, AFTER_DRAIN = false;
    bf16_t* Kn; bf16_t* Vb; const float* SSQ; const unsigned* wmaxbits;
    __device__ __forceinline__ void operator()(const f32x4 (&acc)[2][2][4][2], const Unit& u, int wr, int wc, int fr, int fq) const {
        const int row0 = u.pm * BM + wr * 64 + fr, cl = wc * 32 + 8 * fq; bf16_t* base = (u.pn < 4 ? Kn : Vb) + (u.pn & 3) * 256 + cl;
        float rs[2][4];
#pragma unroll
        for (int ai = 0; ai < 2; ++ai)
#pragma unroll
            for (int m = 0; m < 4; ++m) rs[ai][m] = row_rs(SSQ + (size_t)(row0 + ai * HALF + m * 16) * 8, 1.0f / 512.0f, 1e-6f) * ((1.0f / (440.0f * 16.0f)) * __uint_as_float(*wmaxbits));
        asm volatile("" ::: "memory");
#pragma unroll
        for (int ai = 0; ai < 2; ++ai)
#pragma unroll
            for (int m = 0; m < 4; ++m) { const int row = row0 + ai * HALF + m * 16; bf16_t* rowp = base + (size_t)row * 1024;
#pragma unroll
                for (int bj = 0; bj < 2; ++bj) *(u32x4*)(rowp + bj * HALF) = pack8(acc[ai][bj][m][0] * rs[ai][m], acc[ai][bj][m][1] * rs[ai][m]); }
    }
};
struct EpiKr {
    static constexpr bool PERM = true, AFTER_DRAIN = false;
    bf16_t* KR; const float* bias; const float* CS; const float* rowscale; const unsigned* wmaxbits;
    __device__ __forceinline__ void operator()(const f32x4 (&acc)[2][2][4][2], const Unit& u, int wr, int wc, int fr, int fq) const {
        if (wc >= 2) return;
        const int row0 = u.pm * BM + wr * 64 + fr, cl = wc * 32 + 8 * fq; const float wsc = __uint_as_float(*wmaxbits) * (1.0f / 440.0f);
        const f32x4 b0 = *(const f32x4*)(bias + cl), b1 = *(const f32x4*)(bias + cl + 4);
#pragma unroll
        for (int ai = 0; ai < 2; ++ai)
#pragma unroll
            for (int m = 0; m < 4; ++m) { const int row = row0 + ai * HALF + m * 16; const float rs = rowscale[row] * wsc; f32x4 v0 = acc[ai][0][m][0] * rs + b0, v1 = acc[ai][0][m][1] * rs + b1;
                rope8(v0, v1, CS + ((size_t)row * 32 + (cl >> 1)) * 2); *(u32x4*)(KR + (size_t)row * 64 + cl) = pack8(v0, v1);
                if (m & 1) asm volatile("" ::: "memory"); }
    }
};
__device__ __forceinline__ void unpk8f8(unsigned lo, unsigned hi, f32x4& a, f32x4& b) { typedef float f32x2u __attribute__((ext_vector_type(2)));
    const f32x2u p0 = __builtin_amdgcn_cvt_pk_f32_fp8((int)lo, false), p1 = __builtin_amdgcn_cvt_pk_f32_fp8((int)lo, true), p2 = __builtin_amdgcn_cvt_pk_f32_fp8((int)hi, false), p3 = __builtin_amdgcn_cvt_pk_f32_fp8((int)hi, true);
    a = (f32x4){p0[0], p0[1], p1[0], p1[1]}; b = (f32x4){p2[0], p2[1], p3[0], p3[1]}; }
template <int MODE> struct EpiGate {
    static constexpr bool PERM = true, AFTER_DRAIN = false;
    unsigned char* T8; const unsigned char* SG8; unsigned char* MIX8; const unsigned* wmaxbits; float actmul;
    __device__ __forceinline__ void operator()(const f32x4 (&acc)[2][2][4][2], const Unit& u, int wr, int wc, int fr, int fq) const {
        typedef unsigned u32x2e __attribute__((ext_vector_type(2)));
        const int row0 = u.pm * BM + wr * 64 + fr, col0 = u.pn * BM + wc * 32 + 8 * fq; const float sc = __uint_as_float(*wmaxbits) * (1.0f / 440.0f) * actmul;
#pragma unroll
        for (int ai = 0; ai < 2; ++ai)
#pragma unroll
            for (int m = 0; m < 4; ++m) { const int row = row0 + ai * HALF + m * 16;
#pragma unroll
                for (int bj = 0; bj < 2; ++bj) { const int c = col0 + bj * HALF; const u32x2e g = *(const u32x2e*)(SG8 + (size_t)row * 4096 + MODE * 2048 + c);
                    f32x4 g0, g1; unpk8f8(g.x, g.y, g0, g1);
                    f32x4 v0 = acc[ai][bj][m][0] * sc * g0, v1 = acc[ai][bj][m][1] * sc * g1;
                    if (MODE == 1) { const u32x2e t = *(const u32x2e*)(T8 + (size_t)row * 2048 + c); f32x4 t0, t1; unpk8f8(t.x, t.y, t0, t1); v0 = v0 + t0; v1 = v1 + t1; }
                    u32x2e o; o.x = pk4f8(v0[0], v0[1], v0[2], v0[3]); o.y = pk4f8(v1[0], v1[1], v1[2], v1[3]);
                    *(u32x2e*)((MODE == 0 ? T8 : MIX8) + (size_t)row * 2048 + c) = o; } }
    }
};
struct EpiWo {
    static constexpr bool PERM = true, AFTER_DRAIN = false;
    const float* X; bf16_t* U1; const float* MOD; float alpha; const unsigned* wmaxbits; float actinv;
    __device__ __forceinline__ void operator()(const f32x4 (&acc)[2][2][4][2], const Unit& u, int wr, int wc, int fr, int fq) const {
        const int row0 = u.pm * BM + wr * 64 + fr, col0 = u.pn * BM + wc * 32 + 8 * fq; const int b = (u.pm * BM) >> 12;
        f32x4 gv[2][2];
#pragma unroll
        for (int bj = 0; bj < 2; ++bj)
#pragma unroll
            for (int n = 0; n < 2; ++n) gv[bj][n] = *(const f32x4*)(MOD + ((size_t)b * 6 + 2) * 2048 + col0 + bj * HALF + n * 4) * (__uint_as_float(*wmaxbits) * (1.0f / 440.0f) * actinv);
#pragma unroll
        for (int ai = 0; ai < 2; ++ai)
#pragma unroll
            for (int m = 0; m < 4; ++m) { const size_t off = (size_t)(row0 + ai * HALF + m * 16) * 2048 + col0;
#pragma unroll
                for (int bj = 0; bj < 2; ++bj) { const f32x4 x0 = *(const f32x4*)(X + off + bj * HALF), x1 = *(const f32x4*)(X + off + bj * HALF + 4);
                    const f32x4 v0 = x0 * alpha + gv[bj][0] * acc[ai][bj][m][0], v1 = x1 * alpha + gv[bj][1] * acc[ai][bj][m][1];
                    *(u32x4*)(U1 + off + bj * HALF) = pack8(v0, v1); }
                asm volatile("" ::: "memory"); }
    }
};

__device__ __forceinline__ bf16x8 lds_rd16(const PG8_LAS bf16x8* __restrict__ p) { return *p; }
typedef int i32x4g __attribute__((ext_vector_type(4))); typedef int i32x8g __attribute__((ext_vector_type(8)));
template <class Epi, class Sched, bool ALIGN_EPI = false, bool SP2 = false, bool F8 = false>
__device__ __forceinline__ void gemm_phase(PG8_LAS unsigned char* lds, const Gemm g, const Sched& S, const Epi& E, const int tid) {
    const int wid = __builtin_amdgcn_readfirstlane(tid >> 6), lane = tid & 63, wr = wid >> 2, wc = wid & 3, fr = lane & 15, fq = lane >> 4;
    const int K = g.K, nt = K / BK;
    unsigned voffA[2], voffB[2];
#pragma unroll
    for (int i = 0; i < 2; ++i) { int R, C; stage_rc(tid * 16 + i * 8192, R, C); const int Rb = Epi::PERM ? ((R & ~31) + perm32(R & 31)) : R;
        voffA[i] = (unsigned)(R * K + C) * 2u; voffB[i] = (unsigned)(Rb * K + C) * 2u; }
    const size_t kstep = (size_t)(BK * 2);
    const size_t hstep = (size_t)HALF * K * 2;
    const size_t tstep = 2 * hstep;
    const unsigned ldsbase_u = (unsigned)(size_t)lds;
    const unsigned ldsw = (unsigned)wid * 1024u;
    const int aoff = lds_byte(wr * 64 + fr, fq * 8), boff = lds_byte(wc * 32 + fr, fq * 8);
#define PG8_SA(b, h) (((b) * 2 + (h)) * HTB)
#define PG8_SB(b, h) ((4 + (b) * 2 + (h)) * HTB)
#define PG8_STAGE(bufoff, gbase, voff) do { _Pragma("unroll") for (int _i = 0; _i < 2; ++_i) { unsigned keep_; \
        asm volatile("s_mov_b32 %0, m0\n\ts_mov_b32 m0, %3\n\ts_nop 0\n\tglobal_load_lds_dwordx4 %1, %2\n\ts_mov_b32 m0, %0" \
                     : "=&s"(keep_) : "v"((voff)[_i]), "s"((const char*)(gbase)), "s"(ldsbase_u + (unsigned)(bufoff) + ldsw + (unsigned)(_i * 8192)) : "memory"); } } while (0)
#define PG8_LDA(dst, b, h) do { _Pragma("unroll") for (int m = 0; m < 4; ++m) _Pragma("unroll") for (int k = 0; k < 2; ++k) dst[m][k] = lds_rd16((const PG8_LAS bf16x8*)(lds + PG8_SA(b, h) + aoff + m * 2048 + k * 1024)); } while (0)
#define PG8_LDB(dst, b, h) do { _Pragma("unroll") for (int n = 0; n < 2; ++n) _Pragma("unroll") for (int k = 0; k < 2; ++k) dst[n][k] = lds_rd16((const PG8_LAS bf16x8*)(lds + PG8_SB(b, h) + boff + n * 2048 + k * 1024)); } while (0)
#define PG8_MMA(ai, bj, At, Bt) do { __builtin_amdgcn_s_setprio(1); _Pragma("unroll") for (int m = 0; m < 4; ++m) _Pragma("unroll") for (int n = 0; n < 2; ++n) { \
        if constexpr (F8) { const i32x8g a8_ = __builtin_shufflevector(__builtin_bit_cast(i32x4g, At[m][0]), __builtin_bit_cast(i32x4g, At[m][1]), 0, 1, 2, 3, 4, 5, 6, 7); \
                            const i32x8g b8_ = __builtin_shufflevector(__builtin_bit_cast(i32x4g, Bt[n][0]), __builtin_bit_cast(i32x4g, Bt[n][1]), 0, 1, 2, 3, 4, 5, 6, 7); \
                            acc[ai][bj][m][n] = __builtin_amdgcn_mfma_scale_f32_16x16x128_f8f6f4(b8_, a8_, acc[ai][bj][m][n], 0, 0, 0, 0x7f7f7f7f, 0, 0x7f7f7f7f); } \
        else { _Pragma("unroll") for (int k = 0; k < 2; ++k) acc[ai][bj][m][n] = __builtin_amdgcn_mfma_f32_16x16x32_bf16(Bt[n][k], At[m][k], acc[ai][bj][m][n], 0, 0, 0); } } \
        __builtin_amdgcn_s_setprio(0); } while (0)
#define PG8_WAIT_V(n) asm volatile("s_waitcnt vmcnt(" #n ")" ::: "memory")
#define PG8_WAIT_L(n) asm volatile("s_waitcnt lgkmcnt(" #n ")" ::: "memory")
#define PG8_BAR __builtin_amdgcn_s_barrier()
#define PG8_SCHED __builtin_amdgcn_sched_barrier(0)
    Unit cur, nxt; int ui = 0;
    if (!S.next(0, cur)) return;
    f32x4 acc[2][2][4][2];
#pragma unroll
    for (int a = 0; a < 2; ++a)
#pragma unroll
        for (int b = 0; b < 2; ++b)
#pragma unroll
            for (int m = 0; m < 4; ++m)
#pragma unroll
                for (int n = 0; n < 2; ++n) acc[a][b][m][n] = (f32x4){0.f, 0.f, 0.f, 0.f};
    bf16x8 At[4][2], B0[2][2], B1[2][2];
    const char* cA = (const char*)g.A + (size_t)cur.pm * tstep; const char* cB = (const char*)g.Bt + (size_t)cur.pn * tstep;
    S.a_ready(cur);
    if constexpr (SP2) {
        PG8_STAGE(PG8_SB(0, 0), cB, voffB); PG8_STAGE(PG8_SB(0, 1), cB + hstep, voffB); PG8_STAGE(PG8_SA(0, 0), cA, voffA); PG8_STAGE(PG8_SA(0, 1), cA + hstep, voffA);
        if (wr == 1) PG8_BAR;
        PG8_WAIT_V(2); PG8_BAR;
        PG8_STAGE(PG8_SB(1, 0), cB + kstep, voffB); PG8_STAGE(PG8_SA(1, 0), cA + kstep, voffA); PG8_STAGE(PG8_SB(1, 1), cB + hstep + kstep, voffB);
        PG8_WAIT_V(6); PG8_BAR;
    } else {
        PG8_STAGE(PG8_SB(0, 0), cB, voffB); PG8_STAGE(PG8_SA(0, 0), cA, voffA); PG8_STAGE(PG8_SB(0, 1), cB + hstep, voffB); PG8_STAGE(PG8_SA(0, 1), cA + hstep, voffA);
        if (wr == 1) PG8_BAR;
        PG8_WAIT_V(4); PG8_BAR;
        PG8_STAGE(PG8_SB(1, 0), cB + kstep, voffB); PG8_STAGE(PG8_SA(1, 0), cA + kstep, voffA); PG8_STAGE(PG8_SB(1, 1), cB + hstep + kstep, voffB);
        PG8_WAIT_V(6); PG8_BAR;
    }
    for (;;) {
        const bool has_next = S.next(ui + 1, nxt);
        const char* nA = has_next ? (const char*)g.A + (size_t)nxt.pm * tstep : cA; const char* nB = has_next ? (const char*)g.Bt + (size_t)nxt.pn * tstep : cB;
#pragma unroll 1
        for (int t = 0; t < nt; t += 2) {
            const bool last = (t == nt - 2);
            const char* a1 = cA + (size_t)(t + 1) * kstep;
            const char* a2 = last ? nA : cA + (size_t)(t + 2) * kstep; const char* b2 = last ? nB : cB + (size_t)(t + 2) * kstep;
            const char* a3 = a2 + kstep; const char* b3 = b2 + kstep;
            if (last && has_next) S.a_ready(nxt);
            if constexpr (SP2) {
            PG8_LDB(B0, 0, 0); PG8_LDB(B1, 0, 1); PG8_SCHED; PG8_LDA(At, 0, 0); PG8_STAGE(PG8_SA(1, 1), a1 + hstep, voffA);
            PG8_WAIT_V(8); PG8_WAIT_L(0); PG8_BAR; PG8_MMA(0, 0, At, B0); PG8_MMA(0, 1, At, B1); PG8_BAR; PG8_SCHED;
            PG8_LDA(At, 0, 1); PG8_STAGE(PG8_SB(0, 0), b2, voffB); PG8_STAGE(PG8_SB(0, 1), b2 + hstep, voffB); PG8_STAGE(PG8_SA(0, 0), a2, voffA);
            PG8_WAIT_V(8); PG8_WAIT_L(0); PG8_BAR; PG8_MMA(1, 0, At, B0); PG8_MMA(1, 1, At, B1); PG8_BAR; PG8_SCHED;
            PG8_LDB(B0, 1, 0); PG8_LDB(B1, 1, 1); PG8_SCHED; PG8_LDA(At, 1, 0); PG8_STAGE(PG8_SA(0, 1), a2 + hstep, voffA);
            PG8_WAIT_V(8); PG8_WAIT_L(0); PG8_BAR; PG8_MMA(0, 0, At, B0); PG8_MMA(0, 1, At, B1); PG8_BAR; PG8_SCHED;
            PG8_LDA(At, 1, 1); PG8_STAGE(PG8_SB(1, 0), b3, voffB); PG8_STAGE(PG8_SB(1, 1), b3 + hstep, voffB); PG8_STAGE(PG8_SA(1, 0), a3, voffA);
            PG8_WAIT_V(8); PG8_WAIT_L(0); PG8_BAR; PG8_MMA(1, 0, At, B0); PG8_MMA(1, 1, At, B1); PG8_BAR; PG8_SCHED;
            } else {
            PG8_LDB(B0, 0, 0); PG8_SCHED; PG8_LDA(At, 0, 0); PG8_STAGE(PG8_SA(1, 1), a1 + hstep, voffA);
            PG8_WAIT_L(8); PG8_BAR; PG8_WAIT_L(0); PG8_MMA(0, 0, At, B0); PG8_BAR; PG8_SCHED;
            PG8_LDB(B1, 0, 1); PG8_STAGE(PG8_SB(0, 0), b2, voffB);
            PG8_BAR; PG8_WAIT_L(0); PG8_MMA(0, 1, At, B1); PG8_BAR;
            PG8_LDA(At, 0, 1); PG8_STAGE(PG8_SA(0, 0), a2, voffA);
            PG8_BAR; PG8_WAIT_L(0); PG8_MMA(1, 0, At, B0); PG8_BAR; PG8_SCHED;
            PG8_STAGE(PG8_SB(0, 1), b2 + hstep, voffB);
            PG8_WAIT_V(6); PG8_BAR; PG8_MMA(1, 1, At, B1); PG8_BAR;
            PG8_LDB(B0, 1, 0); PG8_SCHED; PG8_LDA(At, 1, 0); PG8_STAGE(PG8_SA(0, 1), a2 + hstep, voffA);
            PG8_WAIT_L(8); PG8_BAR; PG8_WAIT_L(0); PG8_MMA(0, 0, At, B0); PG8_BAR; PG8_SCHED;
            PG8_LDB(B1, 1, 1); PG8_STAGE(PG8_SB(1, 0), b3, voffB);
            PG8_BAR; PG8_WAIT_L(0); PG8_MMA(0, 1, At, B1); PG8_BAR;
            PG8_LDA(At, 1, 1); PG8_STAGE(PG8_SA(1, 0), a3, voffA);
            PG8_BAR; PG8_WAIT_L(0); PG8_MMA(1, 0, At, B0); PG8_BAR; PG8_SCHED;
            PG8_STAGE(PG8_SB(1, 1), b3 + hstep, voffB);
            PG8_WAIT_V(6); PG8_BAR; PG8_MMA(1, 1, At, B1); PG8_BAR;
            }
        }
        if constexpr (ALIGN_EPI) { if (wr == 0) PG8_BAR; }
        if constexpr (!Epi::AFTER_DRAIN) { int ln_; asm volatile("v_mbcnt_lo_u32_b32 %0, -1, 0\n\tv_mbcnt_hi_u32_b32 %0, -1, %0" : "=v"(ln_));
            E(acc, cur, wr, wc, ln_ & 15, ln_ >> 4); S.done(cur); }
        if (!has_next) break;
#pragma unroll
        for (int a = 0; a < 2; ++a)
#pragma unroll
            for (int b = 0; b < 2; ++b)
#pragma unroll
                for (int m = 0; m < 4; ++m)
#pragma unroll
                    for (int n = 0; n < 2; ++n) acc[a][b][m][n] = (f32x4){0.f, 0.f, 0.f, 0.f};
        cur = nxt; cA = nA; cB = nB; ++ui;
        if constexpr (ALIGN_EPI) { if (wr == 1) PG8_BAR; }
    }
    PG8_WAIT_V(0);
    if constexpr (!ALIGN_EPI) { if (wr == 0) PG8_BAR; }
    PG8_BAR;
    if constexpr (Epi::AFTER_DRAIN) { E.fused(acc, cur, wr, wc, fr, fq, lds, wid, lane); S.done(cur); }
#undef PG8_SA
#undef PG8_SB
#undef PG8_STAGE
#undef PG8_LDA
#undef PG8_LDB
#undef PG8_MMA
#undef PG8_WAIT_V
#undef PG8_WAIT_L
#undef PG8_BAR
#undef PG8_SCHED
}
}

constexpr int NB = 8, SEQ = 4096, DM = 2048, TOK = NB * SEQ;
constexpr int NWAVES = 8;
constexpr float LN_EPS = 1e-5f;
constexpr float DN_ALPHA = 1.189207115002721f;
constexpr float LOG2E = 1.4426950408889634f;
constexpr float QSCALE_A = 0.08838834764831845f * LOG2E;
constexpr float QSCALE_B = 0.07216878364870322f * LOG2E;

constexpr size_t MiB = 1u << 20;
constexpr size_t WS_CTL = 0, CTL_ZERO_BYTES = 1 * MiB;
constexpr size_t WS_WIN = 1 * MiB;
constexpr size_t WS_WKR = 33 * MiB;
constexpr size_t WS_WUQ = 34 * MiB;
constexpr size_t WS_WUKV = 36 * MiB;
constexpr size_t WS_WPA = 38 * MiB;
constexpr size_t WS_WPB = 42 * MiB;
constexpr size_t WS_WO = 46 * MiB;
constexpr size_t WS_WSK = 54 * MiB;
constexpr size_t WS_MOD = 62 * MiB;
constexpr size_t WS_BIAS = 62 * MiB + 512 * 1024;
constexpr size_t WS_LN1 = 63 * MiB;
constexpr size_t WS_UT = 64 * MiB;
constexpr size_t WS_VT = 96 * MiB;
constexpr size_t WS_TSCALE = 62 * MiB + 768 * 1024;
constexpr size_t WS_W8 = 80 * MiB;
constexpr size_t WS_HSC = 63 * MiB + 512 * 1024;
constexpr size_t WS_WUQ8 = 121 * MiB;
constexpr size_t WS_WUKV8 = 122 * MiB;
constexpr size_t WS_WKR8 = 112 * MiB;
constexpr size_t WS_WPA8 = 113 * MiB;
constexpr size_t WS_WPB8 = 115 * MiB;
constexpr size_t WS_WO8 = 117 * MiB;
constexpr size_t WS_H8 = 128 * MiB;
constexpr size_t WS_H = 192 * MiB;
constexpr size_t WS_QKVA = 320 * MiB;
constexpr size_t WS_SCORE = 320 * MiB;
constexpr size_t WS_CQ = 512 * MiB;
constexpr size_t WS_CKV = 544 * MiB;
constexpr size_t WS_U1B = 576 * MiB;
constexpr size_t WS_QN = 576 * MiB;
constexpr size_t WS_QR = 640 * MiB;
constexpr size_t WS_KN = 672 * MiB;
constexpr size_t WS_VB = 736 * MiB;
constexpr size_t WS_KR = 800 * MiB;
constexpr size_t WS_YA = 804 * MiB;
constexpr size_t WS_YB = 868 * MiB;
constexpr size_t WS_CS = 932 * MiB;
constexpr size_t WS_SSQ = 940 * MiB;
constexpr size_t WS_END = 942 * MiB;
constexpr size_t WS_IDS = 736 * MiB;
constexpr size_t WS_GATES = 744 * MiB;
constexpr size_t WS_W = 760 * MiB;
constexpr size_t WS_WSC = 768 * MiB;
constexpr size_t WS_SX = 776 * MiB;
constexpr size_t WS_S8 = 776 * MiB + 128 * 1024;
constexpr size_t WS_PA = 320 * MiB;
constexpr size_t WS_XH = 804 * MiB;
constexpr size_t WS_XL = 836 * MiB;
constexpr size_t WS_ST2 = 778 * MiB;
constexpr size_t UT_SLICE = 2 * MiB;
constexpr int CW_BAR = 4096;
constexpr int CW_WMAX = 8;
constexpr float ACT_C = 16.0f;
constexpr float ACT_Y = 32.0f, ACT_MIX = 64.0f;
constexpr int CW_WMAX0 = 8;

constexpr int RING_BYTES = 131072;
constexpr int MISC_OFF = RING_BYTES + 320;
constexpr int LDS_BYTES = 147456;

#define GAS __attribute__((address_space(1)))
#define LAS __attribute__((address_space(3)))
typedef unsigned short bf16;
typedef unsigned v4u __attribute__((ext_vector_type(4)));
typedef unsigned v2u __attribute__((ext_vector_type(2)));
typedef float f32x4 __attribute__((ext_vector_type(4)));
typedef float f32x16 __attribute__((ext_vector_type(16)));
typedef short bf16x8 __attribute__((ext_vector_type(8)));
typedef short s16x4 __attribute__((ext_vector_type(4)));
typedef __bf16 bf16x2_t __attribute__((ext_vector_type(2)));
#define LDS_WAIT() asm volatile("s_waitcnt lgkmcnt(0)" ::: "memory")
#define VM_WAIT() asm volatile("s_waitcnt vmcnt(0)" ::: "memory")
__device__ __forceinline__ unsigned f2bf(float f) { unsigned u = __builtin_bit_cast(unsigned, f); return (u + 0x7fffu + ((u >> 16) & 1u)) >> 16; }
__device__ __forceinline__ unsigned pk2(float lo, float hi) { return f2bf(lo) | (f2bf(hi) << 16); }
#define WRED_DPP(v, ctrl) __builtin_amdgcn_update_dpp(0, (v), (ctrl), 0xF, 0xF, true)
__device__ __forceinline__ float wave_sum(float v) {
    v += __int_as_float(WRED_DPP(__float_as_int(v), 0xB1)); v += __int_as_float(WRED_DPP(__float_as_int(v), 0x4E));
    v += __int_as_float(WRED_DPP(__float_as_int(v), 0x141)); v += __int_as_float(WRED_DPP(__float_as_int(v), 0x140));
    { const auto r = __builtin_amdgcn_permlane16_swap(__float_as_uint(v), __float_as_uint(v), false, false); v = __uint_as_float(r[0]) + __uint_as_float(r[1]); }
    { const auto r = __builtin_amdgcn_permlane32_swap(__float_as_uint(v), __float_as_uint(v), false, false); v = __uint_as_float(r[0]) + __uint_as_float(r[1]); }
    return v;
}
__device__ __forceinline__ float wave_max(float v) {
    v = fmaxf(v, __int_as_float(WRED_DPP(__float_as_int(v), 0xB1))); v = fmaxf(v, __int_as_float(WRED_DPP(__float_as_int(v), 0x4E)));
    v = fmaxf(v, __int_as_float(WRED_DPP(__float_as_int(v), 0x141))); v = fmaxf(v, __int_as_float(WRED_DPP(__float_as_int(v), 0x140)));
    { const auto r = __builtin_amdgcn_permlane16_swap(__float_as_uint(v), __float_as_uint(v), false, false); v = fmaxf(__uint_as_float(r[0]), __uint_as_float(r[1])); }
    { const auto r = __builtin_amdgcn_permlane32_swap(__float_as_uint(v), __float_as_uint(v), false, false); v = fmaxf(__uint_as_float(r[0]), __uint_as_float(r[1])); }
    return v;
}
__device__ __forceinline__ int wave_sum_int(int v) {
    v += WRED_DPP(v, 0xB1); v += WRED_DPP(v, 0x4E); v += WRED_DPP(v, 0x141); v += WRED_DPP(v, 0x140);
    { const auto r = __builtin_amdgcn_permlane16_swap((unsigned)v, (unsigned)v, false, false); v = (int)(r[0] + r[1]); }
    { const auto r = __builtin_amdgcn_permlane32_swap((unsigned)v, (unsigned)v, false, false); v = (int)(r[0] + r[1]); }
    return v;
}
__device__ __forceinline__ float bflo(unsigned w) { return __uint_as_float(w << 16); }
__device__ __forceinline__ float bfhi(unsigned w) { return __uint_as_float(w & 0xffff0000u); }

#define XB_TMO      128
#define XB_XCNT(j)  (256  + 64 * (j))
#define XB_XSUB(j)  (1280 + 64 * (j))
#define XB_XGEN(j)  (2304 + 64 * (j))
#define XB_TOP      3328
#define XB_TOPGEN   3392
#define XCD_BAR_WORDS 3456
#define XB_SPIN_CAP (1u << 18)

__device__ __forceinline__ unsigned xb_ld(unsigned* p)              { return __hip_atomic_load(p, __ATOMIC_RELAXED, __HIP_MEMORY_SCOPE_AGENT); }
__device__ __forceinline__ unsigned xb_add(unsigned* p, unsigned v) { return __hip_atomic_fetch_add(p, v, __ATOMIC_RELAXED, __HIP_MEMORY_SCOPE_AGENT); }
__device__ __forceinline__ unsigned xb_xcc_id() { return (unsigned)__builtin_amdgcn_s_getreg((3 << 11) | 20) & 0xFu; }
#define XB_SPIN(cond, bar) do { unsigned _sp = 0; while (cond) { __builtin_amdgcn_s_sleep(1); \
    if ((++_sp & 255u) == 0u) { if (xb_ld(&(bar)[XB_TMO])) break; if (_sp > XB_SPIN_CAP) { atomicAdd(&(bar)[XB_TMO], 1u); break; } } } } while (0)

struct XcdBarrier {
    unsigned* bar; unsigned x;
    volatile LAS unsigned* st;
    bool w0;
};
__device__ __forceinline__ bool xb_thread0(bool w0) { return w0 && __builtin_amdgcn_mbcnt_hi(~0u, __builtin_amdgcn_mbcnt_lo(~0u, 0u)) == 0u; }

__device__ __forceinline__ XcdBarrier xcd_barrier_post(unsigned* bar, volatile LAS unsigned* st, bool w0) {
    XcdBarrier b; b.bar = bar; b.x = xb_xcc_id(); b.st = st; b.w0 = w0;
    if (xb_thread0(w0)) (void)xb_add(&bar[XB_XCNT(b.x)], 1u);
    return b;
}
__device__ __forceinline__ void xcd_barrier_complete(unsigned* bar, unsigned x, unsigned& nloc, unsigned& nx) {
    const unsigned G = gridDim.x * gridDim.y * gridDim.z;
    unsigned sum, cnt, mine, sp = 0u;
    for (;;) {
        sum = 0u; cnt = 0u; mine = 0u;
#pragma unroll
        for (unsigned j = 0; j < 16; ++j) { const unsigned c = xb_ld(&bar[XB_XCNT(j)]); sum += c; cnt += (c > 0u) ? 1u : 0u; mine = (j == x) ? c : mine; }
        if (sum == G) break;
        __builtin_amdgcn_s_sleep(1);
        if ((++sp & 255u) == 0u) { if (xb_ld(&bar[XB_TMO])) break; if (sp > XB_SPIN_CAP) { atomicAdd(&bar[XB_TMO], 1u); break; } }
    }
    nloc = mine > 0u ? mine : 1u; nx = cnt > 0u ? cnt : 1u;
}

__device__ __forceinline__ void xcd_barrier(const XcdBarrier& b) {
    asm volatile("s_waitcnt vmcnt(0)" ::: "memory");
    __syncthreads();
    if (xb_thread0(b.w0)) {
        unsigned* bar = b.bar;
        __builtin_amdgcn_s_waitcnt(0);
        unsigned nloc = b.st[0], nx = b.st[1];
        if (nloc == 0u) { xcd_barrier_complete(bar, b.x, nloc, nx); b.st[0] = nloc; b.st[1] = nx; }
        const unsigned old = xb_add(&bar[XB_XSUB(b.x)], 1u);
        const unsigned gen = old / nloc;
        if (old + 1u == (gen + 1u) * nloc) {
            __builtin_amdgcn_fence(__ATOMIC_RELEASE, "agent");
            asm volatile("s_waitcnt vmcnt(0)" ::: "memory");
            const unsigned og = xb_add(&bar[XB_TOP], 1u);
            const unsigned tg = og / nx;
            if (og + 1u == (tg + 1u) * nx) xb_add(&bar[XB_TOPGEN], 1u);
            else XB_SPIN(xb_ld(&bar[XB_TOPGEN]) == tg, bar);
            __builtin_amdgcn_fence(__ATOMIC_ACQUIRE, "agent");
            xb_add(&bar[XB_XGEN(b.x)], 1u);
            asm volatile("s_waitcnt vmcnt(0)" ::: "memory");
        } else {
            XB_SPIN(xb_ld(&bar[XB_XGEN(b.x)]) == gen, bar);
            __builtin_amdgcn_fence(__ATOMIC_ACQUIRE, "agent");
            asm volatile("s_waitcnt vmcnt(0)" ::: "memory");
        }
    }
    __syncthreads();
}

namespace att {
constexpr int SHM_V = 16384, SHM_KN = 16384, SHM_KR = 8192, BUFB = SHM_V + SHM_KN + SHM_KR;
constexpr int OFF_V = 0, OFF_KN = SHM_V, OFF_KR = SHM_V + SHM_KN;
constexpr int NSLOT = 3;
constexpr int OFF_WS = NSLOT * BUFB, OFF_BIAS = OFF_WS + 2048, ATT_LDS = OFF_BIAS + 1280;
static_assert(ATT_LDS <= RING_BYTES, "attention LDS");
#define KSWZ(row, colB) ((row) * 256 + ((colB) ^ (((row) & 15) << 4)))
#define KRSWZ(row, colB) ((row) * 128 + ((colB) ^ ((((row) >> 1) & 7) << 4)))
__device__ __forceinline__ int v_st(int k, int c) { const int kk = (k & ~0xC) | ((k & 4) << 1) | ((k & 8) >> 1); return ((kk >> 3) * 4 + (c >> 5)) * 512 + ((kk & 7) * 32 + (c & 31)) * 2; }
__device__ __forceinline__ int v_rd_base(int lane) { return ((lane & 3) << 3) | (((lane >> 2) & 3) << 6) | (((lane >> 4) & 1) << 5) | (((lane >> 5) & 1) << 8); }
__device__ __forceinline__ int crow(int r, int hi) { return (r & 3) + 8 * (r >> 2) + 4 * hi; }
__device__ __forceinline__ unsigned cvtpk(float lo, float hi) { return pg8::cvt_pk_bf16(lo, hi); }
constexpr float THR = 8.0f;

template <int MODE>
__device__ __forceinline__ void attn_unit(LAS unsigned char* lds, int b, int h, int qb, const bf16* __restrict__ Qn, const bf16* __restrict__ Qr, const bf16* __restrict__ Kn,
                                          const bf16* __restrict__ Kr, const bf16* __restrict__ V, bf16* __restrict__ O, const float* __restrict__ relb, const int tid_in) {
    constexpr int ND = MODE ? 12 : 8;
    int tid = tid_in; asm volatile("" : "+v"(tid));
    const int wid = __builtin_amdgcn_readfirstlane(tid >> 6), lane = tid & 63, r32 = lane & 31, hi = lane >> 5;
    const int tb = b * SEQ, cw = 4 * qb + (wid >> 1);
    const int j_lo = MODE ? 0 : (4 * qb - 8 > 0 ? 4 * qb - 8 : 0), j_hi = 4 * qb + 4, NTL = j_hi - j_lo;
    bf16x8 qr[ND];
    { const size_t qrow = (size_t)(tb + 256 * qb + 32 * wid + r32);
#pragma unroll
      for (int d0 = 0; d0 < 8; ++d0) qr[d0] = *(const bf16x8*)(Qn + qrow * 1024 + h * 128 + d0 * 16 + hi * 8);
      if constexpr (MODE == 1) {
#pragma unroll
          for (int d0 = 0; d0 < 4; ++d0) qr[8 + d0] = *(const bf16x8*)(Qr + qrow * 512 + h * 64 + d0 * 16 + hi * 8); } }
    unsigned gk[2], gv[2], gkr;
#pragma unroll
    for (int i = 0; i < 2; ++i) { const int p = 2 * wid + i; const int row = 4 * p + (lane >> 4), colB = ((lane & 15) << 4) ^ ((row & 15) << 4);
        gk[i] = (unsigned)(row * 2048 + colB);
        const int st = 2 * p + (lane >> 5), kk = (st >> 2) * 8 + ((lane & 31) >> 2), c = (st & 3) * 32 + (lane & 3) * 8, k = (kk & ~0xC) | ((kk & 4) << 1) | ((kk & 8) >> 1);
        gv[i] = (unsigned)(k * 2048 + c * 2); }
    { const int row = 8 * wid + (lane >> 3), colB = ((lane & 7) << 4) ^ (((row >> 1) & 7) << 4); gkr = (unsigned)(row * 128 + colB); }
    const char* Kg = (const char*)(Kn + (size_t)tb * 1024 + h * 128); const char* Vg = (const char*)(V + (size_t)tb * 1024 + h * 128); const char* Krg = (const char*)(Kr + (size_t)tb * 64);
#define ATT_STAGE(j, bo) do { const size_t to_ = (size_t)(j) * (64 * 2048); \
        __builtin_amdgcn_global_load_lds((const unsigned*)(Kg + to_ + gk[0]), (LAS unsigned*)(lds + (bo) + OFF_KN + wid * 2048), 16, 0, 0); \
        __builtin_amdgcn_global_load_lds((const unsigned*)(Kg + to_ + gk[1]), (LAS unsigned*)(lds + (bo) + OFF_KN + wid * 2048 + 1024), 16, 0, 0); \
        __builtin_amdgcn_global_load_lds((const unsigned*)(Vg + to_ + gv[0]), (LAS unsigned*)(lds + (bo) + OFF_V + wid * 2048), 16, 0, 0); \
        __builtin_amdgcn_global_load_lds((const unsigned*)(Vg + to_ + gv[1]), (LAS unsigned*)(lds + (bo) + OFF_V + wid * 2048 + 1024), 16, 0, 0); \
        if constexpr (MODE == 1) __builtin_amdgcn_global_load_lds((const unsigned*)(Krg + (size_t)(j) * (64 * 128) + gkr), (LAS unsigned*)(lds + (bo) + OFF_KR + wid * 1024), 16, 0, 0); } while (0)
    float m_reg = -1e30f, l_reg = 0.f; f32x16 o[4] = {};
    LAS float* li_l = (LAS float*)(lds + OFF_WS) + wid * 64; LAS float* al_l = li_l + 32;
    const LAS float* biasL = (const LAS float*)(lds + OFF_BIAS);
    if constexpr (MODE == 0) { if (tid < 320) ((LAS float*)(lds + OFF_BIAS))[tid] = relb[tid] * LOG2E; }
    int kb[8], krb[4];
#pragma unroll
    for (int dd = 0; dd < 4; ++dd) { kb[dd] = OFF_KN + KSWZ(r32, (dd * 16 + hi * 8) * 2); kb[4 + dd] = OFF_KN + KSWZ(r32, 128 + (dd * 16 + hi * 8) * 2); krb[dd] = OFF_KR + KRSWZ(r32, dd * 32 + hi * 16); }
    const unsigned vb0 = (unsigned)(uintptr_t)lds + OFF_V + v_rd_base(lane);
    constexpr int NDMA = MODE ? 5 : 4;
    ATT_STAGE(j_lo, 0);
    if (NTL > 1) { ATT_STAGE(j_lo + 1, BUFB); asm volatile("s_waitcnt vmcnt(%0)" :: "i"(NDMA) : "memory"); } else VM_WAIT();
    __syncthreads();
    int bo = 0, bo2 = 2 * BUFB;
    for (int t = 0; t < NTL; ++t) {
        const int j = j_lo + t;
        if (t + 2 < NTL) ATT_STAGE(j + 2, bo2);
        const bool act = MODE ? (j <= cw) : (j <= cw && j >= cw - 8);
        if (act) {
            f32x16 p0 = {}, p1 = {};
            { bf16x8 kf[2][2];
              unsigned kad[8], krad[4];
#pragma unroll
              for (int dd = 0; dd < 4; ++dd) { kad[dd] = (unsigned)(uintptr_t)lds + (unsigned)bo + (unsigned)kb[dd]; kad[4 + dd] = (unsigned)(uintptr_t)lds + (unsigned)bo + (unsigned)kb[4 + dd]; krad[dd] = (unsigned)(uintptr_t)lds + (unsigned)bo + (unsigned)krb[dd]; }
#define ATT_KRD(dst, ad, off) asm volatile("ds_read_b128 %0, %1 offset:%2" : "=&v"(dst) : "v"(ad), "i"(off) : "memory")
#define ATT_KLD(d0_, s_) do { if ((d0_) < 8) { ATT_KRD(kf[s_][0], kad[(d0_) & 7], 0); ATT_KRD(kf[s_][1], kad[(d0_) & 7], 32 * 256); } \
                                  else { ATT_KRD(kf[s_][0], krad[((d0_) - 8) & 3], 0); ATT_KRD(kf[s_][1], krad[((d0_) - 8) & 3], 32 * 128); } } while (0)
              ATT_KLD(0, 0);
#pragma unroll
              for (int d0 = 0; d0 < ND; ++d0) {
                  if (d0 + 1 < ND) { ATT_KLD(d0 + 1, (d0 + 1) & 1); asm volatile("s_waitcnt lgkmcnt(2)" ::: "memory"); } else { asm volatile("s_waitcnt lgkmcnt(0)" ::: "memory"); }
                  __builtin_amdgcn_sched_barrier(0);
                  p0 = __builtin_amdgcn_mfma_f32_32x32x16_bf16(kf[d0 & 1][0], qr[d0], p0, 0, 0, 0); p1 = __builtin_amdgcn_mfma_f32_32x32x16_bf16(kf[d0 & 1][1], qr[d0], p1, 0, 0, 0);
                  __builtin_amdgcn_sched_barrier(0); }
#undef ATT_KLD
#undef ATT_KRD
            }
            if constexpr (MODE == 0) {
                const int dc = cw - j;
                if (dc >= 5) { const float bc = biasL[319];
#pragma unroll
                    for (int r = 0; r < 16; ++r) { p0[r] += bc; p1[r] += bc; } }
                else { const int base = 64 * dc + 32 * (wid & 1) + r32 - 4 * hi;
#pragma unroll
                    for (int r = 0; r < 16; ++r) { const int rel0 = base - ((r & 3) + 8 * (r >> 2)); int i0 = rel0 < -63 ? -63 : rel0; i0 = i0 > 256 ? 256 : i0; int i1 = rel0 - 32 < -63 ? -63 : rel0 - 32; i1 = i1 > 256 ? 256 : i1;
                        p0[r] += biasL[i0 + 63]; p1[r] += biasL[i1 + 63]; } }
            }
            float pmax = p0[0];
#pragma unroll
            for (int r = 1; r < 16; ++r) pmax = fmaxf(pmax, p0[r]);
#pragma unroll
            for (int r = 0; r < 16; ++r) pmax = fmaxf(pmax, p1[r]);
            { auto rr = __builtin_amdgcn_permlane32_swap(__float_as_uint(pmax), __float_as_uint(pmax), false, false); pmax = fmaxf(__uint_as_float(rr[0]), __uint_as_float(rr[1])); }
            float mn, alpha;
            if (__all((pmax - m_reg) <= THR)) { mn = m_reg; alpha = 1.f; }
            else { mn = fmaxf(m_reg, pmax); alpha = __builtin_amdgcn_exp2f(m_reg - mn); m_reg = mn; }
#pragma unroll
            for (int r = 0; r < 16; ++r) { p0[r] = __builtin_amdgcn_exp2f(p0[r] - mn); p1[r] = __builtin_amdgcn_exp2f(p1[r] - mn); }
            float ps = 0.f;
#pragma unroll
            for (int r = 0; r < 16; ++r) ps += p0[r];
#pragma unroll
            for (int r = 0; r < 16; ++r) ps += p1[r];
            { auto rr = __builtin_amdgcn_permlane32_swap(__float_as_uint(ps), __float_as_uint(ps), false, false); ps = __uint_as_float(rr[0]) + __uint_as_float(rr[1]); }
            l_reg = l_reg * alpha + ps;
            bf16x8 pa0, pa1, pa2, pa3;
#define ATT_PK4(P, B_, OUT) do { unsigned a0 = cvtpk(P[B_+0], P[B_+1]), a1 = cvtpk(P[B_+2], P[B_+3]); unsigned b0 = cvtpk(P[B_+4], P[B_+5]), b1 = cvtpk(P[B_+6], P[B_+7]); \
        auto r0 = __builtin_amdgcn_permlane32_swap(a0, b0, false, false); auto r1 = __builtin_amdgcn_permlane32_swap(a1, b1, false, false); \
        v4u w = {r0[0], r1[0], r0[1], r1[1]}; OUT = __builtin_bit_cast(bf16x8, w); } while (0)
            ATT_PK4(p0, 0, pa0); ATT_PK4(p0, 8, pa1); ATT_PK4(p1, 0, pa2); ATT_PK4(p1, 8, pa3);
#undef ATT_PK4
            if (__any(alpha < 1.f)) { if (hi == 0) al_l[r32] = alpha; LDS_WAIT();
#pragma unroll
                for (int r = 0; r < 16; ++r) { const float a = al_l[crow(r, hi)];
#pragma unroll
                    for (int d = 0; d < 4; ++d) o[d][r] *= a; } }
            const unsigned vb = vb0 + (unsigned)bo;
#define ATT_TRRD(dst, off) asm volatile("ds_read_b64_tr_b16 %0, %1 offset:%2" : "=&v"(dst) : "v"(vb), "i"(off) : "memory")
#define ATT_VLD(d0, L) do { constexpr int b_ = (d0) * 512; ATT_TRRD(L[0], b_); ATT_TRRD(L[4], b_ + 2048); ATT_TRRD(L[1], b_ + 4096); ATT_TRRD(L[5], b_ + 6144); ATT_TRRD(L[2], b_ + 8192); ATT_TRRD(L[6], b_ + 10240); ATT_TRRD(L[3], b_ + 12288); ATT_TRRD(L[7], b_ + 14336); } while (0)
#define ATT_PVM(d0, L) do { \
        o[d0] = __builtin_amdgcn_mfma_f32_32x32x16_bf16(pa0, (bf16x8){L[0][0], L[0][1], L[0][2], L[0][3], L[4][0], L[4][1], L[4][2], L[4][3]}, o[d0], 0, 0, 0); \
        o[d0] = __builtin_amdgcn_mfma_f32_32x32x16_bf16(pa1, (bf16x8){L[1][0], L[1][1], L[1][2], L[1][3], L[5][0], L[5][1], L[5][2], L[5][3]}, o[d0], 0, 0, 0); \
        o[d0] = __builtin_amdgcn_mfma_f32_32x32x16_bf16(pa2, (bf16x8){L[2][0], L[2][1], L[2][2], L[2][3], L[6][0], L[6][1], L[6][2], L[6][3]}, o[d0], 0, 0, 0); \
        o[d0] = __builtin_amdgcn_mfma_f32_32x32x16_bf16(pa3, (bf16x8){L[3][0], L[3][1], L[3][2], L[3][3], L[7][0], L[7][1], L[7][2], L[7][3]}, o[d0], 0, 0, 0); } while (0)
            { s16x4 va[8], vb_[8];
              ATT_VLD(0, va);
              ATT_VLD(1, vb_); asm volatile("s_waitcnt lgkmcnt(8)" ::: "memory"); __builtin_amdgcn_sched_barrier(0); ATT_PVM(0, va); __builtin_amdgcn_sched_barrier(0);
              ATT_VLD(2, va);  asm volatile("s_waitcnt lgkmcnt(8)" ::: "memory"); __builtin_amdgcn_sched_barrier(0); ATT_PVM(1, vb_); __builtin_amdgcn_sched_barrier(0);
              ATT_VLD(3, vb_); asm volatile("s_waitcnt lgkmcnt(8)" ::: "memory"); __builtin_amdgcn_sched_barrier(0); ATT_PVM(2, va); __builtin_amdgcn_sched_barrier(0);
              asm volatile("s_waitcnt lgkmcnt(0)" ::: "memory"); __builtin_amdgcn_sched_barrier(0); ATT_PVM(3, vb_); }
#undef ATT_VLD
#undef ATT_PVM
#undef ATT_TRRD
        }
        if (t + 2 < NTL) asm volatile("s_waitcnt vmcnt(%0)" :: "i"(NDMA) : "memory"); else VM_WAIT();
        asm volatile("s_waitcnt lgkmcnt(0)" ::: "memory"); __builtin_amdgcn_s_barrier(); asm volatile("" ::: "memory");
        bo = (bo == 2 * BUFB) ? 0 : bo + BUFB; bo2 = (bo2 == 2 * BUFB) ? 0 : bo2 + BUFB;
    }
    if (hi == 0) li_l[r32] = l_reg; LDS_WAIT();
    { LAS unsigned char* ost = lds + wid * 4096;
#pragma unroll
      for (int r = 0; r < 16; ++r) { const int orow = crow(r, hi); const float rl = __builtin_amdgcn_rcpf(li_l[orow]) * ACT_Y;
#pragma unroll
          for (int d0 = 0; d0 < 4; ++d0) { const float v = o[d0][r] * rl; ost[orow * 128 + d0 * 32 + r32] = (unsigned char)(__builtin_amdgcn_cvt_pk_fp8_f32(v, v, 0, false) & 0xff); } }
      LDS_WAIT();
      unsigned char* Ow = (unsigned char*)O + (size_t)(tb + 256 * qb + 32 * wid) * 1024 + h * 128;
#pragma unroll
      for (int k = 0; k < 4; ++k) { const int idx = lane + 64 * k, row = idx >> 3, ch = idx & 7;
          const v4u val = *(const LAS v4u*)(lds + wid * 4096 + row * 128 + ch * 16);
          *(v4u*)(Ow + (size_t)row * 1024 + ch * 16) = val; } }
    __syncthreads();
#undef ATT_STAGE
}
#undef KSWZ
#undef KRSWZ
}


struct Args {
    const float *x, *c; const int* positions;
    const float *w_ada, *b_ada, *w_in, *b_in, *rel_bias, *q_norm_g, *kv_norm_g, *w_uq, *w_ukv, *w_pa, *w_pb, *w_o, *ln1_g, *ln1_b, *peer_wq, *peer_keys, *peer_u, *peer_v, *ln2_g, *ln2_b;
    float* out; unsigned char* ws; int ph_lo, ph_hi;
};

template <class SrcCol>
__device__ __forceinline__ void transpose_item(const float* __restrict__ W, int K, int N, bf16* __restrict__ WT, int nblk, LAS float* scr, int item, int lane, SrcCol srccol, const float* __restrict__ kscale, float* amax = nullptr) {
    const int kb = item / nblk, nb = item % nblk, k0 = 64 * kb, n0 = 32 * nb;
    const int scol = srccol(n0 + (lane & 31));
    float am = 0.f, vv[32];
    { const float* wp = W + (size_t)(k0 + (lane >> 5)) * N + scol;
#pragma unroll
      for (int i = 0; i < 32; ++i) vv[i] = __builtin_nontemporal_load(wp + (size_t)(2 * i) * N); }
#pragma unroll
    for (int i = 0; i < 32; ++i) { const int kk = 2 * i + (lane >> 5); float v = vv[i]; if (kscale) v *= kscale[k0 + kk]; scr[kk * 33 + (lane & 31)] = v; am = fmaxf(am, fabsf(v)); }
    if (amax) *amax = fmaxf(*amax, am);
    LDS_WAIT(); asm volatile("" ::: "memory");
    const int c = lane & 7;
#pragma unroll
    for (int j = 0; j < 4; ++j) { const int n = (lane >> 3) + 8 * j; const LAS float* s = scr + (8 * c) * 33 + n;
        v4u o; o.x = pk2(s[0 * 33], s[1 * 33]); o.y = pk2(s[2 * 33], s[3 * 33]); o.z = pk2(s[4 * 33], s[5 * 33]); o.w = pk2(s[6 * 33], s[7 * 33]);
        *(v4u*)(WT + (size_t)(n0 + n) * K + k0 + 8 * c) = o; }
    LDS_WAIT(); asm volatile("" ::: "memory");
}
struct ColIn { __device__ int operator()(int n) const { return n < 4096 ? n : n + 64; } };
struct ColKr { __device__ int operator()(int n) const { return 4096 + (n >> 1) + 32 * (n & 1); } };
struct ColUq { __device__ int operator()(int n) const { if (n < 1024) return (n >> 7) * 192 + (n & 127); const int r = n - 1024, hh = r >> 6, o = r & 63; return hh * 192 + 128 + (o >> 1) + 32 * (o & 1); } };
struct ColUkv { __device__ int operator()(int n) const { return n < 1024 ? (n >> 7) * 256 + (n & 127) : ((n - 1024) >> 7) * 256 + 128 + (n & 127); } };
struct ColId { __device__ int operator()(int n) const { return n; } };

__device__ __forceinline__ void p0_prologue(const Args& A, LAS unsigned char* lds, int tid, int lane, int wave, int vcu, int G) {
    unsigned char* ws = A.ws;
    {
        LAS float* sl = (LAS float*)lds;
        LAS float* red = (LAS float*)(lds + 65536);
        for (int i = tid; i < NB * DM; i += NWAVES * 64) { const int b = i >> 11, k = i & 2047; const float v = A.c[i]; sl[k * 8 + b] = v / (1.0f + __expf(-v)); }
        __syncthreads();
        float* mod = (float*)(ws + WS_MOD);
        for (int cb = blockIdx.x; cb < 256; cb += G) {
            const int r = lane / 12, c4 = lane % 12; const int col = cb * 48 + c4 * 4;
            float acc[8][4];
#pragma unroll
            for (int b = 0; b < 8; ++b)
#pragma unroll
                for (int i = 0; i < 4; ++i) acc[b][i] = 0.f;
            if (r < 5) {
#pragma unroll 4
                for (int kk = r; kk < 256; kk += 5) { const int k = wave * 256 + kk;
                    const f32x4 wv = __builtin_nontemporal_load((const f32x4*)(A.w_ada + (size_t)k * (6 * DM) + col));
                    const f32x4 s0 = *(const LAS f32x4*)(sl + k * 8), s1 = *(const LAS f32x4*)(sl + k * 8 + 4);
#pragma unroll
                    for (int i = 0; i < 4; ++i) { acc[0][i] += s0[0] * wv[i]; acc[1][i] += s0[1] * wv[i]; acc[2][i] += s0[2] * wv[i]; acc[3][i] += s0[3] * wv[i];
                                                  acc[4][i] += s1[0] * wv[i]; acc[5][i] += s1[1] * wv[i]; acc[6][i] += s1[2] * wv[i]; acc[7][i] += s1[3] * wv[i]; } }
#pragma unroll
                for (int i = 0; i < 4; ++i)
#pragma unroll
                    for (int b = 0; b < 8; ++b) red[((wave * 5 + r) * 48 + c4 * 4 + i) * 8 + b] = acc[b][i];
            }
            __syncthreads();
            if (tid < 384) { const int cc = tid >> 3, b = tid & 7; float s = 0.f;
                for (int p = 0; p < 40; ++p) s += red[(p * 48 + cc) * 8 + b];
                const int col2 = cb * 48 + cc; mod[(size_t)b * (6 * DM) + col2] = s + A.b_ada[col2]; }
            __syncthreads();
        }
    }
    const int gw = vcu * NWAVES + wave, NGW = G * NWAVES;
    {
        LAS float* scr = (LAS float*)(lds + wave * 16384);
        constexpr int I_IN = 32 * 256, I_KR = 32 * 2, I_UQ = 8 * 48, I_UKV = 8 * 64, I_PA = 16 * 64, I_PB = 16 * 64, I_O = 32 * 64;
        constexpr int NITEMS = I_IN + I_KR + I_UQ + I_UKV + I_PA + I_PB + I_O;
        float amx[6] = {0.f, 0.f, 0.f, 0.f, 0.f, 0.f};
        for (int it = gw; it < NITEMS; it += NGW) {
            int r = it;
            if (r < I_IN) { transpose_item(A.w_in, 2048, 8256, (bf16*)(ws + WS_WIN), 256, scr, r, lane, ColIn(), nullptr, &amx[0]); continue; } r -= I_IN;
            if (r < I_KR) { transpose_item(A.w_in, 2048, 8256, (bf16*)(ws + WS_WKR), 2, scr, r, lane, ColKr(), nullptr); continue; } r -= I_KR;
            if (r < I_UQ) { transpose_item(A.w_uq, 512, 1536, (bf16*)(ws + WS_WUQ), 48, scr, r, lane, ColUq(), A.q_norm_g, &amx[4]); continue; } r -= I_UQ;
            if (r < I_UKV) { transpose_item(A.w_ukv, 512, 2048, (bf16*)(ws + WS_WUKV), 64, scr, r, lane, ColUkv(), A.kv_norm_g, &amx[5]); continue; } r -= I_UKV;
            if (r < I_PA) { transpose_item(A.w_pa, 1024, 2048, (bf16*)(ws + WS_WPA), 64, scr, r, lane, ColId(), nullptr, &amx[1]); continue; } r -= I_PA;
            if (r < I_PB) { transpose_item(A.w_pb, 1024, 2048, (bf16*)(ws + WS_WPB), 64, scr, r, lane, ColId(), nullptr, &amx[2]); continue; } r -= I_PB;
            transpose_item(A.w_o, 2048, 2048, (bf16*)(ws + WS_WO), 64, scr, r, lane, ColId(), nullptr, &amx[3]);
        }
        { v4u* z = (v4u*)(ws + WS_WKR + (size_t)64 * 2048 * 2); const int n16 = 192 * 2048 * 2 / 16;
          for (int i = blockIdx.x * (NWAVES * 64) + tid; i < n16; i += G * NWAVES * 64) z[i] = (v4u){0u, 0u, 0u, 0u}; }
#pragma unroll
        for (int m = 0; m < 6; ++m) {
            amx[m] = wave_max(amx[m]); }
        if (lane == 0) {
#pragma unroll
            for (int m = 0; m < 6; ++m) scr[2112 + m] = amx[m]; }
    }
    __syncthreads();
    if (tid < 6) { float am = 0.f;
#pragma unroll
        for (int w = 0; w < NWAVES; ++w) am = fmaxf(am, ((LAS float*)(lds + w * 16384))[2112 + tid]);
        atomicMax((unsigned*)(ws + WS_CTL) + CW_WMAX + tid, __float_as_uint(am)); }
    __syncthreads();
    {
        LAS float* lk = (LAS float*)lds;
        LAS float* lw = (LAS float*)(lds + 128 * 129 * 4);
        bf16* wsk = (bf16*)(ws + WS_WSK);
        for (int it = vcu; it < 16 * 64; it += G) {
            const int hp = it >> 6, k0 = (it & 63) * 32;
            for (int idx = tid; idx < 16384; idx += NWAVES * 64) lk[(idx >> 7) * 129 + (idx & 127)] = A.peer_keys[(size_t)hp * 16384 + idx];
            for (int idx = tid; idx < 4096; idx += NWAVES * 64) lw[idx] = A.peer_wq[(size_t)(k0 + (idx >> 7)) * 2048 + hp * 128 + (idx & 127)];
            __syncthreads();
            const int n = tid & 127, kq = tid >> 7; float acc[8];
#pragma unroll
            for (int j = 0; j < 8; ++j) acc[j] = 0.f;
#pragma unroll 2
            for (int c4 = 0; c4 < 32; ++c4) { const float k0v = lk[n * 129 + 4 * c4], k1v = lk[n * 129 + 4 * c4 + 1], k2v = lk[n * 129 + 4 * c4 + 2], k3v = lk[n * 129 + 4 * c4 + 3];
#pragma unroll
                for (int j = 0; j < 8; ++j) { const f32x4 w4 = *(const LAS f32x4*)(lw + (kq * 8 + j) * 128 + 4 * c4); acc[j] += (k0v * w4[0] + k1v * w4[1]) + (k2v * w4[2] + k3v * w4[3]); } }
            v4u o; o.x = pk2(acc[0], acc[1]); o.y = pk2(acc[2], acc[3]); o.z = pk2(acc[4], acc[5]); o.w = pk2(acc[6], acc[7]);
            *(v4u*)(wsk + (size_t)(hp * 128 + n) * 2048 + k0 + kq * 8) = o;
            __syncthreads();
        }
    }
#pragma unroll 2
    for (int rw = gw; rw < 2 * 16384; rw += NGW) {
        const float* src = (rw < 16384 ? A.peer_u : A.peer_v) + (size_t)(rw & 16383) * 2048;
        unsigned char* dst = ws + (rw < 16384 ? WS_UT : WS_VT) + (size_t)(rw & 16383) * 1024;
        f32x4 v[8]; float am = 0.f;
#pragma unroll
        for (int q = 0; q < 8; ++q) { v[q] = __builtin_nontemporal_load((const f32x4*)(src + q * 256 + lane * 4)); am = fmaxf(am, fmaxf(fmaxf(fabsf(v[q][0]), fabsf(v[q][1])), fmaxf(fabsf(v[q][2]), fabsf(v[q][3])))); }
        if (rw < 16384) {
            float ss = 0.f;
#pragma unroll
            for (int q = 0; q < 8; ++q) ss += (v[q][0] * v[q][0] + v[q][1] * v[q][1]) + (v[q][2] * v[q][2] + v[q][3] * v[q][3]);
            ss = wave_sum(ss);
            const float step = 0.3352f * sqrtf(ss * (1.0f / 2048.0f)), inv = ss > 0.f ? 1.0f / step : 0.f;
            if (lane == 0) ((float*)(ws + WS_TSCALE))[rw] = step;
#pragma unroll
            for (int q = 0; q < 8; ++q) { unsigned h = 0u;
#pragma unroll
                for (int m = 0; m < 4; ++m) { int qi = (int)floorf(v[q][m] * inv); qi = qi < -8 ? -8 : (qi > 7 ? 7 : qi); h |= ((unsigned)qi & 15u) << (4 * m); }
                *(unsigned short*)(ws + WS_UT + (size_t)q * UT_SLICE + (size_t)rw * 128 + lane * 2) = (unsigned short)h; }
            continue;
        }
        am = wave_max(am);
        const float sc = am > 0.f ? 6.0f / am : 1.0f;
        if (lane == 0) ((float*)(ws + WS_TSCALE))[rw] = am > 0.f ? am / 6.0f : 1.0f;
        v4u o;
#pragma unroll
        for (int k = 0; k < 4; ++k) { const f32x4 f0 = v[2 * k] * sc, f1 = v[2 * k + 1] * sc; unsigned w = 0u;
            w = __builtin_amdgcn_cvt_scalef32_pk_fp4_f32(w, f0[0], f0[1], 1.0f, 0); w = __builtin_amdgcn_cvt_scalef32_pk_fp4_f32(w, f0[2], f0[3], 1.0f, 1);
            w = __builtin_amdgcn_cvt_scalef32_pk_fp4_f32(w, f1[0], f1[1], 1.0f, 2); w = __builtin_amdgcn_cvt_scalef32_pk_fp4_f32(w, f1[2], f1[3], 1.0f, 3); o[k] = w; }
#pragma unroll
        for (int k = 0; k < 4; ++k) {
            *(unsigned short*)(ws + WS_VT + (size_t)(2 * k) * UT_SLICE + (size_t)(rw & 16383) * 128 + lane * 2) = (unsigned short)(o[k] & 0xffffu);
            *(unsigned short*)(ws + WS_VT + (size_t)(2 * k + 1) * UT_SLICE + (size_t)(rw & 16383) * 128 + lane * 2) = (unsigned short)(o[k] >> 16); }
    }
    {
        float* cs = (float*)(ws + WS_CS);
        for (int i = blockIdx.x * (NWAVES * 64) + tid; i < TOK * 32; i += G * NWAVES * 64) { const int t = i >> 5, j = i & 31;
            const float inv = powf(10000.0f, -(float)(2 * j) / 64.0f); const float ang = (float)A.positions[t] * inv;
            cs[(size_t)i * 2] = cosf(ang); cs[(size_t)i * 2 + 1] = sinf(ang); }
        float* bs = (float*)(ws + WS_BIAS);
        for (int i = blockIdx.x * (NWAVES * 64) + tid; i < 8192 + 64; i += G * NWAVES * 64) bs[i] = i < 8192 ? A.b_in[i < 4096 ? i : i + 64] : A.b_in[4096 + ((i - 8192) >> 1) + 32 * ((i - 8192) & 1)];
    }
}

__device__ __forceinline__ unsigned pk4_fp8(float a, float b, float c, float d) { int w = __builtin_amdgcn_cvt_pk_fp8_f32(a, b, 0, false); w = __builtin_amdgcn_cvt_pk_fp8_f32(c, d, w, true); return (unsigned)w; }
__device__ __forceinline__ void p1_w8(const unsigned char* srcb, unsigned char* dstb, int n8, float wq, int lane, int gw, int NGW) {
    const v4u* src = (const v4u*)srcb; v2u* dst = (v2u*)dstb;
    for (int i = gw * 64 + lane; i < n8; i += NGW * 64) { const v4u w = src[i]; v2u o;
        o.x = pk4_fp8(bflo(w.x) * wq, bfhi(w.x) * wq, bflo(w.y) * wq, bfhi(w.y) * wq); o.y = pk4_fp8(bflo(w.z) * wq, bfhi(w.z) * wq, bflo(w.w) * wq, bfhi(w.w) * wq); dst[i] = o; }
}
__device__ __forceinline__ void p1_modulate(const Args& A, int lane, int gw, int NGW) {
    const float* mod = (const float*)(A.ws + WS_MOD); unsigned* H8 = (unsigned*)(A.ws + WS_H8); float* hsc = (float*)(A.ws + WS_HSC);
    constexpr int R = 4;
    for (int t0 = gw * R; t0 < TOK; t0 += NGW * R) { const int b = t0 >> 12; const float* sh = mod + (size_t)b * (6 * DM); const float* sc = sh + DM;
        f32x4 hv[R][8];
#pragma unroll
        for (int r = 0; r < R; ++r)
#pragma unroll
            for (int j = 0; j < 8; ++j) hv[r][j] = __builtin_nontemporal_load((const f32x4*)(A.x + (size_t)(t0 + r) * DM + j * 256 + lane * 4));
        float am[R];
#pragma unroll
        for (int r = 0; r < R; ++r) am[r] = 0.f;
#pragma unroll
        for (int j = 0; j < 8; ++j) { const int c = j * 256 + lane * 4; const f32x4 s1 = *(const f32x4*)(sc + c) + 1.0f, s0 = *(const f32x4*)(sh + c);
#pragma unroll
            for (int r = 0; r < R; ++r) { hv[r][j] = hv[r][j] * s1 + s0; am[r] = fmaxf(am[r], fmaxf(fmaxf(fabsf(hv[r][j][0]), fabsf(hv[r][j][1])), fmaxf(fabsf(hv[r][j][2]), fabsf(hv[r][j][3])))); } }
#pragma unroll
        for (int r = 0; r < R; ++r) {
            am[r] = wave_max(am[r]);
            const float q = am[r] > 0.f ? 440.0f / am[r] : 1.0f;
            if (lane == 0) hsc[t0 + r] = am[r] > 0.f ? am[r] * (1.0f / 440.0f) : 1.0f;
#pragma unroll
            for (int j = 0; j < 8; ++j) { const int c = j * 256 + lane * 4; H8[((size_t)(t0 + r) * DM + c) >> 2] = pk4_fp8(hv[r][j][0] * q, hv[r][j][1] * q, hv[r][j][2] * q, hv[r][j][3] * q); } } }
    { const unsigned* wm = (const unsigned*)(A.ws + WS_CTL) + CW_WMAX;
      p1_w8(A.ws + WS_WIN, A.ws + WS_W8, 8192 * 2048 / 8, 440.0f / __uint_as_float(wm[0]), lane, gw, NGW);
      p1_w8(A.ws + WS_WKR, A.ws + WS_WKR8, 256 * 2048 / 8, 440.0f / __uint_as_float(wm[0]), lane, gw, NGW);
      p1_w8(A.ws + WS_WPA, A.ws + WS_WPA8, 2048 * 1024 / 8, 440.0f / __uint_as_float(wm[1]), lane, gw, NGW);
      p1_w8(A.ws + WS_WPB, A.ws + WS_WPB8, 2048 * 1024 / 8, 440.0f / __uint_as_float(wm[2]), lane, gw, NGW);
      p1_w8(A.ws + WS_WO, A.ws + WS_WO8, 2048 * 2048 / 8, 440.0f / __uint_as_float(wm[3]), lane, gw, NGW);
      p1_w8(A.ws + WS_WUQ, A.ws + WS_WUQ8, 1536 * 512 / 8, 440.0f / __uint_as_float(wm[4]), lane, gw, NGW);
      p1_w8(A.ws + WS_WUKV, A.ws + WS_WUKV8, 2048 * 512 / 8, 440.0f / __uint_as_float(wm[5]), lane, gw, NGW); }
}
__device__ __forceinline__ void p7_ln1(const Args& A, int lane, int gw, int NGW) {
    const float* mod = (const float*)(A.ws + WS_MOD); bf16* H = (bf16*)(A.ws + WS_H); float* st = (float*)(A.ws + WS_LN1);
    constexpr int R = 4;
    for (int t0 = gw * R; t0 < TOK; t0 += NGW * R) { const int b = t0 >> 12; const float* sh = mod + ((size_t)b * 6 + 3) * DM; const float* sc = sh + DM;
        f32x4 v[R][8];
#pragma unroll
        for (int r = 0; r < R; ++r)
#pragma unroll
            for (int j = 0; j < 8; ++j) { const v2u w = *(const v2u*)((const bf16*)(A.ws + WS_U1B) + (size_t)(t0 + r) * DM + j * 256 + lane * 4); v[r][j] = (f32x4){bflo(w.x), bfhi(w.x), bflo(w.y), bfhi(w.y)}; }
        float rstd[R], am[R];
#pragma unroll
        for (int r = 0; r < R; ++r) am[r] = 0.f;
#pragma unroll
        for (int r = 0; r < R; ++r) { float s = 0.f;
#pragma unroll
            for (int j = 0; j < 8; ++j) s += (v[r][j][0] + v[r][j][1]) + (v[r][j][2] + v[r][j][3]);
            const float mean = wave_sum(s) * (1.0f / DM); float q = 0.f;
#pragma unroll
            for (int j = 0; j < 8; ++j) { v[r][j] = v[r][j] - mean; q += (v[r][j][0] * v[r][j][0] + v[r][j][1] * v[r][j][1]) + (v[r][j][2] * v[r][j][2] + v[r][j][3] * v[r][j][3]); }
            rstd[r] = 1.0f / sqrtf(wave_sum(q) * (1.0f / DM) + LN_EPS);
            if (lane == 0) { st[(size_t)(t0 + r) * 2] = mean; st[(size_t)(t0 + r) * 2 + 1] = rstd[r]; } }
#pragma unroll
        for (int j = 0; j < 8; ++j) { const int c = j * 256 + lane * 4; const f32x4 g = *(const f32x4*)(A.ln1_g + c), bb = *(const f32x4*)(A.ln1_b + c), s1 = *(const f32x4*)(sc + c), s0 = *(const f32x4*)(sh + c);
#pragma unroll
            for (int r = 0; r < R; ++r) { const f32x4 x1 = v[r][j] * rstd[r] * g + bb; const f32x4 hv = x1 * (s1 + 1.0f) + s0; v2u o; o.x = pk2(hv[0], hv[1]); o.y = pk2(hv[2], hv[3]); *(v2u*)(H + (size_t)(t0 + r) * DM + c) = o;
                v[r][j] = hv; am[r] = fmaxf(am[r], fmaxf(fmaxf(fabsf(hv[0]), fabsf(hv[1])), fmaxf(fabsf(hv[2]), fabsf(hv[3])))); } }
#pragma unroll
        for (int r = 0; r < R; ++r) {
            am[r] = wave_max(am[r]);
            const float inv = am[r] > 0.f ? 119.0f / am[r] : 0.f; int ssum = 0;
#pragma unroll
            for (int j = 0; j < 8; ++j) { unsigned hh = 0u, ll = 0u;
#pragma unroll
                for (int m = 0; m < 4; ++m) { const int x8 = (int)rintf(v[r][j][m] * inv); const int lo = ((x8 + 8) & 15) - 8, hi = (x8 - lo) >> 4; ssum += x8; hh |= ((unsigned)hi & 15u) << (4 * m); ll |= ((unsigned)lo & 15u) << (4 * m); }
                *(unsigned short*)(A.ws + WS_XH + (size_t)(t0 + r) * 1024 + j * 128 + lane * 2) = (unsigned short)hh;
                *(unsigned short*)(A.ws + WS_XL + (size_t)(t0 + r) * 1024 + j * 128 + lane * 2) = (unsigned short)ll; }
            ssum = wave_sum_int(ssum);
            if (lane == 0) { ((float*)(A.ws + WS_SX))[t0 + r] = am[r] * (1.0f / 119.0f); ((int*)(A.ws + WS_S8))[t0 + r] = ssum; } } }
}


__device__ __forceinline__ float max2f(float a, float b) { float r; asm("v_max_f32_e32 %0, %1, %2" : "=v"(r) : "v"(a), "v"(b)); return r; }
__device__ __forceinline__ float min2f(float a, float b) { float r; asm("v_min_f32_e32 %0, %1, %2" : "=v"(r) : "v"(a), "v"(b)); return r; }
#define INS16(L, x) do { _Pragma("unroll") for (int k_ = 0; k_ < 16; ++k_) { const float h_ = max2f(L[k_], x); x = min2f(L[k_], x); L[k_] = h_; } } while (0)
__device__ __forceinline__ void topk16_128(const float* __restrict__ src, float (&L)[16]) {
#pragma unroll
    for (int k = 0; k < 16; ++k) L[k] = -INFINITY;
#pragma unroll 4
    for (int i = 0; i < 32; ++i) { const f32x4 v = *(const f32x4*)(src + 4 * i);
#pragma unroll
        for (int e = 0; e < 4; ++e) { float x = __uint_as_float((__float_as_uint(v[e]) & ~127u) | (unsigned)(4 * i + e)); INS16(L, x); } }
}
__device__ __forceinline__ float dot2bf(unsigned a, unsigned b, float acc) { return __builtin_amdgcn_fdot2_f32_bf16(__builtin_bit_cast(bf16x2_t, a), __builtin_bit_cast(bf16x2_t, b), acc, false); }
__device__ __forceinline__ float dot8(const v4u a, const v4u b, float acc) {
    const unsigned a0 = a[0], a1 = a[1], a2 = a[2], a3 = a[3], b0 = b[0], b1 = b[1], b2 = b[2], b3 = b[3];
    acc = dot2bf(a0, b0, acc); acc = dot2bf(a1, b1, acc); acc = dot2bf(a2, b2, acc); acc = dot2bf(a3, b3, acc);
    return acc;
}

constexpr int RB = 8;
typedef float f32x2g __attribute__((ext_vector_type(2)));
#define P9_LOAD(BUF, TAB, EV, L0) do { _Pragma("unroll") for (int i_ = 0; i_ < RB; ++i_) { const int id_ = __builtin_amdgcn_readlane((EV), (L0) + i_); \
        BUF[i_] = ((const v4u*)((TAB) + (size_t)id_ * 1024))[lane]; } } while (0)
__device__ __forceinline__ float gelu_as(float v) {
    const float av = fabsf(v), t = __builtin_amdgcn_rcpf(av * 0.2316418882f + 1.0f);
    float q = t * 0.5307027145f + (-0.7265760135f); q = q * t + 0.7107068705f; q = q * t + (-0.142248368f); q = q * t + 0.127414796f; q = q * t;
    const float e = __builtin_amdgcn_exp2f((v * v) * (-0.72134752044f)); const float m = v * (q * e);
    return v < 0.f ? m : v - m;
}
typedef __bf16 bf16x2p __attribute__((ext_vector_type(2)));
__device__ __forceinline__ float p9_dot(const v4u d, const v2u (&xq)[8]) {
    float s0 = 0.f, s1 = 0.f;
#pragma unroll
    for (int k = 0; k < 4; ++k) { const unsigned w = d[k]; const unsigned x0 = xq[2 * k][0], x1 = xq[2 * k][1], x2 = xq[2 * k + 1][0], x3 = xq[2 * k + 1][1];
        s0 = __builtin_amdgcn_fdot2_f32_bf16(__builtin_amdgcn_cvt_scalef32_pk_bf16_fp4(w, 1.0f, 0), __builtin_bit_cast(bf16x2p, x0), s0, false);
        s1 = __builtin_amdgcn_fdot2_f32_bf16(__builtin_amdgcn_cvt_scalef32_pk_bf16_fp4(w, 1.0f, 1), __builtin_bit_cast(bf16x2p, x1), s1, false);
        s0 = __builtin_amdgcn_fdot2_f32_bf16(__builtin_amdgcn_cvt_scalef32_pk_bf16_fp4(w, 1.0f, 2), __builtin_bit_cast(bf16x2p, x2), s0, false);
        s1 = __builtin_amdgcn_fdot2_f32_bf16(__builtin_amdgcn_cvt_scalef32_pk_bf16_fp4(w, 1.0f, 3), __builtin_bit_cast(bf16x2p, x3), s1, false); }
    return s0 + s1;
}
__device__ __forceinline__ void p9_axpy(const v4u d, float wgt, f32x2g (&acc)[16]) {
    const f32x2g w2 = {wgt, wgt};
#pragma unroll
    for (int k = 0; k < 4; ++k) { const unsigned w = d[k];
        acc[4 * k]     = __builtin_elementwise_fma(__builtin_amdgcn_cvt_scalef32_pk_f32_fp4(w, 1.0f, 0), w2, acc[4 * k]);
        acc[4 * k + 1] = __builtin_elementwise_fma(__builtin_amdgcn_cvt_scalef32_pk_f32_fp4(w, 1.0f, 1), w2, acc[4 * k + 1]);
        acc[4 * k + 2] = __builtin_elementwise_fma(__builtin_amdgcn_cvt_scalef32_pk_f32_fp4(w, 1.0f, 2), w2, acc[4 * k + 2]);
        acc[4 * k + 3] = __builtin_elementwise_fma(__builtin_amdgcn_cvt_scalef32_pk_f32_fp4(w, 1.0f, 3), w2, acc[4 * k + 3]); }
}
__device__ __forceinline__ float p9_reduce8(const float (&p)[8], int lane) {
    const bool b5 = (lane & 32) != 0, b4 = (lane & 16) != 0, b3 = (lane & 8) != 0; float r[4], s[2];
#pragma unroll
    for (int k = 0; k < 4; ++k) { const float keep = b5 ? p[k + 4] : p[k], send = b5 ? p[k] : p[k + 4]; r[k] = keep + __shfl_xor(send, 32); }
#pragma unroll
    for (int k = 0; k < 2; ++k) { const float keep = b4 ? r[k + 2] : r[k], send = b4 ? r[k] : r[k + 2]; s[k] = keep + __shfl_xor(send, 16); }
    float t; { const float keep = b3 ? s[1] : s[0], send = b3 ? s[0] : s[1]; t = keep + __shfl_xor(send, 8); }
    t += __shfl_xor(t, 4); t += __shfl_xor(t, 2); t += __shfl_xor(t, 1);
    return t;
}
__device__ __forceinline__ void p9a_topk(const Args& A, int lane_in, int gw, int NGW) {
    unsigned char* ws = A.ws; const float* SC = (const float*)(ws + WS_SCORE);
    for (int task = gw; task < TOK / 8; task += NGW) {
        int lane = lane_in; asm volatile("" : "+v"(lane));
        const int tl = lane >> 3, hd = lane & 7; const float* srow = SC + (size_t)(task * 8 + tl) * 2048 + hd * 256;
        float L0[16], L1[16], R[16];
        topk16_128(srow, L0); topk16_128(srow + 128, L1);
#pragma unroll
        for (int k = 0; k < 16; ++k) R[k] = -INFINITY;
#pragma unroll
        for (int i = 0; i < 16; ++i)
#pragma unroll
            for (int j = 0; j < 16; ++j) if ((i + 1) * (j + 1) <= 16) { float x = __uint_as_float((__float_as_uint(L0[i] + L1[j]) & ~255u) | (unsigned)(i * 16 + j)); INS16(R, x); __builtin_amdgcn_sched_barrier(0); }
        const float mx = __uint_as_float(__float_as_uint(R[0]) & ~255u); float ex[16], es = 0.f;
#pragma unroll
        for (int r = 0; r < 16; ++r) { ex[r] = __expf(__uint_as_float(__float_as_uint(R[r]) & ~255u) - mx); es += ex[r]; }
        const float inv = 1.0f / es;
        unsigned idp[8];
#pragma unroll
        for (int r = 0; r < 16; ++r) { const unsigned code = __float_as_uint(R[r]) & 255u, ci = code >> 4, cj = code & 15u; unsigned e1 = 0u, e2 = 0u;
#pragma unroll
            for (int k = 0; k < 16; ++k) { e1 = (ci == (unsigned)k) ? (__float_as_uint(L0[k]) & 127u) : e1; e2 = (cj == (unsigned)k) ? (__float_as_uint(L1[k]) & 127u) : e2; }
            const unsigned e = e1 * 128u + e2; if (r & 1) idp[r >> 1] |= e << 16; else idp[r >> 1] = e; ex[r] *= inv; __builtin_amdgcn_sched_barrier(0); }
        const size_t slot0 = (size_t)(task * 8 + tl) * 128 + hd * 16;
        v4u* ip = (v4u*)(ws + WS_IDS + slot0 * 2); ip[0] = (v4u){idp[0], idp[1], idp[2], idp[3]}; ip[1] = (v4u){idp[4], idp[5], idp[6], idp[7]};
        f32x4* gp = (f32x4*)(ws + WS_GATES + slot0 * 4);
#pragma unroll
        for (int k = 0; k < 4; ++k) gp[k] = (f32x4){ex[4 * k], ex[4 * k + 1], ex[4 * k + 2], ex[4 * k + 3]};
    }
}

typedef int v2i __attribute__((ext_vector_type(2)));
__device__ __forceinline__ int dpp_add8(int v) {
    v += __builtin_amdgcn_update_dpp(0, v, 0xB1, 0xF, 0xF, true);
    v += __builtin_amdgcn_update_dpp(0, v, 0x4E, 0xF, 0xF, true);
    v += __builtin_amdgcn_update_dpp(0, v, 0x141, 0xF, 0xF, true);
    return v;
}
#define P10_IDS(IDW, JP) __builtin_amdgcn_ds_swizzle((int)(IDW), 0x18 | ((JP) << 5))
#define P10_LOAD1(BUF, IDW, HALF, JP) do { const unsigned pr_ = (unsigned)P10_IDS(IDW, (HALF) * 4 + (JP)); \
        BUF[2 * (JP)] = *(const v4u*)(UTx + ((pr_ & 0xffffu) * 128u + s16)); BUF[2 * (JP) + 1] = *(const v4u*)(UTx + ((pr_ >> 16) * 128u + s16)); } while (0)
#define P10_LOAD(BUF, IDW, HALF) do { P10_LOAD1(BUF, IDW, HALF, 0); P10_LOAD1(BUF, IDW, HALF, 1); P10_LOAD1(BUF, IDW, HALF, 2); P10_LOAD1(BUF, IDW, HALF, 3); } while (0)
#define P10_DOTS(BUF, HALF) do { _Pragma("unroll") for (int i_ = 0; i_ < 8; ++i_) { int d1_ = 0, d2_ = 0; \
        _Pragma("unroll") for (int k_ = 0; k_ < 4; ++k_) { d1_ = __builtin_amdgcn_sdot8((int)BUF[i_][k_], (int)xh[k_], d1_, false); d2_ = __builtin_amdgcn_sdot8((int)BUF[i_][k_], (int)xl[k_], d2_, false); } \
        res[(HALF) * 8 + i_] = dpp_add8(d1_ * 16 + d2_); } } while (0)
__device__ __forceinline__ void p10_udot(const Args& A, int lane_in, int wave, int bx, int G) {
    unsigned char* ws = A.ws;
    const int x = bx & 7, nblk = (G - x + 7) >> 3, stride = nblk * NWAVES;
    const unsigned char* UTx = ws + WS_UT + (size_t)x * UT_SLICE;
    int lane = lane_in; asm volatile("" : "+v"(lane));
    const unsigned s16 = (unsigned)(lane & 7) * 16u;
    const unsigned* IDS32 = (const unsigned*)(ws + WS_IDS);
    int* PA = (int*)(ws + WS_PA) + (size_t)x * TOK * 128;
    int t = (bx >> 3) * NWAVES + wave; if (t >= TOK) return;
    v4u bufA[8], bufB[8];
    unsigned idw = IDS32[(size_t)t * 64 + lane];
    v4u xh = *(const v4u*)(ws + WS_XH + (size_t)t * 1024 + x * 128 + s16), xl = *(const v4u*)(ws + WS_XL + (size_t)t * 1024 + x * 128 + s16);
    P10_LOAD(bufA, idw, 0); P10_LOAD(bufB, idw, 1);
#pragma unroll 1
    for (;;) {
        const int tn = t + stride; const bool more = tn < TOK;
        unsigned idwn = 0u; v4u xhn = xh, xln = xl;
        if (more) { idwn = IDS32[(size_t)tn * 64 + lane]; xhn = *(const v4u*)(ws + WS_XH + (size_t)tn * 1024 + x * 128 + s16); xln = *(const v4u*)(ws + WS_XL + (size_t)tn * 1024 + x * 128 + s16); }
        int res[16];
        P10_DOTS(bufA, 0);
        if (more) P10_LOAD(bufA, idwn, 0);
        P10_DOTS(bufB, 1);
        if (more) P10_LOAD(bufB, idwn, 1);
        int r0 = res[0], r1 = res[1];
#pragma unroll
        for (int k = 1; k < 8; ++k) { const bool m = (lane & 7) == k; r0 = m ? res[2 * k] : r0; r1 = m ? res[2 * k + 1] : r1; }
        *(v2i*)(PA + (size_t)t * 128 + 2 * lane) = (v2i){r0, r1};
        if (!more) break;
        t = tn; idw = idwn; xh = xhn; xl = xln;
    }
}
#undef P10_IDS
#undef P10_LOAD
#undef P10_LOAD1
#undef P10_DOTS

__device__ __forceinline__ void p11_w(const Args& A, int lane, int gw, int NGW) {
    unsigned char* ws = A.ws; const unsigned* IDS32 = (const unsigned*)(ws + WS_IDS); const int* PA = (const int*)(ws + WS_PA);
    const float* SU = (const float*)(ws + WS_TSCALE); const float* SV = SU + 16384; const float* SX = (const float*)(ws + WS_SX); const int* S8 = (const int*)(ws + WS_S8);
    for (int t = gw; t < TOK; t += NGW) {
        const unsigned idw = IDS32[(size_t)t * 64 + lane]; const int id0 = (int)(idw & 0xffffu), id1 = (int)(idw >> 16);
        int s0 = 0, s1 = 0;
#pragma unroll
        for (int x = 0; x < 8; ++x) { const v2i p = *(const v2i*)(PA + ((size_t)x * TOK + t) * 128 + 2 * lane); s0 += p.x; s1 += p.y; }
        const float sxt = SX[t], half = 0.5f * (float)S8[t];
        const float a0 = SU[id0] * sxt * ((float)s0 + half), a1 = SU[id1] * sxt * ((float)s1 + half);
        const f32x2g gt = *(const f32x2g*)(ws + WS_GATES + ((size_t)t * 128 + 2 * lane) * 4);
        f32x2g w; w.x = gt.x * SV[id0] * gelu_as(a0); w.y = gt.y * SV[id1] * gelu_as(a1);
        float am = fmaxf(fabsf(w.x), fabsf(w.y));
        am = wave_max(am);
        const float sc = am > 0.f ? 224.0f / am : 0.f;
        const int ph = __builtin_amdgcn_cvt_pk_fp8_f32(w.x * sc, w.y * sc, 0, false); const f32x2g bk = __builtin_amdgcn_cvt_pk_f32_fp8(ph, false);
        const int pl = __builtin_amdgcn_cvt_pk_fp8_f32(w.x * sc - bk.x, w.y * sc - bk.y, 0, false);
        *(unsigned short*)(ws + WS_W + (size_t)t * 256 + 2 * lane) = (unsigned short)(ph & 0xffff); *(unsigned short*)(ws + WS_W + (size_t)t * 256 + 128 + 2 * lane) = (unsigned short)(pl & 0xffff);
        if (lane == 0) ((float*)(ws + WS_WSC))[t] = am > 0.f ? am * (1.0f / 224.0f) : 0.f;
    }
}

typedef int i32x8v __attribute__((ext_vector_type(8)));
#define P12_TRRD(dst, ad, off) asm volatile("ds_read_b64_tr_b4 %0, %1 offset:%2" : "=&v"(dst) : "v"(ad), "i"(off) : "memory")
#define P12_DMA(IDW) do { unsigned pr_[16]; _Pragma("unroll") for (int q_ = 0; q_ < 16; ++q_) pr_[q_] = (unsigned)__builtin_amdgcn_ds_bpermute(bp_base + 16 * q_, (int)(IDW)); \
        _Pragma("unroll") for (int q_ = 0; q_ < 16; ++q_) { const unsigned id_ = (pr_[q_] >> idsh) & 0xffffu; \
        __builtin_amdgcn_global_load_lds((const unsigned*)(VTx + (id_ * 128u + ((q_ & 1) ? cs_odd : cs_even))), (LAS unsigned*)(ldsp + q_ * 1024), 16, 0, 0); } } while (0)
#define P12_RD(J, R) do { \
        P12_TRRD(R[0], tra[(J) >> 1], 8 * ((J) & 1)); P12_TRRD(R[1], tra[(J) >> 1], 2048 + 8 * ((J) & 1)); \
        P12_TRRD(R[2], tra[2 + ((J) >> 1)], 8 * ((J) & 1)); P12_TRRD(R[3], tra[2 + ((J) >> 1)], 2048 + 8 * ((J) & 1)); \
        P12_TRRD(R[4], tra[4 + ((J) >> 1)], 8 * ((J) & 1)); P12_TRRD(R[5], tra[4 + ((J) >> 1)], 2048 + 8 * ((J) & 1)); \
        P12_TRRD(R[6], tra[6 + ((J) >> 1)], 8 * ((J) & 1)); P12_TRRD(R[7], tra[6 + ((J) >> 1)], 2048 + 8 * ((J) & 1)); } while (0)
#define P12_MF1(I, R, W) do { asm volatile("s_waitcnt lgkmcnt(" #W ")" : "+v"(R[2 * (I)]), "+v"(R[2 * (I) + 1])); \
        acc[I] = __builtin_amdgcn_mfma_scale_f32_16x16x128_f8f6f4(aj_, (i32x8v){(int)R[2 * (I)][0], (int)R[2 * (I)][1], (int)R[2 * (I) + 1][0], (int)R[2 * (I) + 1][1], 0, 0, 0, 0}, acc[I], 0, 4, 0, 0x7f7f7f7f, 0, 0x7f7f7f7f); } while (0)
#define P12_AJ(J) do { const bool on_ = avalid && (jl == (J)); aj_[0] = on_ ? (int)a0[0] : 0; aj_[1] = on_ ? (int)a0[1] : 0; aj_[2] = on_ ? (int)a0[2] : 0; aj_[3] = on_ ? (int)a0[3] : 0; \
        aj_[4] = on_ ? (int)a1[0] : 0; aj_[5] = on_ ? (int)a1[1] : 0; aj_[6] = on_ ? (int)a1[2] : 0; aj_[7] = on_ ? (int)a1[3] : 0; } while (0)
#define P12_MMA() do { v2u ra_[8], rb_[8], rc_[8]; i32x8v aj_; \
        P12_RD(0, ra_); P12_RD(1, rb_); \
        P12_AJ(0); P12_MF1(0, ra_, 14); P12_MF1(1, ra_, 12); P12_MF1(2, ra_, 10); P12_MF1(3, ra_, 8); \
        P12_RD(2, rc_); \
        P12_AJ(1); P12_MF1(0, rb_, 14); P12_MF1(1, rb_, 12); P12_MF1(2, rb_, 10); P12_MF1(3, rb_, 8); \
        P12_RD(3, ra_); \
        P12_AJ(2); P12_MF1(0, rc_, 14); P12_MF1(1, rc_, 12); P12_MF1(2, rc_, 10); P12_MF1(3, rc_, 8); \
        P12_AJ(3); P12_MF1(0, ra_, 6); P12_MF1(1, ra_, 4); P12_MF1(2, ra_, 2); P12_MF1(3, ra_, 0); } while (0)
__device__ __forceinline__ float wave_sum_dpp(float v) {
    v += __int_as_float(__builtin_amdgcn_update_dpp(0, __float_as_int(v), 0xB1, 0xF, 0xF, true));
    v += __int_as_float(__builtin_amdgcn_update_dpp(0, __float_as_int(v), 0x4E, 0xF, 0xF, true));
    v += __int_as_float(__builtin_amdgcn_update_dpp(0, __float_as_int(v), 0x141, 0xF, 0xF, true));
    v += __int_as_float(__builtin_amdgcn_update_dpp(0, __float_as_int(v), 0x140, 0xF, 0xF, true));
    { const auto r = __builtin_amdgcn_permlane16_swap(__float_as_uint(v), __float_as_uint(v), false, false); v = __uint_as_float(r[0]) + __uint_as_float(r[1]); }
    { const auto r = __builtin_amdgcn_permlane32_swap(__float_as_uint(v), __float_as_uint(v), false, false); v = __uint_as_float(r[0]) + __uint_as_float(r[1]); }
    return v;
}
__device__ __forceinline__ void p12_vslice(const Args& A, LAS unsigned char* lds, int lane_in, int wave, int bx, int G) {
    unsigned char* ws = A.ws;
    const int x = bx & 7, nblk = (G - x + 7) >> 3, stride = nblk * NWAVES;
    const unsigned char* VTx = ws + WS_VT + (size_t)x * UT_SLICE;
    int lane = lane_in; asm volatile("" : "+v"(lane));
    LAS unsigned char* ldsp = lds + wave * 16384;
    const int gq = lane >> 3, sq = lane & 7;
    const unsigned cs_even = 16u * (unsigned)(sq ^ (gq >> 1)), cs_odd = 16u * (unsigned)(sq ^ (4 + (gq >> 1)));
    const int bp_base = (gq >> 1) * 4; const unsigned idsh = (unsigned)(gq & 1) * 16u;
    const int i16 = lane & 15, kq = lane >> 4;
    unsigned tra[8];
    { const unsigned rowb = (unsigned)(uintptr_t)ldsp + (unsigned)(32 * kq + i16) * 128u, sw = (unsigned)(i16 >> 1) & 7u;
#pragma unroll
      for (int c = 0; c < 8; ++c) tra[c] = rowb + (((unsigned)c ^ sw) << 4); }
    const bool avalid = (i16 & 3) < 2; const int jl = i16 >> 2;
    const unsigned aoff = (unsigned)(i16 & 1) * 128u + (unsigned)kq * 16u;
    const unsigned* IDS32 = (const unsigned*)(ws + WS_IDS); const unsigned char* WQ8 = ws + WS_W; const float* WSC = (const float*)(ws + WS_WSC);
    const float* st1 = (const float*)(ws + WS_LN1); const float* mod = (const float*)(ws + WS_MOD); const bf16* U1B = (const bf16*)(ws + WS_U1B); bf16* U2 = (bf16*)(ws + WS_H);
    f32x2g* ST2 = (f32x2g*)(ws + WS_ST2) + (size_t)x * TOK;
    const int c0 = x * 256 + lane;
    float g1[4], b1[4];
#pragma unroll
    for (int i = 0; i < 4; ++i) { g1[i] = A.ln1_g[c0 + 64 * i]; b1[i] = A.ln1_b[c0 + 64 * i]; }
    int t = (bx >> 3) * NWAVES + wave; if (t >= TOK) return;
    unsigned idw = IDS32[(size_t)t * 64 + lane];
    unsigned idw1 = (t + stride < TOK) ? IDS32[(size_t)(t + stride) * 64 + lane] : 0u;
    v4u a0 = *(const v4u*)(WQ8 + (size_t)t * 256 + aoff), a1 = *(const v4u*)(WQ8 + (size_t)t * 256 + aoff + 64);
    unsigned uh[4]; float gg[4];
#pragma unroll
    for (int i = 0; i < 4; ++i) { uh[i] = (unsigned)U1B[(size_t)t * DM + c0 + 64 * i]; gg[i] = mod[((size_t)(t >> 12) * 6 + 5) * DM + c0 + 64 * i]; }
    float mean1 = st1[(size_t)t * 2], rstd1 = st1[(size_t)t * 2 + 1], wsc = WSC[t];
    P12_DMA(idw);
#pragma unroll 1
    for (;;) {
        const int tn = t + stride; const bool more = tn < TOK;
        asm volatile("s_waitcnt vmcnt(0)" ::: "memory"); __builtin_amdgcn_sched_barrier(0);
        const unsigned idwn = idw1; unsigned idw2 = 0u; v4u n0 = a0, n1 = a1; unsigned uhn[4]; float ggn[4], mean1n = mean1, rstd1n = rstd1, wscn = wsc;
        if (tn + stride < TOK) idw2 = IDS32[(size_t)(tn + stride) * 64 + lane];
#pragma unroll
        for (int i = 0; i < 4; ++i) { uhn[i] = uh[i]; ggn[i] = gg[i]; }
        if (more) { n0 = *(const v4u*)(WQ8 + (size_t)tn * 256 + aoff); n1 = *(const v4u*)(WQ8 + (size_t)tn * 256 + aoff + 64);
#pragma unroll
                    for (int i = 0; i < 4; ++i) { uhn[i] = (unsigned)U1B[(size_t)tn * DM + c0 + 64 * i]; ggn[i] = mod[((size_t)(tn >> 12) * 6 + 5) * DM + c0 + 64 * i]; }
                    mean1n = st1[(size_t)tn * 2]; rstd1n = st1[(size_t)tn * 2 + 1]; wscn = WSC[tn]; }
        f32x4 acc[4];
#pragma unroll
        for (int i = 0; i < 4; ++i) acc[i] = (f32x4){0.f, 0.f, 0.f, 0.f};
        __builtin_amdgcn_sched_barrier(0);
        P12_MMA();
        __builtin_amdgcn_sched_barrier(0);
        if (more) P12_DMA(idwn);
        __builtin_amdgcn_sched_barrier(0);
        float s1 = 0.f, s2 = 0.f;
#pragma unroll
        for (int i = 0; i < 4; ++i) { const float p = (acc[i][0] + acc[i][1]) * wsc; const float u = __uint_as_float(uh[i] << 16);
            const float x1 = (u - mean1) * rstd1 * g1[i] + b1[i]; const float u2 = DN_ALPHA * x1 + gg[i] * p; s1 += u2; s2 += u2 * u2;
            U2[(size_t)t * DM + c0 + 64 * i] = (bf16)f2bf(u2); }
        s1 = wave_sum_dpp(s1); s2 = wave_sum_dpp(s2);
        if (lane == 0) ST2[t] = (f32x2g){s1, s2};
        if (!more) break;
        t = tn; idw = idwn; idw1 = idw2; a0 = n0; a1 = n1; mean1 = mean1n; rstd1 = rstd1n; wsc = wscn;
#pragma unroll
        for (int i = 0; i < 4; ++i) { uh[i] = uhn[i]; gg[i] = ggn[i]; }
    }
}
#undef P12_TRRD
#undef P12_DMA
#undef P12_MMA
#undef P12_RD
#undef P12_MF1
#undef P12_AJ

__device__ __forceinline__ void p13_ln2(const Args& A, int lane, int gw, int NGW) {
    unsigned char* ws = A.ws; const bf16* U2 = (const bf16*)(ws + WS_H); const f32x2g* ST2 = (const f32x2g*)(ws + WS_ST2);
    constexpr int R = 4;
    for (int t0 = gw * R; t0 < TOK; t0 += NGW * R) {
        v2u u[R][8]; float mean[R], rstd[R];
#pragma unroll
        for (int r = 0; r < R; ++r)
#pragma unroll
            for (int q = 0; q < 8; ++q) u[r][q] = *(const v2u*)(U2 + (size_t)(t0 + r) * DM + q * 256 + lane * 4);
#pragma unroll
        for (int r = 0; r < R; ++r) { float s1 = 0.f, s2 = 0.f;
#pragma unroll
            for (int x = 0; x < 8; ++x) { const f32x2g pp = ST2[(size_t)x * TOK + t0 + r]; s1 += pp.x; s2 += pp.y; }
            mean[r] = s1 * (1.0f / DM); const float var = fmaxf(s2 * (1.0f / DM) - mean[r] * mean[r], 0.f); rstd[r] = 1.0f / sqrtf(var + LN_EPS); }
#pragma unroll
        for (int q = 0; q < 8; ++q) { const int c = q * 256 + lane * 4; const f32x4 g = *(const f32x4*)(A.ln2_g + c), bb = *(const f32x4*)(A.ln2_b + c);
#pragma unroll
            for (int r = 0; r < R; ++r) { const f32x4 v = (f32x4){bflo(u[r][q].x), bfhi(u[r][q].x), bflo(u[r][q].y), bfhi(u[r][q].y)};
                __builtin_nontemporal_store((v - mean[r]) * rstd[r] * g + bb, (f32x4*)(A.out + (size_t)(t0 + r) * DM + c)); } }
    }
}


struct ArgsG {
    const GAS float *x, *c; const GAS int* positions;
    const GAS float *w_ada, *b_ada, *w_in, *b_in, *rel_bias, *q_norm_g, *kv_norm_g, *w_uq, *w_ukv, *w_pa, *w_pb, *w_o, *ln1_g, *ln1_b, *peer_wq, *peer_keys, *peer_u, *peer_v, *ln2_g, *ln2_b;
    GAS float* out; GAS unsigned char* ws; int ph_lo, ph_hi;
};
static_assert(sizeof(ArgsG) == sizeof(Args), "ArgsG mirrors Args");
#define CAS __attribute__((address_space(4)))
__device__ __forceinline__ Args load_args(const CAS ArgsG* p) {
    Args a;
    a.x = (const float*)p->x; a.c = (const float*)p->c; a.positions = (const int*)p->positions; a.w_ada = (const float*)p->w_ada; a.b_ada = (const float*)p->b_ada; a.w_in = (const float*)p->w_in; a.b_in = (const float*)p->b_in;
    a.rel_bias = (const float*)p->rel_bias; a.q_norm_g = (const float*)p->q_norm_g; a.kv_norm_g = (const float*)p->kv_norm_g; a.w_uq = (const float*)p->w_uq; a.w_ukv = (const float*)p->w_ukv; a.w_pa = (const float*)p->w_pa;
    a.w_pb = (const float*)p->w_pb; a.w_o = (const float*)p->w_o; a.ln1_g = (const float*)p->ln1_g; a.ln1_b = (const float*)p->ln1_b; a.peer_wq = (const float*)p->peer_wq; a.peer_keys = (const float*)p->peer_keys;
    a.peer_u = (const float*)p->peer_u; a.peer_v = (const float*)p->peer_v; a.ln2_g = (const float*)p->ln2_g; a.ln2_b = (const float*)p->ln2_b; a.out = (float*)p->out; a.ws = (unsigned char*)p->ws;
    a.ph_lo = p->ph_lo; a.ph_hi = p->ph_hi; return a;
}
__global__ void __launch_bounds__(NWAVES * 64, 2) fwd(Args A_) {
    extern __shared__ __attribute__((aligned(16))) unsigned char lds_raw[];
    LAS unsigned char* lds = (LAS unsigned char*)lds_raw;
    const CAS Args* Ap0 = (const CAS Args*)__builtin_amdgcn_kernarg_segment_ptr();
#define PHASE_ENV() const CAS Args* Ap = Ap0; asm volatile("" : "+s"(Ap)); const Args A = load_args((const CAS ArgsG*)Ap); \
    int wave = wave_s; asm volatile("" : "+s"(wave)); int lane; asm volatile("v_mbcnt_lo_u32_b32 %0, -1, 0\n\tv_mbcnt_hi_u32_b32 %0, -1, %0" : "=v"(lane)); const int tid = wave * 64 + lane; \
    const int G = gridDim.x, bx = blockIdx.x, vcu = (G % 8 == 0) ? (bx % 8) * (G / 8) + bx / 8 : bx, gw = vcu * NWAVES + wave, NGW = G * NWAVES; \
    unsigned char* const ws = A.ws; bf16* const H = (bf16*)(ws + WS_H); (void)lane; (void)gw; (void)NGW; (void)H; (void)vcu
    const int wave_s = __builtin_amdgcn_readfirstlane(threadIdx.x >> 6);
    for (int u = threadIdx.x; u < (LDS_BYTES - RING_BYTES) / 4; u += NWAVES * 64) ((LAS unsigned*)(lds + RING_BYTES))[u] = 0u;
    __syncthreads();
    const int lo = A_.ph_lo, hi = A_.ph_hi; const bool multi = (hi - lo) > 1;
    volatile LAS unsigned* MISC = (volatile LAS unsigned*)(lds + MISC_OFF);
    XcdBarrier bar; bar.bar = (unsigned*)(A_.ws + WS_CTL) + CW_BAR; bar.x = 0; bar.st = MISC + 8; bar.w0 = (wave_s == 0);
    if (multi) bar = xcd_barrier_post((unsigned*)(A_.ws + WS_CTL) + CW_BAR, MISC + 8, wave_s == 0);
#ifdef DBG_PHASE
#define IN(k) ((k) == DBG_PHASE)
#else
#define IN(k) (lo <= (k) && (k) < hi)
#endif
#define GRID_BAR(k) do { if (IN(k) && IN((k) + 1)) xcd_barrier(bar); } while (0)
    if (IN(0)) { { PHASE_ENV(); p0_prologue(A, lds, tid, lane, wave, vcu, G); } GRID_BAR(0); }
    if (IN(1)) { { PHASE_ENV(); p1_modulate(A, lane, gw, NGW); } GRID_BAR(1); }
    if (IN(2)) {
        { PHASE_ENV();
        pg8::Gemm g{(const bf16*)(ws + WS_H8), (const bf16*)(ws + WS_W8), TOK, 8192, 1024}; pg8::StaticOrder S; S.init(TOK, 8192, G, bx);
        pg8::EpiInProj E{(bf16*)(ws + WS_QKVA), (bf16*)(ws + WS_CQ), (bf16*)(ws + WS_CKV), (bf16*)A.out, (float*)(ws + WS_SSQ), (const float*)(ws + WS_BIAS), QSCALE_A, (const float*)(ws + WS_HSC), (const unsigned*)(ws + WS_CTL) + CW_WMAX};
        pg8::gemm_phase<pg8::EpiInProj, pg8::StaticOrder, true, true, true>(lds, g, S, E, tid); }
        GRID_BAR(2);
    }
    if (IN(3)) {
        {
        { PHASE_ENV(); pg8::Gemm g{(const bf16*)(ws + WS_CQ), (const bf16*)(ws + WS_WUQ8), TOK, 1536, 256}; pg8::StaticOrder S; S.init(TOK, 1536, G, bx);
          pg8::EpiQUp E{(bf16*)(ws + WS_QN), (bf16*)(ws + WS_QR), (const float*)(ws + WS_SSQ), (const float*)(ws + WS_CS), QSCALE_B, (const unsigned*)(ws + WS_CTL) + CW_WMAX + 4};
          pg8::gemm_phase<pg8::EpiQUp, pg8::StaticOrder, true, true, true>(lds, g, S, E, tid); }
        { PHASE_ENV(); pg8::Gemm g{(const bf16*)(ws + WS_CKV), (const bf16*)(ws + WS_WUKV8), TOK, 2048, 256}; pg8::StaticOrder S; S.init(TOK, 2048, G, bx);
          pg8::EpiKvUp E{(bf16*)(ws + WS_KN), (bf16*)(ws + WS_VB), (const float*)(ws + WS_SSQ) + (size_t)TOK * 8, (const unsigned*)(ws + WS_CTL) + CW_WMAX + 5};
          pg8::gemm_phase<pg8::EpiKvUp, pg8::StaticOrder, true, true, true>(lds, g, S, E, tid); }
        { PHASE_ENV(); pg8::Gemm g{(const bf16*)(ws + WS_H8), (const bf16*)(ws + WS_WKR8), TOK, 256, 1024}; pg8::StaticOrder S; S.init(TOK, 256, G, bx);
          pg8::EpiKr E{(bf16*)(ws + WS_KR), (const float*)(ws + WS_BIAS) + 8192, (const float*)(ws + WS_CS), (const float*)(ws + WS_HSC), (const unsigned*)(ws + WS_CTL) + CW_WMAX};
          pg8::gemm_phase<pg8::EpiKr, pg8::StaticOrder, true, true, true>(lds, g, S, E, tid); }
        { PHASE_ENV(); const bf16* Q = (const bf16*)(ws + WS_QKVA); const bf16* K = Q + (size_t)TOK * 1024; const bf16* V = K + (size_t)TOK * 1024;
          for (int u = vcu; u < 1024; u += G) { const int bh = u >> 4, qb = u & 15;
              att::attn_unit<0>(lds, bh >> 3, bh & 7, qb, Q, nullptr, K, nullptr, V, (bf16*)(ws + WS_YA), A.rel_bias + (bh & 7) * 320, tid); } }
        }
        GRID_BAR(3);
    }
    if (IN(4)) {
        {
        { PHASE_ENV();
        for (int s2 = 0; vcu + G * (s2 >> 1) < 512; ++s2) { const int it = vcu + G * (s2 >> 1), bh = it >> 3, x = it & 7, qb = (s2 & 1) ? 15 - x : x;
            att::attn_unit<1>(lds, bh >> 3, bh & 7, qb, (const bf16*)(ws + WS_QN), (const bf16*)(ws + WS_QR), (const bf16*)(ws + WS_KN), (const bf16*)(ws + WS_KR), (const bf16*)(ws + WS_VB), (bf16*)(ws + WS_YB), nullptr, tid); } }
        { PHASE_ENV(); pg8::Gemm g{(const bf16*)(ws + WS_YA), (const bf16*)(ws + WS_WPA8), TOK, 2048, 512}; pg8::StaticOrder S; S.init(TOK, 2048, G, bx);
          pg8::EpiGate<0> E{(unsigned char*)H, (const unsigned char*)A.out, nullptr, (const unsigned*)(ws + WS_CTL) + CW_WMAX + 1, ACT_MIX / ACT_Y};
          pg8::gemm_phase<pg8::EpiGate<0>, pg8::StaticOrder, true, true, true>(lds, g, S, E, tid); }
        }
        GRID_BAR(4);
    }
    if (IN(5)) {
        { PHASE_ENV(); pg8::Gemm g{(const bf16*)(ws + WS_YB), (const bf16*)(ws + WS_WPB8), TOK, 2048, 512}; pg8::StaticOrder S; S.init(TOK, 2048, G, bx);
        pg8::EpiGate<1> E{(unsigned char*)H, (const unsigned char*)A.out, ws + WS_H8, (const unsigned*)(ws + WS_CTL) + CW_WMAX + 2, ACT_MIX / ACT_Y};
        pg8::gemm_phase<pg8::EpiGate<1>, pg8::StaticOrder, true, true, true>(lds, g, S, E, tid); }
        GRID_BAR(5);
    }
    if (IN(6)) {
        { PHASE_ENV(); pg8::Gemm g{(const bf16*)(ws + WS_H8), (const bf16*)(ws + WS_WO8), TOK, 2048, 1024}; pg8::StaticOrder S; S.init(TOK, 2048, G, bx);
        pg8::EpiWo E{A.x, (bf16*)(ws + WS_U1B), (const float*)(ws + WS_MOD), DN_ALPHA, (const unsigned*)(ws + WS_CTL) + CW_WMAX + 3, 1.0f / ACT_MIX};
        pg8::gemm_phase<pg8::EpiWo, pg8::StaticOrder, true, true, true>(lds, g, S, E, tid); }
        GRID_BAR(6);
    }
    if (IN(7)) { { PHASE_ENV(); p7_ln1(A, lane, gw, NGW); } GRID_BAR(7); }
    if (IN(8)) {
        { PHASE_ENV(); pg8::Gemm g{H, (const bf16*)(ws + WS_WSK), TOK, 2048, 2048}; pg8::StaticOrder S; S.init(TOK, 2048, G, bx);
        pg8::EpiF32 E{(float*)(ws + WS_SCORE), 2048};
        pg8::gemm_phase<pg8::EpiF32, pg8::StaticOrder, true, true>(lds, g, S, E, tid); }
        GRID_BAR(8);
    }
    if (IN(9)) { { PHASE_ENV(); p9a_topk(A, lane, gw, NGW); } GRID_BAR(9); }
    if (IN(10)) { { PHASE_ENV(); p10_udot(A, lane, wave, bx, G); } GRID_BAR(10); }
    if (IN(11)) { { PHASE_ENV(); p11_w(A, lane, gw, NGW); } GRID_BAR(11); }
    if (IN(12)) { { PHASE_ENV(); p12_vslice(A, lds, lane, wave, bx, G); } GRID_BAR(12); }
    if (IN(13)) { PHASE_ENV(); p13_ln2(A, lane, gw, NGW); }
#undef IN
#undef GRID_BAR
#undef PHASE_ENV
}

#ifndef MK_ONE_LAUNCH
#define MK_ONE_LAUNCH 1
#endif
constexpr int N_PHASES = 14;
extern "C" void kernel_launch(void* const* d_in, const int* in_sizes, int n_in, void* d_out, int out_size, void* d_ws, size_t ws_size, hipStream_t stream) {
    static int grid = 0;
    if (grid == 0) {
        if (n_in != 23 || out_size != TOK * DM || ws_size < WS_END) { fprintf(stderr, "kernel_launch: unexpected shapes (n_in %d, out %d, ws %zu); nothing launched\n", n_in, out_size, ws_size); grid = -1; return; }
        int dev = 0, cus = 0, per_cu = 0;
        if (hipGetDevice(&dev) != hipSuccess || hipDeviceGetAttribute(&cus, hipDeviceAttributeMultiprocessorCount, dev) != hipSuccess) { grid = -1; return; }
        if (hipFuncSetAttribute((const void*)fwd, hipFuncAttributeMaxDynamicSharedMemorySize, LDS_BYTES) != hipSuccess) { fprintf(stderr, "kernel_launch: hipFuncSetAttribute failed\n"); grid = -1; return; }
        if (hipOccupancyMaxActiveBlocksPerMultiprocessor(&per_cu, (const void*)fwd, NWAVES * 64, LDS_BYTES) != hipSuccess || per_cu < 1) fprintf(stderr, "kernel_launch: occupancy query reports %d\n", per_cu);
        (void)hipGetLastError();
        grid = cus;
    }
    if (grid < 0) return;
    (void)hipMemsetAsync((char*)d_ws + WS_CTL, 0, CTL_ZERO_BYTES, stream);
    Args a{};
    a.x = (const float*)d_in[0]; a.c = (const float*)d_in[1]; a.positions = (const int*)d_in[2];
    a.w_ada = (const float*)d_in[3]; a.b_ada = (const float*)d_in[4]; a.w_in = (const float*)d_in[5]; a.b_in = (const float*)d_in[6]; a.rel_bias = (const float*)d_in[7];
    a.q_norm_g = (const float*)d_in[8]; a.kv_norm_g = (const float*)d_in[9]; a.w_uq = (const float*)d_in[10]; a.w_ukv = (const float*)d_in[11]; a.w_pa = (const float*)d_in[12];
    a.w_pb = (const float*)d_in[13]; a.w_o = (const float*)d_in[14]; a.ln1_g = (const float*)d_in[15]; a.ln1_b = (const float*)d_in[16]; a.peer_wq = (const float*)d_in[17];
    a.peer_keys = (const float*)d_in[18]; a.peer_u = (const float*)d_in[19]; a.peer_v = (const float*)d_in[20]; a.ln2_g = (const float*)d_in[21]; a.ln2_b = (const float*)d_in[22];
    a.out = (float*)d_out; a.ws = (unsigned char*)d_ws;
#if MK_ONE_LAUNCH
    a.ph_lo = 0; a.ph_hi = N_PHASES;
    hipLaunchKernelGGL(fwd, dim3(grid), dim3(NWAVES * 64), LDS_BYTES, stream, a);
#else
    for (int p = 0; p < N_PHASES; ++p) { a.ph_lo = p; a.ph_hi = p + 1; hipLaunchKernelGGL(fwd, dim3(grid), dim3(NWAVES * 64), LDS_BYTES, stream, a); }
#endif
}
```

```cpp
#include <hip/hip_runtime.h>
#include <cstdio>
#include <cstdint>
#include <cmath>
namespace pg8 {
#define PG8_LAS __attribute__((address_space(3)))
typedef unsigned short bf16_t;
typedef short bf16x8 __attribute__((ext_vector_type(8)));
typedef float f32x4 __attribute__((ext_vector_type(4)));
typedef unsigned u32x4 __attribute__((ext_vector_type(4)));
constexpr int BM = 256, BK = 64, HALF = 128, HTB = HALF * BK * 2  , STAGE_BYTES = 8 * HTB, NXCD = 8, WGM = 8;

__host__ __device__ __forceinline__ int lds_byte(int r, int c) { const int st = (r >> 4) * 2 + (c >> 5), rr = r & 15, cc = c & 31, ob = rr * 64 + cc * 2; return st * 1024 + (ob ^ (((ob >> 9) & 1) << 5)); }
__host__ __device__ __forceinline__ void stage_rc(int b, int& R, int& C) { const int st = b / 1024, sb = b % 1024, swz = sb ^ (((sb >> 9) & 1) << 5); R = (st >> 1) * 16 + swz / 64; C = (st & 1) * 32 + (swz % 64) / 2; }
__host__ __device__ __forceinline__ int perm32(int rho) { const int n = rho >> 4, i = rho & 15; return 8 * (i >> 2) + 4 * n + (i & 3); }

struct Unit { int pm, pn; };
struct Gemm { const bf16_t* A; const bf16_t* Bt; int M, N, K; };

struct StaticOrder {
    int nM, nN, nwg, G, c;
    __host__ __device__ void init(int M, int N, int G_, int c_) { nM = M / BM; nN = N / BM; nwg = nM * nN; G = G_; c = c_; }
    __host__ __device__ bool next(int i, Unit& u) const {
        const long L = (long)i * G + c; if (L >= nwg) return false;
        int wgid = (int)L; { const int q = nwg / NXCD, r = nwg % NXCD, xcd = wgid % NXCD, off = wgid / NXCD; wgid = (xcd < r ? xcd * (q + 1) : r * (q + 1) + (xcd - r) * q) + off; }
        const int nig = WGM * nN, gid = wgid / nig, fm = gid * WGM, gsz = (nM - fm) < WGM ? (nM - fm) : WGM;
        u.pm = fm + ((wgid % nig) % gsz); u.pn = (wgid % nig) / gsz; return true;
    }
    __device__ __forceinline__ void a_ready(const Unit&) const {}
    __device__ __forceinline__ void done(const Unit&) const {}
};

typedef float f32x2c_t __attribute__((ext_vector_type(2))); typedef __bf16 bf16x2c_t __attribute__((ext_vector_type(2)));
__device__ __forceinline__ unsigned cvt_pk_bf16(float lo, float hi) { const f32x2c_t v = {lo, hi}; const bf16x2c_t b = __builtin_convertvector(v, bf16x2c_t); return __builtin_bit_cast(unsigned, b); }
typedef float f32x2 __attribute__((ext_vector_type(2)));

constexpr int TOK = 32768;
__device__ __forceinline__ u32x4 pack8(const f32x4& v0, const f32x4& v1) { u32x4 w; w.x = cvt_pk_bf16(v0[0], v0[1]); w.y = cvt_pk_bf16(v0[2], v0[3]); w.z = cvt_pk_bf16(v1[0], v1[1]); w.w = cvt_pk_bf16(v1[2], v1[3]); return w; }
__device__ __forceinline__ float bf_lo(unsigned w) { return __uint_as_float(w << 16); }
__device__ __forceinline__ float bf_hi(unsigned w) { return __uint_as_float(w & 0xffff0000u); }
__device__ __forceinline__ float sigmoidf_fast(float v) { return __builtin_amdgcn_rcpf(1.0f + __builtin_amdgcn_exp2f(-1.4426950408889634f * v)); }

__device__ __forceinline__ unsigned pk4f8(float a, float b, float c, float d) { int w = __builtin_amdgcn_cvt_pk_fp8_f32(a, b, 0, false); w = __builtin_amdgcn_cvt_pk_fp8_f32(c, d, w, true); return (unsigned)w; }
struct EpiF32 {
    static constexpr bool PERM = false, AFTER_DRAIN = false;
    float* C; int ldc;
    __device__ __forceinline__ void operator()(const f32x4 (&acc)[2][2][4][2], const Unit& u, int wr, int wc, int fr, int fq) const {
        const int row0 = u.pm * BM + wr * 64 + fr, col0 = u.pn * BM + wc * 32 + 4 * fq;
#pragma unroll
        for (int ai = 0; ai < 2; ++ai)
#pragma unroll
            for (int m = 0; m < 4; ++m) { float* rowp = C + (size_t)(row0 + ai * HALF + m * 16) * ldc + col0;
#pragma unroll
                for (int bj = 0; bj < 2; ++bj)
#pragma unroll
                    for (int n = 0; n < 2; ++n) *(f32x4*)(rowp + bj * HALF + n * 16) = acc[ai][bj][m][n]; }
    }
};
struct EpiInProj {
    static constexpr bool PERM = true, AFTER_DRAIN = false;
    bf16_t* QKV;
    bf16_t* CQ; bf16_t* CKV;
    bf16_t* SG;
    float* SSQ;
    const float* bias;
    float qscale;
    const float* rowscale;
    const unsigned* wmaxbits;
    __device__ __forceinline__ void operator()(const f32x4 (&acc)[2][2][4][2], const Unit& u, int wr, int wc, int fr, int fq) const {
        const int row0 = u.pm * BM + wr * 64 + fr, cl = wc * 32 + 8 * fq, bcol0 = u.pn * BM + cl;
        f32x4 bv[2][2];
#pragma unroll
        for (int bj = 0; bj < 2; ++bj)
#pragma unroll
            for (int n = 0; n < 2; ++n) bv[bj][n] = *(const f32x4*)(bias + bcol0 + bj * HALF + 4 * n);
        const float wsc = __uint_as_float(*wmaxbits) * (1.0f / 440.0f); float rsc[2][4];
#pragma unroll
        for (int ai = 0; ai < 2; ++ai)
#pragma unroll
            for (int m = 0; m < 4; ++m) rsc[ai][m] = rowscale[row0 + ai * HALF + m * 16] * wsc;
        asm volatile("" :: "v"(bv[0][0]), "v"(bv[0][1]), "v"(bv[1][0]), "v"(bv[1][1]), "v"(rsc[0][0]), "v"(rsc[0][1]), "v"(rsc[0][2]), "v"(rsc[0][3]), "v"(rsc[1][0]), "v"(rsc[1][1]), "v"(rsc[1][2]), "v"(rsc[1][3]));
        if (u.pn < 12) {
            const int t = u.pn >> 2; bf16_t* base = QKV + (size_t)t * TOK * 1024 + (u.pn & 3) * 256 + cl; const float sc = (t == 0) ? qscale : 1.0f;
#pragma unroll
            for (int ai = 0; ai < 2; ++ai)
#pragma unroll
                for (int m = 0; m < 4; ++m) { bf16_t* rowp = base + (size_t)(row0 + ai * HALF + m * 16) * 1024;
#pragma unroll
                    for (int bj = 0; bj < 2; ++bj) { const f32x4 v0 = (acc[ai][bj][m][0] * rsc[ai][m] + bv[bj][0]) * sc, v1 = (acc[ai][bj][m][1] * rsc[ai][m] + bv[bj][1]) * sc; *(u32x4*)(rowp + bj * HALF) = pack8(v0, v1); } }
        } else if (u.pn < 16) {
            const int which = (u.pn - 12) >> 1, tl = (u.pn - 12) & 1; unsigned char* base = (unsigned char*)(which ? CKV : CQ) + tl * 256 + cl; float* sq = SSQ + (size_t)which * TOK * 8 + tl * 4 + wc;
#pragma unroll
            for (int ai = 0; ai < 2; ++ai)
#pragma unroll
                for (int m = 0; m < 4; ++m) { const int row = row0 + ai * HALF + m * 16; unsigned char* rowp = base + (size_t)row * 512; float ss = 0.f;
#pragma unroll
                    for (int bj = 0; bj < 2; ++bj) { const f32x4 v0 = acc[ai][bj][m][0] * rsc[ai][m] + bv[bj][0], v1 = acc[ai][bj][m][1] * rsc[ai][m] + bv[bj][1];
                        typedef unsigned u32x2c __attribute__((ext_vector_type(2))); u32x2c o; o.x = pk4f8(v0[0] * 16.0f, v0[1] * 16.0f, v0[2] * 16.0f, v0[3] * 16.0f); o.y = pk4f8(v1[0] * 16.0f, v1[1] * 16.0f, v1[2] * 16.0f, v1[3] * 16.0f);
                        *(u32x2c*)(rowp + bj * HALF) = o;
                        ss += (v0[0] * v0[0] + v0[1] * v0[1]) + (v0[2] * v0[2] + v0[3] * v0[3]) + (v1[0] * v1[0] + v1[1] * v1[1]) + (v1[2] * v1[2] + v1[3] * v1[3]); }
                    ss += __int_as_float(__builtin_amdgcn_ds_swizzle(__float_as_int(ss), 0x401F));
                    { auto rr_ = __builtin_amdgcn_permlane32_swap(__float_as_uint(ss), __float_as_uint(ss), false, false); ss = __uint_as_float(rr_[0]) + __uint_as_float(rr_[1]); }
                    if (fq == 0) sq[(size_t)row * 8] = ss; }
        } else {
            unsigned char* base = (unsigned char*)SG + (u.pn - 16) * 256 + cl;
#pragma unroll
            for (int ai = 0; ai < 2; ++ai)
#pragma unroll
                for (int m = 0; m < 4; ++m) { unsigned char* rowp = base + (size_t)(row0 + ai * HALF + m * 16) * 4096;
#pragma unroll
                    for (int bj = 0; bj < 2; ++bj) { f32x4 v0 = acc[ai][bj][m][0] * rsc[ai][m] + bv[bj][0], v1 = acc[ai][bj][m][1] * rsc[ai][m] + bv[bj][1];
#pragma unroll
                        for (int j = 0; j < 4; ++j) { v0[j] = sigmoidf_fast(v0[j]); v1[j] = sigmoidf_fast(v1[j]); }
                        typedef unsigned u32x2c __attribute__((ext_vector_type(2))); u32x2c o; o.x = pk4f8(v0[0], v0[1], v0[2], v0[3]); o.y = pk4f8(v1[0], v1[1], v1[2], v1[3]);
                        *(u32x2c*)(rowp + bj * HALF) = o; } }
        }
    }
};
__device__ __forceinline__ float row_rs(const float* ssq_row, float inv_n, float eps) {
    const f32x4 a = *(const f32x4*)ssq_row, b = *(const f32x4*)(ssq_row + 4);
    const float s = ((a[0] + a[1]) + (a[2] + a[3])) + ((b[0] + b[1]) + (b[2] + b[3]));
    return 1.0f / sqrtf(s * inv_n + eps);
}
__device__ __forceinline__ void rope8(f32x4& v0, f32x4& v1, const float* cs) {
    const f32x4 c0 = *(const f32x4*)cs, c1 = *(const f32x4*)(cs + 4);
    f32x4 o0, o1;
    o0[0] = v0[0] * c0[0] - v0[1] * c0[1]; o0[1] = v0[0] * c0[1] + v0[1] * c0[0]; o0[2] = v0[2] * c0[2] - v0[3] * c0[3]; o0[3] = v0[2] * c0[3] + v0[3] * c0[2];
    o1[0] = v1[0] * c1[0] - v1[1] * c1[1]; o1[1] = v1[0] * c1[1] + v1[1] * c1[0]; o1[2] = v1[2] * c1[2] - v1[3] * c1[3]; o1[3] = v1[2] * c1[3] + v1[3] * c1[2];
    v0 = o0; v1 = o1;
}
struct EpiQUp {
    static constexpr bool PERM = true, AFTER_DRAIN = false;
    bf16_t* Qn; bf16_t* Qr; const float* SSQ; const float* CS; float qscale; const unsigned* wmaxbits;
    __device__ __forceinline__ void operator()(const f32x4 (&acc)[2][2][4][2], const Unit& u, int wr, int wc, int fr, int fq) const {
        const int row0 = u.pm * BM + wr * 64 + fr, cl = wc * 32 + 8 * fq;
        float rs[2][4];
#pragma unroll
        for (int ai = 0; ai < 2; ++ai)
#pragma unroll
            for (int m = 0; m < 4; ++m) rs[ai][m] = row_rs(SSQ + (size_t)(row0 + ai * HALF + m * 16) * 8, 1.0f / 512.0f, 1e-6f) * (qscale * (1.0f / (440.0f * 16.0f)) * __uint_as_float(wmaxbits[fq >> 2]));
        asm volatile("" ::: "memory");
        if (u.pn < 4) {
#pragma unroll
            for (int ai = 0; ai < 2; ++ai)
#pragma unroll
                for (int m = 0; m < 4; ++m) { const int row = row0 + ai * HALF + m * 16; bf16_t* rowp = Qn + (size_t)row * 1024 + u.pn * 256 + cl;
#pragma unroll
                    for (int bj = 0; bj < 2; ++bj) *(u32x4*)(rowp + bj * HALF) = pack8(acc[ai][bj][m][0] * rs[ai][m], acc[ai][bj][m][1] * rs[ai][m]); }
        } else { const int rc = (u.pn - 4) * 256 + cl;
#pragma unroll
            for (int ai = 0; ai < 2; ++ai)
#pragma unroll
                for (int m = 0; m < 4; ++m) { const int row = row0 + ai * HALF + m * 16;
#pragma unroll
                    for (int bj = 0; bj < 2; ++bj) { const int c = rc + bj * HALF; f32x4 v0 = acc[ai][bj][m][0] * rs[ai][m], v1 = acc[ai][bj][m][1] * rs[ai][m];
                        rope8(v0, v1, (const float*)((const char*)CS + (unsigned)((row * 32 + ((c & 63) >> 1)) * 8))); *(u32x4*)((char*)Qr + (unsigned)((row * 512 + c) * 2)) = pack8(v0, v1); }
                    if (m & 1) asm volatile("" ::: "memory"); }
        }
    }
};
struct EpiKvUp {
    static constexpr bool PERM = true, AFTER_DRAIN = false;
    bf16_t* Kn; bf16_t* Vb; const float* SSQ; const unsigned* wmaxbits;
    __device__ __forceinline__ void operator()(const f32x4 (&acc)[2][2][4][2], const Unit& u, int wr, int wc, int fr, int fq) const {
        const int row0 = u.pm * BM + wr * 64 + fr, cl = wc * 32 + 8 * fq; bf16_t* base = (u.pn < 4 ? Kn : Vb) + (u.pn & 3) * 256 + cl;
        float rs[2][4];
#pragma unroll
        for (int ai = 0; ai < 2; ++ai)
#pragma unroll
            for (int m = 0; m < 4; ++m) rs[ai][m] = row_rs(SSQ + (size_t)(row0 + ai * HALF + m * 16) * 8, 1.0f / 512.0f, 1e-6f) * ((1.0f / (440.0f * 16.0f)) * __uint_as_float(*wmaxbits));
        asm volatile("" ::: "memory");
#pragma unroll
        for (int ai = 0; ai < 2; ++ai)
#pragma unroll
            for (int m = 0; m < 4; ++m) { const int row = row0 + ai * HALF + m * 16; bf16_t* rowp = base + (size_t)row * 1024;
#pragma unroll
                for (int bj = 0; bj < 2; ++bj) *(u32x4*)(rowp + bj * HALF) = pack8(acc[ai][bj][m][0] * rs[ai][m], acc[ai][bj][m][1] * rs[ai][m]); }
    }
};
struct EpiKr {
    static constexpr bool PERM = true, AFTER_DRAIN = false;
    bf16_t* KR; const float* bias; const float* CS; const float* rowscale; const unsigned* wmaxbits;
    __device__ __forceinline__ void operator()(const f32x4 (&acc)[2][2][4][2], const Unit& u, int wr, int wc, int fr, int fq) const {
        if (wc >= 2) return;
        const int row0 = u.pm * BM + wr * 64 + fr, cl = wc * 32 + 8 * fq; const float wsc = __uint_as_float(*wmaxbits) * (1.0f / 440.0f);
        const f32x4 b0 = *(const f32x4*)(bias + cl), b1 = *(const f32x4*)(bias + cl + 4);
#pragma unroll
        for (int ai = 0; ai < 2; ++ai)
#pragma unroll
            for (int m = 0; m < 4; ++m) { const int row = row0 + ai * HALF + m * 16; const float rs = rowscale[row] * wsc; f32x4 v0 = acc[ai][0][m][0] * rs + b0, v1 = acc[ai][0][m][1] * rs + b1;
                rope8(v0, v1, CS + ((size_t)row * 32 + (cl >> 1)) * 2); *(u32x4*)(KR + (size_t)row * 64 + cl) = pack8(v0, v1);
                if (m & 1) asm volatile("" ::: "memory"); }
    }
};
__device__ __forceinline__ void unpk8f8(unsigned lo, unsigned hi, f32x4& a, f32x4& b) { typedef float f32x2u __attribute__((ext_vector_type(2)));
    const f32x2u p0 = __builtin_amdgcn_cvt_pk_f32_fp8((int)lo, false), p1 = __builtin_amdgcn_cvt_pk_f32_fp8((int)lo, true), p2 = __builtin_amdgcn_cvt_pk_f32_fp8((int)hi, false), p3 = __builtin_amdgcn_cvt_pk_f32_fp8((int)hi, true);
    a = (f32x4){p0[0], p0[1], p1[0], p1[1]}; b = (f32x4){p2[0], p2[1], p3[0], p3[1]}; }
template <int MODE> struct EpiGate {
    static constexpr bool PERM = true, AFTER_DRAIN = false;
    unsigned char* T8; const unsigned char* SG8; unsigned char* MIX8; const unsigned* wmaxbits; float actmul;
    __device__ __forceinline__ void operator()(const f32x4 (&acc)[2][2][4][2], const Unit& u, int wr, int wc, int fr, int fq) const {
        typedef unsigned u32x2e __attribute__((ext_vector_type(2)));
        const int row0 = u.pm * BM + wr * 64 + fr, col0 = u.pn * BM + wc * 32 + 8 * fq; const float sc = __uint_as_float(*wmaxbits) * (1.0f / 440.0f) * actmul;
#pragma unroll
        for (int ai = 0; ai < 2; ++ai)
#pragma unroll
            for (int m = 0; m < 4; ++m) { const int row = row0 + ai * HALF + m * 16;
#pragma unroll
                for (int bj = 0; bj < 2; ++bj) { const int c = col0 + bj * HALF; const u32x2e g = *(const u32x2e*)(SG8 + (size_t)row * 4096 + MODE * 2048 + c);
                    f32x4 g0, g1; unpk8f8(g.x, g.y, g0, g1);
                    f32x4 v0 = acc[ai][bj][m][0] * sc * g0, v1 = acc[ai][bj][m][1] * sc * g1;
                    if (MODE == 1) { const u32x2e t = *(const u32x2e*)(T8 + (size_t)row * 2048 + c); f32x4 t0, t1; unpk8f8(t.x, t.y, t0, t1); v0 = v0 + t0; v1 = v1 + t1; }
                    u32x2e o; o.x = pk4f8(v0[0], v0[1], v0[2], v0[3]); o.y = pk4f8(v1[0], v1[1], v1[2], v1[3]);
                    *(u32x2e*)((MODE == 0 ? T8 : MIX8) + (size_t)row * 2048 + c) = o; } }
    }
};
struct EpiWo {
    static constexpr bool PERM = true, AFTER_DRAIN = false;
    const float* X; bf16_t* U1; const float* MOD; float alpha; const unsigned* wmaxbits; float actinv;
    __device__ __forceinline__ void operator()(const f32x4 (&acc)[2][2][4][2], const Unit& u, int wr, int wc, int fr, int fq) const {
        const int row0 = u.pm * BM + wr * 64 + fr, col0 = u.pn * BM + wc * 32 + 8 * fq; const int b = (u.pm * BM) >> 12;
        f32x4 gv[2][2];
#pragma unroll
        for (int bj = 0; bj < 2; ++bj)
#pragma unroll
            for (int n = 0; n < 2; ++n) gv[bj][n] = *(const f32x4*)(MOD + ((size_t)b * 6 + 2) * 2048 + col0 + bj * HALF + n * 4) * (__uint_as_float(*wmaxbits) * (1.0f / 440.0f) * actinv);
#pragma unroll
        for (int ai = 0; ai < 2; ++ai)
#pragma unroll
            for (int m = 0; m < 4; ++m) { const size_t off = (size_t)(row0 + ai * HALF + m * 16) * 2048 + col0;
#pragma unroll
                for (int bj = 0; bj < 2; ++bj) { const f32x4 x0 = *(const f32x4*)(X + off + bj * HALF), x1 = *(const f32x4*)(X + off + bj * HALF + 4);
                    const f32x4 v0 = x0 * alpha + gv[bj][0] * acc[ai][bj][m][0], v1 = x1 * alpha + gv[bj][1] * acc[ai][bj][m][1];
                    *(u32x4*)(U1 + off + bj * HALF) = pack8(v0, v1); }
                asm volatile("" ::: "memory"); }
    }
};

__device__ __forceinline__ bf16x8 lds_rd16(const PG8_LAS bf16x8* __restrict__ p) { return *p; }
typedef int i32x4g __attribute__((ext_vector_type(4))); typedef int i32x8g __attribute__((ext_vector_type(8)));
template <class Epi, class Sched, bool ALIGN_EPI = false, bool SP2 = false, bool F8 = false>
__device__ __forceinline__ void gemm_phase(PG8_LAS unsigned char* lds, const Gemm g, const Sched& S, const Epi& E, const int tid) {
    const int wid = __builtin_amdgcn_readfirstlane(tid >> 6), lane = tid & 63, wr = wid >> 2, wc = wid & 3, fr = lane & 15, fq = lane >> 4;
    const int K = g.K, nt = K / BK;
    unsigned voffA[2], voffB[2];
#pragma unroll
    for (int i = 0; i < 2; ++i) { int R, C; stage_rc(tid * 16 + i * 8192, R, C); const int Rb = Epi::PERM ? ((R & ~31) + perm32(R & 31)) : R;
        voffA[i] = (unsigned)(R * K + C) * 2u; voffB[i] = (unsigned)(Rb * K + C) * 2u; }
    const size_t kstep = (size_t)(BK * 2);
    const size_t hstep = (size_t)HALF * K * 2;
    const size_t tstep = 2 * hstep;
    const unsigned ldsbase_u = (unsigned)(size_t)lds;
    const unsigned ldsw = (unsigned)wid * 1024u;
    const int aoff = lds_byte(wr * 64 + fr, fq * 8), boff = lds_byte(wc * 32 + fr, fq * 8);
#define PG8_SA(b, h) (((b) * 2 + (h)) * HTB)
#define PG8_SB(b, h) ((4 + (b) * 2 + (h)) * HTB)
#define PG8_STAGE(bufoff, gbase, voff) do { _Pragma("unroll") for (int _i = 0; _i < 2; ++_i) { unsigned keep_; \
        asm volatile("s_mov_b32 %0, m0\n\ts_mov_b32 m0, %3\n\ts_nop 0\n\tglobal_load_lds_dwordx4 %1, %2\n\ts_mov_b32 m0, %0" \
                     : "=&s"(keep_) : "v"((voff)[_i]), "s"((const char*)(gbase)), "s"(ldsbase_u + (unsigned)(bufoff) + ldsw + (unsigned)(_i * 8192)) : "memory"); } } while (0)
#define PG8_LDA(dst, b, h) do { _Pragma("unroll") for (int m = 0; m < 4; ++m) _Pragma("unroll") for (int k = 0; k < 2; ++k) dst[m][k] = lds_rd16((const PG8_LAS bf16x8*)(lds + PG8_SA(b, h) + aoff + m * 2048 + k * 1024)); } while (0)
#define PG8_LDB(dst, b, h) do { _Pragma("unroll") for (int n = 0; n < 2; ++n) _Pragma("unroll") for (int k = 0; k < 2; ++k) dst[n][k] = lds_rd16((const PG8_LAS bf16x8*)(lds + PG8_SB(b, h) + boff + n * 2048 + k * 1024)); } while (0)
#define PG8_MMA(ai, bj, At, Bt) do { __builtin_amdgcn_s_setprio(1); _Pragma("unroll") for (int m = 0; m < 4; ++m) _Pragma("unroll") for (int n = 0; n < 2; ++n) { \
        if constexpr (F8) { const i32x8g a8_ = __builtin_shufflevector(__builtin_bit_cast(i32x4g, At[m][0]), __builtin_bit_cast(i32x4g, At[m][1]), 0, 1, 2, 3, 4, 5, 6, 7); \
                            const i32x8g b8_ = __builtin_shufflevector(__builtin_bit_cast(i32x4g, Bt[n][0]), __builtin_bit_cast(i32x4g, Bt[n][1]), 0, 1, 2, 3, 4, 5, 6, 7); \
                            acc[ai][bj][m][n] = __builtin_amdgcn_mfma_scale_f32_16x16x128_f8f6f4(b8_, a8_, acc[ai][bj][m][n], 0, 0, 0, 0x7f7f7f7f, 0, 0x7f7f7f7f); } \
        else { _Pragma("unroll") for (int k = 0; k < 2; ++k) acc[ai][bj][m][n] = __builtin_amdgcn_mfma_f32_16x16x32_bf16(Bt[n][k], At[m][k], acc[ai][bj][m][n], 0, 0, 0); } } \
        __builtin_amdgcn_s_setprio(0); } while (0)
#define PG8_WAIT_V(n) asm volatile("s_waitcnt vmcnt(" #n ")" ::: "memory")
#define PG8_WAIT_L(n) asm volatile("s_waitcnt lgkmcnt(" #n ")" ::: "memory")
#define PG8_BAR __builtin_amdgcn_s_barrier()
#define PG8_SCHED __builtin_amdgcn_sched_barrier(0)
    Unit cur, nxt; int ui = 0;
    if (!S.next(0, cur)) return;
    f32x4 acc[2][2][4][2];
#pragma unroll
    for (int a = 0; a < 2; ++a)
#pragma unroll
        for (int b = 0; b < 2; ++b)
#pragma unroll
            for (int m = 0; m < 4; ++m)
#pragma unroll
                for (int n = 0; n < 2; ++n) acc[a][b][m][n] = (f32x4){0.f, 0.f, 0.f, 0.f};
    bf16x8 At[4][2], B0[2][2], B1[2][2];
    const char* cA = (const char*)g.A + (size_t)cur.pm * tstep; const char* cB = (const char*)g.Bt + (size_t)cur.pn * tstep;
    S.a_ready(cur);
    if constexpr (SP2) {
        PG8_STAGE(PG8_SB(0, 0), cB, voffB); PG8_STAGE(PG8_SB(0, 1), cB + hstep, voffB); PG8_STAGE(PG8_SA(0, 0), cA, voffA); PG8_STAGE(PG8_SA(0, 1), cA + hstep, voffA);
        if (wr == 1) PG8_BAR;
        PG8_WAIT_V(2); PG8_BAR;
        PG8_STAGE(PG8_SB(1, 0), cB + kstep, voffB); PG8_STAGE(PG8_SA(1, 0), cA + kstep, voffA); PG8_STAGE(PG8_SB(1, 1), cB + hstep + kstep, voffB);
        PG8_WAIT_V(6); PG8_BAR;
    } else {
        PG8_STAGE(PG8_SB(0, 0), cB, voffB); PG8_STAGE(PG8_SA(0, 0), cA, voffA); PG8_STAGE(PG8_SB(0, 1), cB + hstep, voffB); PG8_STAGE(PG8_SA(0, 1), cA + hstep, voffA);
        if (wr == 1) PG8_BAR;
        PG8_WAIT_V(4); PG8_BAR;
        PG8_STAGE(PG8_SB(1, 0), cB + kstep, voffB); PG8_STAGE(PG8_SA(1, 0), cA + kstep, voffA); PG8_STAGE(PG8_SB(1, 1), cB + hstep + kstep, voffB);
        PG8_WAIT_V(6); PG8_BAR;
    }
    for (;;) {
        const bool has_next = S.next(ui + 1, nxt);
        const char* nA = has_next ? (const char*)g.A + (size_t)nxt.pm * tstep : cA; const char* nB = has_next ? (const char*)g.Bt + (size_t)nxt.pn * tstep : cB;
#pragma unroll 1
        for (int t = 0; t < nt; t += 2) {
            const bool last = (t == nt - 2);
            const char* a1 = cA + (size_t)(t + 1) * kstep;
            const char* a2 = last ? nA : cA + (size_t)(t + 2) * kstep; const char* b2 = last ? nB : cB + (size_t)(t + 2) * kstep;
            const char* a3 = a2 + kstep; const char* b3 = b2 + kstep;
            if (last && has_next) S.a_ready(nxt);
            if constexpr (SP2) {
            PG8_LDB(B0, 0, 0); PG8_LDB(B1, 0, 1); PG8_SCHED; PG8_LDA(At, 0, 0); PG8_STAGE(PG8_SA(1, 1), a1 + hstep, voffA);
            PG8_WAIT_V(8); PG8_WAIT_L(0); PG8_BAR; PG8_MMA(0, 0, At, B0); PG8_MMA(0, 1, At, B1); PG8_BAR; PG8_SCHED;
            PG8_LDA(At, 0, 1); PG8_STAGE(PG8_SB(0, 0), b2, voffB); PG8_STAGE(PG8_SB(0, 1), b2 + hstep, voffB); PG8_STAGE(PG8_SA(0, 0), a2, voffA);
            PG8_WAIT_V(8); PG8_WAIT_L(0); PG8_BAR; PG8_MMA(1, 0, At, B0); PG8_MMA(1, 1, At, B1); PG8_BAR; PG8_SCHED;
            PG8_LDB(B0, 1, 0); PG8_LDB(B1, 1, 1); PG8_SCHED; PG8_LDA(At, 1, 0); PG8_STAGE(PG8_SA(0, 1), a2 + hstep, voffA);
            PG8_WAIT_V(8); PG8_WAIT_L(0); PG8_BAR; PG8_MMA(0, 0, At, B0); PG8_MMA(0, 1, At, B1); PG8_BAR; PG8_SCHED;
            PG8_LDA(At, 1, 1); PG8_STAGE(PG8_SB(1, 0), b3, voffB); PG8_STAGE(PG8_SB(1, 1), b3 + hstep, voffB); PG8_STAGE(PG8_SA(1, 0), a3, voffA);
            PG8_WAIT_V(8); PG8_WAIT_L(0); PG8_BAR; PG8_MMA(1, 0, At, B0); PG8_MMA(1, 1, At, B1); PG8_BAR; PG8_SCHED;
            } else {
            PG8_LDB(B0, 0, 0); PG8_SCHED; PG8_LDA(At, 0, 0); PG8_STAGE(PG8_SA(1, 1), a1 + hstep, voffA);
            PG8_WAIT_L(8); PG8_BAR; PG8_WAIT_L(0); PG8_MMA(0, 0, At, B0); PG8_BAR; PG8_SCHED;
            PG8_LDB(B1, 0, 1); PG8_STAGE(PG8_SB(0, 0), b2, voffB);
            PG8_BAR; PG8_WAIT_L(0); PG8_MMA(0, 1, At, B1); PG8_BAR;
            PG8_LDA(At, 0, 1); PG8_STAGE(PG8_SA(0, 0), a2, voffA);
            PG8_BAR; PG8_WAIT_L(0); PG8_MMA(1, 0, At, B0); PG8_BAR; PG8_SCHED;
            PG8_STAGE(PG8_SB(0, 1), b2 + hstep, voffB);
            PG8_WAIT_V(6); PG8_BAR; PG8_MMA(1, 1, At, B1); PG8_BAR;
            PG8_LDB(B0, 1, 0); PG8_SCHED; PG8_LDA(At, 1, 0); PG8_STAGE(PG8_SA(0, 1), a2 + hstep, voffA);
            PG8_WAIT_L(8); PG8_BAR; PG8_WAIT_L(0); PG8_MMA(0, 0, At, B0); PG8_BAR; PG8_SCHED;
            PG8_LDB(B1, 1, 1); PG8_STAGE(PG8_SB(1, 0), b3, voffB);
            PG8_BAR; PG8_WAIT_L(0); PG8_MMA(0, 1, At, B1); PG8_BAR;
            PG8_LDA(At, 1, 1); PG8_STAGE(PG8_SA(1, 0), a3, voffA);
            PG8_BAR; PG8_WAIT_L(0); PG8_MMA(1, 0, At, B0); PG8_BAR; PG8_SCHED;
            PG8_STAGE(PG8_SB(1, 1), b3 + hstep, voffB);
            PG8_WAIT_V(6); PG8_BAR; PG8_MMA(1, 1, At, B1); PG8_BAR;
            }
        }
        if constexpr (ALIGN_EPI) { if (wr == 0) PG8_BAR; }
        if constexpr (!Epi::AFTER_DRAIN) { int ln_; asm volatile("v_mbcnt_lo_u32_b32 %0, -1, 0\n\tv_mbcnt_hi_u32_b32 %0, -1, %0" : "=v"(ln_));
            E(acc, cur, wr, wc, ln_ & 15, ln_ >> 4); S.done(cur); }
        if (!has_next) break;
#pragma unroll
        for (int a = 0; a < 2; ++a)
#pragma unroll
            for (int b = 0; b < 2; ++b)
#pragma unroll
                for (int m = 0; m < 4; ++m)
#pragma unroll
                    for (int n = 0; n < 2; ++n) acc[a][b][m][n] = (f32x4){0.f, 0.f, 0.f, 0.f};
        cur = nxt; cA = nA; cB = nB; ++ui;
        if constexpr (ALIGN_EPI) { if (wr == 1) PG8_BAR; }
    }
    PG8_WAIT_V(0);
    if constexpr (!ALIGN_EPI) { if (wr == 0) PG8_BAR; }
    PG8_BAR;
    if constexpr (Epi::AFTER_DRAIN) { E.fused(acc, cur, wr, wc, fr, fq, lds, wid, lane); S.done(cur); }
#undef PG8_SA
#undef PG8_SB
#undef PG8_STAGE
#undef PG8_LDA
#undef PG8_LDB
#undef PG8_MMA
#undef PG8_WAIT_V
#undef PG8_WAIT_L
#undef PG8_BAR
#undef PG8_SCHED
}
}

constexpr int NB = 8, SEQ = 4096, DM = 2048, TOK = NB * SEQ;
constexpr int NWAVES = 8;
constexpr float LN_EPS = 1e-5f;
constexpr float DN_ALPHA = 1.189207115002721f;
constexpr float LOG2E = 1.4426950408889634f;
constexpr float QSCALE_A = 0.08838834764831845f * LOG2E;
constexpr float QSCALE_B = 0.07216878364870322f * LOG2E;

constexpr size_t MiB = 1u << 20;
constexpr size_t WS_CTL = 0, CTL_ZERO_BYTES = 1 * MiB;
constexpr size_t WS_WIN = 1 * MiB;
constexpr size_t WS_WKR = 33 * MiB;
constexpr size_t WS_WUQ = 34 * MiB;
constexpr size_t WS_WUKV = 36 * MiB;
constexpr size_t WS_WPA = 38 * MiB;
constexpr size_t WS_WPB = 42 * MiB;
constexpr size_t WS_WO = 46 * MiB;
constexpr size_t WS_WSK = 54 * MiB;
constexpr size_t WS_MOD = 62 * MiB;
constexpr size_t WS_BIAS = 62 * MiB + 512 * 1024;
constexpr size_t WS_LN1 = 63 * MiB;
constexpr size_t WS_UT = 64 * MiB;
constexpr size_t WS_VT = 96 * MiB;
constexpr size_t WS_TSCALE = 62 * MiB + 768 * 1024;
constexpr size_t WS_W8 = 80 * MiB;
constexpr size_t WS_HSC = 63 * MiB + 512 * 1024;
constexpr size_t WS_WUQ8 = 121 * MiB;
constexpr size_t WS_WUKV8 = 122 * MiB;
constexpr size_t WS_WKR8 = 112 * MiB;
constexpr size_t WS_WPA8 = 113 * MiB;
constexpr size_t WS_WPB8 = 115 * MiB;
constexpr size_t WS_WO8 = 117 * MiB;
constexpr size_t WS_H8 = 128 * MiB;
constexpr size_t WS_H = 192 * MiB;
constexpr size_t WS_QKVA = 320 * MiB;
constexpr size_t WS_SCORE = 320 * MiB;
constexpr size_t WS_CQ = 512 * MiB;
constexpr size_t WS_CKV = 544 * MiB;
constexpr size_t WS_U1B = 576 * MiB;
constexpr size_t WS_QN = 576 * MiB;
constexpr size_t WS_QR = 640 * MiB;
constexpr size_t WS_KN = 672 * MiB;
constexpr size_t WS_VB = 736 * MiB;
constexpr size_t WS_KR = 800 * MiB;
constexpr size_t WS_YA = 804 * MiB;
constexpr size_t WS_YB = 868 * MiB;
constexpr size_t WS_CS = 932 * MiB;
constexpr size_t WS_SSQ = 940 * MiB;
constexpr size_t WS_END = 942 * MiB;
constexpr size_t WS_IDS = 736 * MiB;
constexpr size_t WS_GATES = 744 * MiB;
constexpr size_t WS_W = 760 * MiB;
constexpr size_t WS_WSC = 768 * MiB;
constexpr size_t WS_SX = 776 * MiB;
constexpr size_t WS_S8 = 776 * MiB + 128 * 1024;
constexpr size_t WS_PA = 320 * MiB;
constexpr size_t WS_XH = 804 * MiB;
constexpr size_t WS_XL = 836 * MiB;
constexpr size_t WS_ST2 = 778 * MiB;
constexpr size_t WS_IDT = 780 * MiB;
constexpr size_t UT_SLICE = 2 * MiB;
constexpr int CW_BAR = 4096;
constexpr int CW_WMAX = 8;
constexpr float ACT_C = 16.0f;
constexpr float ACT_Y = 32.0f, ACT_MIX = 64.0f;
constexpr int CW_WMAX0 = 8;

constexpr int RING_BYTES = 131072;
constexpr int MISC_OFF = RING_BYTES + 320;
constexpr int LDS_BYTES = 147456;

#define GAS __attribute__((address_space(1)))
#define LAS __attribute__((address_space(3)))
typedef unsigned short bf16;
typedef unsigned v4u __attribute__((ext_vector_type(4)));
typedef unsigned v2u __attribute__((ext_vector_type(2)));
typedef float f32x4 __attribute__((ext_vector_type(4)));
typedef float f32x16 __attribute__((ext_vector_type(16)));
typedef short bf16x8 __attribute__((ext_vector_type(8)));
typedef short s16x4 __attribute__((ext_vector_type(4)));
typedef __bf16 bf16x2_t __attribute__((ext_vector_type(2)));
#define LDS_WAIT() asm volatile("s_waitcnt lgkmcnt(0)" ::: "memory")
#define VM_WAIT() asm volatile("s_waitcnt vmcnt(0)" ::: "memory")
__device__ __forceinline__ unsigned f2bf(float f) { unsigned u = __builtin_bit_cast(unsigned, f); return (u + 0x7fffu + ((u >> 16) & 1u)) >> 16; }
__device__ __forceinline__ unsigned pk2(float lo, float hi) { return f2bf(lo) | (f2bf(hi) << 16); }
#define WRED_DPP(v, ctrl) __builtin_amdgcn_update_dpp(0, (v), (ctrl), 0xF, 0xF, true)
__device__ __forceinline__ float wave_sum(float v) {
    v += __int_as_float(WRED_DPP(__float_as_int(v), 0xB1)); v += __int_as_float(WRED_DPP(__float_as_int(v), 0x4E));
    v += __int_as_float(WRED_DPP(__float_as_int(v), 0x141)); v += __int_as_float(WRED_DPP(__float_as_int(v), 0x140));
    { const auto r = __builtin_amdgcn_permlane16_swap(__float_as_uint(v), __float_as_uint(v), false, false); v = __uint_as_float(r[0]) + __uint_as_float(r[1]); }
    { const auto r = __builtin_amdgcn_permlane32_swap(__float_as_uint(v), __float_as_uint(v), false, false); v = __uint_as_float(r[0]) + __uint_as_float(r[1]); }
    return v;
}
__device__ __forceinline__ float wave_max(float v) {
    v = fmaxf(v, __int_as_float(WRED_DPP(__float_as_int(v), 0xB1))); v = fmaxf(v, __int_as_float(WRED_DPP(__float_as_int(v), 0x4E)));
    v = fmaxf(v, __int_as_float(WRED_DPP(__float_as_int(v), 0x141))); v = fmaxf(v, __int_as_float(WRED_DPP(__float_as_int(v), 0x140)));
    { const auto r = __builtin_amdgcn_permlane16_swap(__float_as_uint(v), __float_as_uint(v), false, false); v = fmaxf(__uint_as_float(r[0]), __uint_as_float(r[1])); }
    { const auto r = __builtin_amdgcn_permlane32_swap(__float_as_uint(v), __float_as_uint(v), false, false); v = fmaxf(__uint_as_float(r[0]), __uint_as_float(r[1])); }
    return v;
}
__device__ __forceinline__ int wave_sum_int(int v) {
    v += WRED_DPP(v, 0xB1); v += WRED_DPP(v, 0x4E); v += WRED_DPP(v, 0x141); v += WRED_DPP(v, 0x140);
    { const auto r = __builtin_amdgcn_permlane16_swap((unsigned)v, (unsigned)v, false, false); v = (int)(r[0] + r[1]); }
    { const auto r = __builtin_amdgcn_permlane32_swap((unsigned)v, (unsigned)v, false, false); v = (int)(r[0] + r[1]); }
    return v;
}
__device__ __forceinline__ float bflo(unsigned w) { return __uint_as_float(w << 16); }
__device__ __forceinline__ float bfhi(unsigned w) { return __uint_as_float(w & 0xffff0000u); }

#define XB_TMO      128
#define XB_XCNT(j)  (256  + 64 * (j))
#define XB_XSUB(j)  (1280 + 64 * (j))
#define XB_XGEN(j)  (2304 + 64 * (j))
#define XB_TOP      3328
#define XB_TOPGEN   3392
#define XCD_BAR_WORDS 3456
#define XB_SPIN_CAP (1u << 18)

__device__ __forceinline__ unsigned xb_ld(unsigned* p)              { return __hip_atomic_load(p, __ATOMIC_RELAXED, __HIP_MEMORY_SCOPE_AGENT); }
__device__ __forceinline__ unsigned xb_add(unsigned* p, unsigned v) { return __hip_atomic_fetch_add(p, v, __ATOMIC_RELAXED, __HIP_MEMORY_SCOPE_AGENT); }
__device__ __forceinline__ unsigned xb_xcc_id() { return (unsigned)__builtin_amdgcn_s_getreg((3 << 11) | 20) & 0xFu; }
#define XB_SPIN(cond, bar) do { unsigned _sp = 0; while (cond) { __builtin_amdgcn_s_sleep(1); \
    if ((++_sp & 255u) == 0u) { if (xb_ld(&(bar)[XB_TMO])) break; if (_sp > XB_SPIN_CAP) { atomicAdd(&(bar)[XB_TMO], 1u); break; } } } } while (0)

struct XcdBarrier {
    unsigned* bar; unsigned x;
    volatile LAS unsigned* st;
    bool w0;
};
__device__ __forceinline__ bool xb_thread0(bool w0) { return w0 && __builtin_amdgcn_mbcnt_hi(~0u, __builtin_amdgcn_mbcnt_lo(~0u, 0u)) == 0u; }

__device__ __forceinline__ XcdBarrier xcd_barrier_post(unsigned* bar, volatile LAS unsigned* st, bool w0) {
    XcdBarrier b; b.bar = bar; b.x = xb_xcc_id(); b.st = st; b.w0 = w0;
    if (xb_thread0(w0)) (void)xb_add(&bar[XB_XCNT(b.x)], 1u);
    return b;
}
__device__ __forceinline__ void xcd_barrier_complete(unsigned* bar, unsigned x, unsigned& nloc, unsigned& nx) {
    const unsigned G = gridDim.x * gridDim.y * gridDim.z;
    unsigned sum, cnt, mine, sp = 0u;
    for (;;) {
        sum = 0u; cnt = 0u; mine = 0u;
#pragma unroll
        for (unsigned j = 0; j < 16; ++j) { const unsigned c = xb_ld(&bar[XB_XCNT(j)]); sum += c; cnt += (c > 0u) ? 1u : 0u; mine = (j == x) ? c : mine; }
        if (sum == G) break;
        __builtin_amdgcn_s_sleep(1);
        if ((++sp & 255u) == 0u) { if (xb_ld(&bar[XB_TMO])) break; if (sp > XB_SPIN_CAP) { atomicAdd(&bar[XB_TMO], 1u); break; } }
    }
    nloc = mine > 0u ? mine : 1u; nx = cnt > 0u ? cnt : 1u;
}

__device__ __forceinline__ void xcd_barrier(const XcdBarrier& b) {
    asm volatile("s_waitcnt vmcnt(0)" ::: "memory");
    __syncthreads();
    if (xb_thread0(b.w0)) {
        unsigned* bar = b.bar;
        __builtin_amdgcn_s_waitcnt(0);
        unsigned nloc = b.st[0], nx = b.st[1];
        if (nloc == 0u) { xcd_barrier_complete(bar, b.x, nloc, nx); b.st[0] = nloc; b.st[1] = nx; }
        const unsigned old = xb_add(&bar[XB_XSUB(b.x)], 1u);
        const unsigned gen = old / nloc;
        if (old + 1u == (gen + 1u) * nloc) {
            __builtin_amdgcn_fence(__ATOMIC_RELEASE, "agent");
            asm volatile("s_waitcnt vmcnt(0)" ::: "memory");
            const unsigned og = xb_add(&bar[XB_TOP], 1u);
            const unsigned tg = og / nx;
            if (og + 1u == (tg + 1u) * nx) xb_add(&bar[XB_TOPGEN], 1u);
            else XB_SPIN(xb_ld(&bar[XB_TOPGEN]) == tg, bar);
            __builtin_amdgcn_fence(__ATOMIC_ACQUIRE, "agent");
            xb_add(&bar[XB_XGEN(b.x)], 1u);
            asm volatile("s_waitcnt vmcnt(0)" ::: "memory");
        } else {
            XB_SPIN(xb_ld(&bar[XB_XGEN(b.x)]) == gen, bar);
            __builtin_amdgcn_fence(__ATOMIC_ACQUIRE, "agent");
            asm volatile("s_waitcnt vmcnt(0)" ::: "memory");
        }
    }
    __syncthreads();
}

namespace att {
constexpr int SHM_V = 16384, SHM_KN = 16384, SHM_KR = 8192, BUFB = SHM_V + SHM_KN + SHM_KR;
constexpr int OFF_V = 0, OFF_KN = SHM_V, OFF_KR = SHM_V + SHM_KN;
constexpr int NSLOT = 3;
constexpr int OFF_WS = NSLOT * BUFB, OFF_BIAS = OFF_WS + 2048, ATT_LDS = OFF_BIAS + 1280;
static_assert(ATT_LDS <= RING_BYTES, "attention LDS");
#define KSWZ(row, colB) ((row) * 256 + ((colB) ^ (((row) & 15) << 4)))
#define KRSWZ(row, colB) ((row) * 128 + ((colB) ^ ((((row) >> 1) & 7) << 4)))
__device__ __forceinline__ int v_st(int k, int c) { const int kk = (k & ~0xC) | ((k & 4) << 1) | ((k & 8) >> 1); return ((kk >> 3) * 4 + (c >> 5)) * 512 + ((kk & 7) * 32 + (c & 31)) * 2; }
__device__ __forceinline__ int v_rd_base(int lane) { return ((lane & 3) << 3) | (((lane >> 2) & 3) << 6) | (((lane >> 4) & 1) << 5) | (((lane >> 5) & 1) << 8); }
__device__ __forceinline__ int crow(int r, int hi) { return (r & 3) + 8 * (r >> 2) + 4 * hi; }
__device__ __forceinline__ unsigned cvtpk(float lo, float hi) { return pg8::cvt_pk_bf16(lo, hi); }
constexpr float THR = 8.0f;

template <int MODE>
__device__ __forceinline__ void attn_unit(LAS unsigned char* lds, int b, int h, int qb, const bf16* __restrict__ Qn, const bf16* __restrict__ Qr, const bf16* __restrict__ Kn,
                                          const bf16* __restrict__ Kr, const bf16* __restrict__ V, bf16* __restrict__ O, const float* __restrict__ relb, const int tid_in) {
    constexpr int ND = MODE ? 12 : 8;
    int tid = tid_in; asm volatile("" : "+v"(tid));
    const int wid = __builtin_amdgcn_readfirstlane(tid >> 6), lane = tid & 63, r32 = lane & 31, hi = lane >> 5;
    const int tb = b * SEQ, cw = 4 * qb + (wid >> 1);
    const int j_lo = MODE ? 0 : (4 * qb - 8 > 0 ? 4 * qb - 8 : 0), j_hi = 4 * qb + 4, NTL = j_hi - j_lo;
    bf16x8 qr[ND];
    { const size_t qrow = (size_t)(tb + 256 * qb + 32 * wid + r32);
#pragma unroll
      for (int d0 = 0; d0 < 8; ++d0) qr[d0] = *(const bf16x8*)(Qn + qrow * 1024 + h * 128 + d0 * 16 + hi * 8);
      if constexpr (MODE == 1) {
#pragma unroll
          for (int d0 = 0; d0 < 4; ++d0) qr[8 + d0] = *(const bf16x8*)(Qr + qrow * 512 + h * 64 + d0 * 16 + hi * 8); } }
    unsigned gk[2], gv[2], gkr;
#pragma unroll
    for (int i = 0; i < 2; ++i) { const int p = 2 * wid + i; const int row = 4 * p + (lane >> 4), colB = ((lane & 15) << 4) ^ ((row & 15) << 4);
        gk[i] = (unsigned)(row * 2048 + colB);
        const int st = 2 * p + (lane >> 5), kk = (st >> 2) * 8 + ((lane & 31) >> 2), c = (st & 3) * 32 + (lane & 3) * 8, k = (kk & ~0xC) | ((kk & 4) << 1) | ((kk & 8) >> 1);
        gv[i] = (unsigned)(k * 2048 + c * 2); }
    { const int row = 8 * wid + (lane >> 3), colB = ((lane & 7) << 4) ^ (((row >> 1) & 7) << 4); gkr = (unsigned)(row * 128 + colB); }
    const char* Kg = (const char*)(Kn + (size_t)tb * 1024 + h * 128); const char* Vg = (const char*)(V + (size_t)tb * 1024 + h * 128); const char* Krg = (const char*)(Kr + (size_t)tb * 64);
#define ATT_STAGE(j, bo) do { const size_t to_ = (size_t)(j) * (64 * 2048); \
        __builtin_amdgcn_global_load_lds((const unsigned*)(Kg + to_ + gk[0]), (LAS unsigned*)(lds + (bo) + OFF_KN + wid * 2048), 16, 0, 0); \
        __builtin_amdgcn_global_load_lds((const unsigned*)(Kg + to_ + gk[1]), (LAS unsigned*)(lds + (bo) + OFF_KN + wid * 2048 + 1024), 16, 0, 0); \
        __builtin_amdgcn_global_load_lds((const unsigned*)(Vg + to_ + gv[0]), (LAS unsigned*)(lds + (bo) + OFF_V + wid * 2048), 16, 0, 0); \
        __builtin_amdgcn_global_load_lds((const unsigned*)(Vg + to_ + gv[1]), (LAS unsigned*)(lds + (bo) + OFF_V + wid * 2048 + 1024), 16, 0, 0); \
        if constexpr (MODE == 1) __builtin_amdgcn_global_load_lds((const unsigned*)(Krg + (size_t)(j) * (64 * 128) + gkr), (LAS unsigned*)(lds + (bo) + OFF_KR + wid * 1024), 16, 0, 0); } while (0)
    float m_reg = -1e30f, l_reg = 0.f; f32x16 o[4] = {};
    LAS float* li_l = (LAS float*)(lds + OFF_WS) + wid * 64; LAS float* al_l = li_l + 32;
    const LAS float* biasL = (const LAS float*)(lds + OFF_BIAS);
    if constexpr (MODE == 0) { if (tid < 320) ((LAS float*)(lds + OFF_BIAS))[tid] = relb[tid] * LOG2E; }
    int kb[8], krb[4];
#pragma unroll
    for (int dd = 0; dd < 4; ++dd) { kb[dd] = OFF_KN + KSWZ(r32, (dd * 16 + hi * 8) * 2); kb[4 + dd] = OFF_KN + KSWZ(r32, 128 + (dd * 16 + hi * 8) * 2); krb[dd] = OFF_KR + KRSWZ(r32, dd * 32 + hi * 16); }
    const unsigned vb0 = (unsigned)(uintptr_t)lds + OFF_V + v_rd_base(lane);
    constexpr int NDMA = MODE ? 5 : 4;
    ATT_STAGE(j_lo, 0);
    if (NTL > 1) { ATT_STAGE(j_lo + 1, BUFB); asm volatile("s_waitcnt vmcnt(%0)" :: "i"(NDMA) : "memory"); } else VM_WAIT();
    __syncthreads();
    int bo = 0, bo2 = 2 * BUFB;
    for (int t = 0; t < NTL; ++t) {
        const int j = j_lo + t;
        if (t + 2 < NTL) ATT_STAGE(j + 2, bo2);
        const bool act = MODE ? (j <= cw) : (j <= cw && j >= cw - 8);
        if (act) {
            f32x16 p0 = {}, p1 = {};
            { bf16x8 kf[2][2];
              unsigned kad[8], krad[4];
#pragma unroll
              for (int dd = 0; dd < 4; ++dd) { kad[dd] = (unsigned)(uintptr_t)lds + (unsigned)bo + (unsigned)kb[dd]; kad[4 + dd] = (unsigned)(uintptr_t)lds + (unsigned)bo + (unsigned)kb[4 + dd]; krad[dd] = (unsigned)(uintptr_t)lds + (unsigned)bo + (unsigned)krb[dd]; }
#define ATT_KRD(dst, ad, off) asm volatile("ds_read_b128 %0, %1 offset:%2" : "=&v"(dst) : "v"(ad), "i"(off) : "memory")
#define ATT_KLD(d0_, s_) do { if ((d0_) < 8) { ATT_KRD(kf[s_][0], kad[(d0_) & 7], 0); ATT_KRD(kf[s_][1], kad[(d0_) & 7], 32 * 256); } \
                                  else { ATT_KRD(kf[s_][0], krad[((d0_) - 8) & 3], 0); ATT_KRD(kf[s_][1], krad[((d0_) - 8) & 3], 32 * 128); } } while (0)
              ATT_KLD(0, 0);
#pragma unroll
              for (int d0 = 0; d0 < ND; ++d0) {
                  if (d0 + 1 < ND) { ATT_KLD(d0 + 1, (d0 + 1) & 1); asm volatile("s_waitcnt lgkmcnt(2)" ::: "memory"); } else { asm volatile("s_waitcnt lgkmcnt(0)" ::: "memory"); }
                  __builtin_amdgcn_sched_barrier(0);
                  p0 = __builtin_amdgcn_mfma_f32_32x32x16_bf16(kf[d0 & 1][0], qr[d0], p0, 0, 0, 0); p1 = __builtin_amdgcn_mfma_f32_32x32x16_bf16(kf[d0 & 1][1], qr[d0], p1, 0, 0, 0);
                  __builtin_amdgcn_sched_barrier(0); }
#undef ATT_KLD
#undef ATT_KRD
            }
            if constexpr (MODE == 0) {
                const int dc = cw - j;
                if (dc >= 5) { const float bc = biasL[319];
#pragma unroll
                    for (int r = 0; r < 16; ++r) { p0[r] += bc; p1[r] += bc; } }
                else { const int base = 64 * dc + 32 * (wid & 1) + r32 - 4 * hi;
#pragma unroll
                    for (int r = 0; r < 16; ++r) { const int rel0 = base - ((r & 3) + 8 * (r >> 2)); int i0 = rel0 < -63 ? -63 : rel0; i0 = i0 > 256 ? 256 : i0; int i1 = rel0 - 32 < -63 ? -63 : rel0 - 32; i1 = i1 > 256 ? 256 : i1;
                        p0[r] += biasL[i0 + 63]; p1[r] += biasL[i1 + 63]; } }
            }
            float pmax = p0[0];
#pragma unroll
            for (int r = 1; r < 16; ++r) pmax = fmaxf(pmax, p0[r]);
#pragma unroll
            for (int r = 0; r < 16; ++r) pmax = fmaxf(pmax, p1[r]);
            { auto rr = __builtin_amdgcn_permlane32_swap(__float_as_uint(pmax), __float_as_uint(pmax), false, false); pmax = fmaxf(__uint_as_float(rr[0]), __uint_as_float(rr[1])); }
            float mn, alpha;
            if (__all((pmax - m_reg) <= THR)) { mn = m_reg; alpha = 1.f; }
            else { mn = fmaxf(m_reg, pmax); alpha = __builtin_amdgcn_exp2f(m_reg - mn); m_reg = mn; }
#pragma unroll
            for (int r = 0; r < 16; ++r) { p0[r] = __builtin_amdgcn_exp2f(p0[r] - mn); p1[r] = __builtin_amdgcn_exp2f(p1[r] - mn); }
            float ps = 0.f;
#pragma unroll
            for (int r = 0; r < 16; ++r) ps += p0[r];
#pragma unroll
            for (int r = 0; r < 16; ++r) ps += p1[r];
            { auto rr = __builtin_amdgcn_permlane32_swap(__float_as_uint(ps), __float_as_uint(ps), false, false); ps = __uint_as_float(rr[0]) + __uint_as_float(rr[1]); }
            l_reg = l_reg * alpha + ps;
            bf16x8 pa0, pa1, pa2, pa3;
#define ATT_PK4(P, B_, OUT) do { unsigned a0 = cvtpk(P[B_+0], P[B_+1]), a1 = cvtpk(P[B_+2], P[B_+3]); unsigned b0 = cvtpk(P[B_+4], P[B_+5]), b1 = cvtpk(P[B_+6], P[B_+7]); \
        auto r0 = __builtin_amdgcn_permlane32_swap(a0, b0, false, false); auto r1 = __builtin_amdgcn_permlane32_swap(a1, b1, false, false); \
        v4u w = {r0[0], r1[0], r0[1], r1[1]}; OUT = __builtin_bit_cast(bf16x8, w); } while (0)
            ATT_PK4(p0, 0, pa0); ATT_PK4(p0, 8, pa1); ATT_PK4(p1, 0, pa2); ATT_PK4(p1, 8, pa3);
#undef ATT_PK4
            if (__any(alpha < 1.f)) { if (hi == 0) al_l[r32] = alpha; LDS_WAIT();
#pragma unroll
                for (int r = 0; r < 16; ++r) { const float a = al_l[crow(r, hi)];
#pragma unroll
                    for (int d = 0; d < 4; ++d) o[d][r] *= a; } }
            const unsigned vb = vb0 + (unsigned)bo;
#define ATT_TRRD(dst, off) asm volatile("ds_read_b64_tr_b16 %0, %1 offset:%2" : "=&v"(dst) : "v"(vb), "i"(off) : "memory")
#define ATT_VLD(d0, L) do { constexpr int b_ = (d0) * 512; ATT_TRRD(L[0], b_); ATT_TRRD(L[4], b_ + 2048); ATT_TRRD(L[1], b_ + 4096); ATT_TRRD(L[5], b_ + 6144); ATT_TRRD(L[2], b_ + 8192); ATT_TRRD(L[6], b_ + 10240); ATT_TRRD(L[3], b_ + 12288); ATT_TRRD(L[7], b_ + 14336); } while (0)
#define ATT_PVM(d0, L) do { \
        o[d0] = __builtin_amdgcn_mfma_f32_32x32x16_bf16(pa0, (bf16x8){L[0][0], L[0][1], L[0][2], L[0][3], L[4][0], L[4][1], L[4][2], L[4][3]}, o[d0], 0, 0, 0); \
        o[d0] = __builtin_amdgcn_mfma_f32_32x32x16_bf16(pa1, (bf16x8){L[1][0], L[1][1], L[1][2], L[1][3], L[5][0], L[5][1], L[5][2], L[5][3]}, o[d0], 0, 0, 0); \
        o[d0] = __builtin_amdgcn_mfma_f32_32x32x16_bf16(pa2, (bf16x8){L[2][0], L[2][1], L[2][2], L[2][3], L[6][0], L[6][1], L[6][2], L[6][3]}, o[d0], 0, 0, 0); \
        o[d0] = __builtin_amdgcn_mfma_f32_32x32x16_bf16(pa3, (bf16x8){L[3][0], L[3][1], L[3][2], L[3][3], L[7][0], L[7][1], L[7][2], L[7][3]}, o[d0], 0, 0, 0); } while (0)
            { s16x4 va[8], vb_[8];
              ATT_VLD(0, va);
              ATT_VLD(1, vb_); asm volatile("s_waitcnt lgkmcnt(8)" ::: "memory"); __builtin_amdgcn_sched_barrier(0); ATT_PVM(0, va); __builtin_amdgcn_sched_barrier(0);
              ATT_VLD(2, va);  asm volatile("s_waitcnt lgkmcnt(8)" ::: "memory"); __builtin_amdgcn_sched_barrier(0); ATT_PVM(1, vb_); __builtin_amdgcn_sched_barrier(0);
              ATT_VLD(3, vb_); asm volatile("s_waitcnt lgkmcnt(8)" ::: "memory"); __builtin_amdgcn_sched_barrier(0); ATT_PVM(2, va); __builtin_amdgcn_sched_barrier(0);
              asm volatile("s_waitcnt lgkmcnt(0)" ::: "memory"); __builtin_amdgcn_sched_barrier(0); ATT_PVM(3, vb_); }
#undef ATT_VLD
#undef ATT_PVM
#undef ATT_TRRD
        }
        if (t + 2 < NTL) asm volatile("s_waitcnt vmcnt(%0)" :: "i"(NDMA) : "memory"); else VM_WAIT();
        asm volatile("s_waitcnt lgkmcnt(0)" ::: "memory"); __builtin_amdgcn_s_barrier(); asm volatile("" ::: "memory");
        bo = (bo == 2 * BUFB) ? 0 : bo + BUFB; bo2 = (bo2 == 2 * BUFB) ? 0 : bo2 + BUFB;
    }
    if (hi == 0) li_l[r32] = l_reg; LDS_WAIT();
    { LAS unsigned char* ost = lds + wid * 4096;
#pragma unroll
      for (int r = 0; r < 16; ++r) { const int orow = crow(r, hi); const float rl = __builtin_amdgcn_rcpf(li_l[orow]) * ACT_Y;
#pragma unroll
          for (int d0 = 0; d0 < 4; ++d0) { const float v = o[d0][r] * rl; ost[orow * 128 + d0 * 32 + r32] = (unsigned char)(__builtin_amdgcn_cvt_pk_fp8_f32(v, v, 0, false) & 0xff); } }
      LDS_WAIT();
      unsigned char* Ow = (unsigned char*)O + (size_t)(tb + 256 * qb + 32 * wid) * 1024 + h * 128;
#pragma unroll
      for (int k = 0; k < 4; ++k) { const int idx = lane + 64 * k, row = idx >> 3, ch = idx & 7;
          const v4u val = *(const LAS v4u*)(lds + wid * 4096 + row * 128 + ch * 16);
          *(v4u*)(Ow + (size_t)row * 1024 + ch * 16) = val; } }
    __syncthreads();
#undef ATT_STAGE
}
#undef KSWZ
#undef KRSWZ
}


struct Args {
    const float *x, *c; const int* positions;
    const float *w_ada, *b_ada, *w_in, *b_in, *rel_bias, *q_norm_g, *kv_norm_g, *w_uq, *w_ukv, *w_pa, *w_pb, *w_o, *ln1_g, *ln1_b, *peer_wq, *peer_keys, *peer_u, *peer_v, *ln2_g, *ln2_b;
    float* out; unsigned char* ws; int ph_lo, ph_hi;
};

template <class SrcCol>
__device__ __forceinline__ void transpose_item(const float* __restrict__ W, int K, int N, bf16* __restrict__ WT, int nblk, LAS float* scr, int item, int lane, SrcCol srccol, const float* __restrict__ kscale, float* amax = nullptr) {
    const int kb = item / nblk, nb = item % nblk, k0 = 64 * kb, n0 = 32 * nb;
    const int scol = srccol(n0 + (lane & 31));
    float am = 0.f, vv[32];
    { const float* wp = W + (size_t)(k0 + (lane >> 5)) * N + scol;
#pragma unroll
      for (int i = 0; i < 32; ++i) vv[i] = __builtin_nontemporal_load(wp + (size_t)(2 * i) * N); }
#pragma unroll
    for (int i = 0; i < 32; ++i) { const int kk = 2 * i + (lane >> 5); float v = vv[i]; if (kscale) v *= kscale[k0 + kk]; scr[kk * 33 + (lane & 31)] = v; am = fmaxf(am, fabsf(v)); }
    if (amax) *amax = fmaxf(*amax, am);
    LDS_WAIT(); asm volatile("" ::: "memory");
    const int c = lane & 7;
#pragma unroll
    for (int j = 0; j < 4; ++j) { const int n = (lane >> 3) + 8 * j; const LAS float* s = scr + (8 * c) * 33 + n;
        v4u o; o.x = pk2(s[0 * 33], s[1 * 33]); o.y = pk2(s[2 * 33], s[3 * 33]); o.z = pk2(s[4 * 33], s[5 * 33]); o.w = pk2(s[6 * 33], s[7 * 33]);
        *(v4u*)(WT + (size_t)(n0 + n) * K + k0 + 8 * c) = o; }
    LDS_WAIT(); asm volatile("" ::: "memory");
}
struct ColIn { __device__ int operator()(int n) const { return n < 4096 ? n : n + 64; } };
struct ColKr { __device__ int operator()(int n) const { return 4096 + (n >> 1) + 32 * (n & 1); } };
struct ColUq { __device__ int operator()(int n) const { if (n < 1024) return (n >> 7) * 192 + (n & 127); const int r = n - 1024, hh = r >> 6, o = r & 63; return hh * 192 + 128 + (o >> 1) + 32 * (o & 1); } };
struct ColUkv { __device__ int operator()(int n) const { return n < 1024 ? (n >> 7) * 256 + (n & 127) : ((n - 1024) >> 7) * 256 + 128 + (n & 127); } };
struct ColId { __device__ int operator()(int n) const { return n; } };

__device__ __forceinline__ void p0_prologue(const Args& A, LAS unsigned char* lds, int tid, int lane, int wave, int vcu, int G) {
    unsigned char* ws = A.ws;
    {
        LAS float* sl = (LAS float*)lds;
        LAS float* red = (LAS float*)(lds + 65536);
        for (int i = tid; i < NB * DM; i += NWAVES * 64) { const int b = i >> 11, k = i & 2047; const float v = A.c[i]; sl[k * 8 + b] = v / (1.0f + __expf(-v)); }
        __syncthreads();
        float* mod = (float*)(ws + WS_MOD);
        for (int cb = blockIdx.x; cb < 256; cb += G) {
            const int r = lane / 12, c4 = lane % 12; const int col = cb * 48 + c4 * 4;
            float acc[8][4];
#pragma unroll
            for (int b = 0; b < 8; ++b)
#pragma unroll
                for (int i = 0; i < 4; ++i) acc[b][i] = 0.f;
            if (r < 5) {
#pragma unroll 4
                for (int kk = r; kk < 256; kk += 5) { const int k = wave * 256 + kk;
                    const f32x4 wv = __builtin_nontemporal_load((const f32x4*)(A.w_ada + (size_t)k * (6 * DM) + col));
                    const f32x4 s0 = *(const LAS f32x4*)(sl + k * 8), s1 = *(const LAS f32x4*)(sl + k * 8 + 4);
#pragma unroll
                    for (int i = 0; i < 4; ++i) { acc[0][i] += s0[0] * wv[i]; acc[1][i] += s0[1] * wv[i]; acc[2][i] += s0[2] * wv[i]; acc[3][i] += s0[3] * wv[i];
                                                  acc[4][i] += s1[0] * wv[i]; acc[5][i] += s1[1] * wv[i]; acc[6][i] += s1[2] * wv[i]; acc[7][i] += s1[3] * wv[i]; } }
#pragma unroll
                for (int i = 0; i < 4; ++i)
#pragma unroll
                    for (int b = 0; b < 8; ++b) red[((wave * 5 + r) * 48 + c4 * 4 + i) * 8 + b] = acc[b][i];
            }
            __syncthreads();
            if (tid < 384) { const int cc = tid >> 3, b = tid & 7; float s = 0.f;
                for (int p = 0; p < 40; ++p) s += red[(p * 48 + cc) * 8 + b];
                const int col2 = cb * 48 + cc; mod[(size_t)b * (6 * DM) + col2] = s + A.b_ada[col2]; }
            __syncthreads();
        }
    }
    const int gw = vcu * NWAVES + wave, NGW = G * NWAVES;
    {
        LAS float* scr = (LAS float*)(lds + wave * 16384);
        constexpr int I_IN = 32 * 256, I_KR = 32 * 2, I_UQ = 8 * 48, I_UKV = 8 * 64, I_PA = 16 * 64, I_PB = 16 * 64, I_O = 32 * 64;
        constexpr int NITEMS = I_IN + I_KR + I_UQ + I_UKV + I_PA + I_PB + I_O;
        float amx[6] = {0.f, 0.f, 0.f, 0.f, 0.f, 0.f};
        for (int it = gw; it < NITEMS; it += NGW) {
            int r = it;
            if (r < I_IN) { transpose_item(A.w_in, 2048, 8256, (bf16*)(ws + WS_WIN), 256, scr, r, lane, ColIn(), nullptr, &amx[0]); continue; } r -= I_IN;
            if (r < I_KR) { transpose_item(A.w_in, 2048, 8256, (bf16*)(ws + WS_WKR), 2, scr, r, lane, ColKr(), nullptr); continue; } r -= I_KR;
            if (r < I_UQ) { transpose_item(A.w_uq, 512, 1536, (bf16*)(ws + WS_WUQ), 48, scr, r, lane, ColUq(), A.q_norm_g, &amx[4]); continue; } r -= I_UQ;
            if (r < I_UKV) { transpose_item(A.w_ukv, 512, 2048, (bf16*)(ws + WS_WUKV), 64, scr, r, lane, ColUkv(), A.kv_norm_g, &amx[5]); continue; } r -= I_UKV;
            if (r < I_PA) { transpose_item(A.w_pa, 1024, 2048, (bf16*)(ws + WS_WPA), 64, scr, r, lane, ColId(), nullptr, &amx[1]); continue; } r -= I_PA;
            if (r < I_PB) { transpose_item(A.w_pb, 1024, 2048, (bf16*)(ws + WS_WPB), 64, scr, r, lane, ColId(), nullptr, &amx[2]); continue; } r -= I_PB;
            transpose_item(A.w_o, 2048, 2048, (bf16*)(ws + WS_WO), 64, scr, r, lane, ColId(), nullptr, &amx[3]);
        }
        { v4u* z = (v4u*)(ws + WS_WKR + (size_t)64 * 2048 * 2); const int n16 = 192 * 2048 * 2 / 16;
          for (int i = blockIdx.x * (NWAVES * 64) + tid; i < n16; i += G * NWAVES * 64) z[i] = (v4u){0u, 0u, 0u, 0u}; }
#pragma unroll
        for (int m = 0; m < 6; ++m) {
            amx[m] = wave_max(amx[m]); }
        if (lane == 0) {
#pragma unroll
            for (int m = 0; m < 6; ++m) scr[2112 + m] = amx[m]; }
    }
    __syncthreads();
    if (tid < 6) { float am = 0.f;
#pragma unroll
        for (int w = 0; w < NWAVES; ++w) am = fmaxf(am, ((LAS float*)(lds + w * 16384))[2112 + tid]);
        atomicMax((unsigned*)(ws + WS_CTL) + CW_WMAX + tid, __float_as_uint(am)); }
    __syncthreads();
    {
        LAS float* lk = (LAS float*)lds;
        LAS float* lw = (LAS float*)(lds + 128 * 129 * 4);
        bf16* wsk = (bf16*)(ws + WS_WSK);
        for (int it = vcu; it < 16 * 64; it += G) {
            const int hp = it >> 6, k0 = (it & 63) * 32;
            for (int idx = tid; idx < 16384; idx += NWAVES * 64) lk[(idx >> 7) * 129 + (idx & 127)] = A.peer_keys[(size_t)hp * 16384 + idx];
            for (int idx = tid; idx < 4096; idx += NWAVES * 64) lw[idx] = A.peer_wq[(size_t)(k0 + (idx >> 7)) * 2048 + hp * 128 + (idx & 127)];
            __syncthreads();
            const int n = tid & 127, kq = tid >> 7; float acc[8];
#pragma unroll
            for (int j = 0; j < 8; ++j) acc[j] = 0.f;
#pragma unroll 2
            for (int c4 = 0; c4 < 32; ++c4) { const float k0v = lk[n * 129 + 4 * c4], k1v = lk[n * 129 + 4 * c4 + 1], k2v = lk[n * 129 + 4 * c4 + 2], k3v = lk[n * 129 + 4 * c4 + 3];
#pragma unroll
                for (int j = 0; j < 8; ++j) { const f32x4 w4 = *(const LAS f32x4*)(lw + (kq * 8 + j) * 128 + 4 * c4); acc[j] += (k0v * w4[0] + k1v * w4[1]) + (k2v * w4[2] + k3v * w4[3]); } }
            v4u o; o.x = pk2(acc[0], acc[1]); o.y = pk2(acc[2], acc[3]); o.z = pk2(acc[4], acc[5]); o.w = pk2(acc[6], acc[7]);
            *(v4u*)(wsk + (size_t)(hp * 128 + n) * 2048 + k0 + kq * 8) = o;
            __syncthreads();
        }
    }
#pragma unroll 2
    for (int rw = gw; rw < 2 * 16384; rw += NGW) {
        const float* src = (rw < 16384 ? A.peer_u : A.peer_v) + (size_t)(rw & 16383) * 2048;
        unsigned char* dst = ws + (rw < 16384 ? WS_UT : WS_VT) + (size_t)(rw & 16383) * 1024;
        f32x4 v[8]; float am = 0.f;
#pragma unroll
        for (int q = 0; q < 8; ++q) { v[q] = __builtin_nontemporal_load((const f32x4*)(src + q * 256 + lane * 4)); am = fmaxf(am, fmaxf(fmaxf(fabsf(v[q][0]), fabsf(v[q][1])), fmaxf(fabsf(v[q][2]), fabsf(v[q][3])))); }
        if (rw < 16384) {
            float ss = 0.f;
#pragma unroll
            for (int q = 0; q < 8; ++q) ss += (v[q][0] * v[q][0] + v[q][1] * v[q][1]) + (v[q][2] * v[q][2] + v[q][3] * v[q][3]);
            ss = wave_sum(ss);
            const float step = 0.3352f * sqrtf(ss * (1.0f / 2048.0f)), inv = ss > 0.f ? 1.0f / step : 0.f;
            if (lane == 0) ((float*)(ws + WS_TSCALE))[rw] = step;
#pragma unroll
            for (int q = 0; q < 8; ++q) { unsigned h = 0u;
#pragma unroll
                for (int m = 0; m < 4; ++m) { int qi = (int)floorf(v[q][m] * inv); qi = qi < -8 ? -8 : (qi > 7 ? 7 : qi); h |= ((unsigned)qi & 15u) << (4 * m); }
                *(unsigned short*)(ws + WS_UT + (size_t)q * UT_SLICE + (size_t)rw * 128 + lane * 2) = (unsigned short)h; }
            continue;
        }
        am = wave_max(am);
        const float sc = am > 0.f ? 6.0f / am : 1.0f;
        if (lane == 0) ((float*)(ws + WS_TSCALE))[rw] = am > 0.f ? am / 6.0f : 1.0f;
        v4u o;
#pragma unroll
        for (int k = 0; k < 4; ++k) { const f32x4 f0 = v[2 * k] * sc, f1 = v[2 * k + 1] * sc; unsigned w = 0u;
            w = __builtin_amdgcn_cvt_scalef32_pk_fp4_f32(w, f0[0], f0[1], 1.0f, 0); w = __builtin_amdgcn_cvt_scalef32_pk_fp4_f32(w, f0[2], f0[3], 1.0f, 1);
            w = __builtin_amdgcn_cvt_scalef32_pk_fp4_f32(w, f1[0], f1[1], 1.0f, 2); w = __builtin_amdgcn_cvt_scalef32_pk_fp4_f32(w, f1[2], f1[3], 1.0f, 3); o[k] = w; }
#pragma unroll
        for (int k = 0; k < 4; ++k) {
            *(unsigned short*)(ws + WS_VT + (size_t)(2 * k) * UT_SLICE + (size_t)(rw & 16383) * 128 + lane * 2) = (unsigned short)(o[k] & 0xffffu);
            *(unsigned short*)(ws + WS_VT + (size_t)(2 * k + 1) * UT_SLICE + (size_t)(rw & 16383) * 128 + lane * 2) = (unsigned short)(o[k] >> 16); }
    }
    {
        float* cs = (float*)(ws + WS_CS);
        for (int i = blockIdx.x * (NWAVES * 64) + tid; i < TOK * 32; i += G * NWAVES * 64) { const int t = i >> 5, j = i & 31;
            const float inv = powf(10000.0f, -(float)(2 * j) / 64.0f); const float ang = (float)A.positions[t] * inv;
            cs[(size_t)i * 2] = cosf(ang); cs[(size_t)i * 2 + 1] = sinf(ang); }
        float* bs = (float*)(ws + WS_BIAS);
        for (int i = blockIdx.x * (NWAVES * 64) + tid; i < 8192 + 64; i += G * NWAVES * 64) bs[i] = i < 8192 ? A.b_in[i < 4096 ? i : i + 64] : A.b_in[4096 + ((i - 8192) >> 1) + 32 * ((i - 8192) & 1)];
    }
}

__device__ __forceinline__ unsigned pk4_fp8(float a, float b, float c, float d) { int w = __builtin_amdgcn_cvt_pk_fp8_f32(a, b, 0, false); w = __builtin_amdgcn_cvt_pk_fp8_f32(c, d, w, true); return (unsigned)w; }
__device__ __forceinline__ void p1_w8(const unsigned char* srcb, unsigned char* dstb, int n8, float wq, int lane, int gw, int NGW) {
    const v4u* src = (const v4u*)srcb; v2u* dst = (v2u*)dstb;
    for (int i = gw * 64 + lane; i < n8; i += NGW * 64) { const v4u w = src[i]; v2u o;
        o.x = pk4_fp8(bflo(w.x) * wq, bfhi(w.x) * wq, bflo(w.y) * wq, bfhi(w.y) * wq); o.y = pk4_fp8(bflo(w.z) * wq, bfhi(w.z) * wq, bflo(w.w) * wq, bfhi(w.w) * wq); dst[i] = o; }
}
__device__ __forceinline__ void p1_modulate(const Args& A, int lane, int gw, int NGW) {
    const float* mod = (const float*)(A.ws + WS_MOD); unsigned* H8 = (unsigned*)(A.ws + WS_H8); float* hsc = (float*)(A.ws + WS_HSC);
    constexpr int R = 4;
    for (int t0 = gw * R; t0 < TOK; t0 += NGW * R) { const int b = t0 >> 12; const float* sh = mod + (size_t)b * (6 * DM); const float* sc = sh + DM;
        f32x4 hv[R][8];
#pragma unroll
        for (int r = 0; r < R; ++r)
#pragma unroll
            for (int j = 0; j < 8; ++j) hv[r][j] = __builtin_nontemporal_load((const f32x4*)(A.x + (size_t)(t0 + r) * DM + j * 256 + lane * 4));
        float am[R];
#pragma unroll
        for (int r = 0; r < R; ++r) am[r] = 0.f;
#pragma unroll
        for (int j = 0; j < 8; ++j) { const int c = j * 256 + lane * 4; const f32x4 s1 = *(const f32x4*)(sc + c) + 1.0f, s0 = *(const f32x4*)(sh + c);
#pragma unroll
            for (int r = 0; r < R; ++r) { hv[r][j] = hv[r][j] * s1 + s0; am[r] = fmaxf(am[r], fmaxf(fmaxf(fabsf(hv[r][j][0]), fabsf(hv[r][j][1])), fmaxf(fabsf(hv[r][j][2]), fabsf(hv[r][j][3])))); } }
#pragma unroll
        for (int r = 0; r < R; ++r) {
            am[r] = wave_max(am[r]);
            const float q = am[r] > 0.f ? 440.0f / am[r] : 1.0f;
            if (lane == 0) hsc[t0 + r] = am[r] > 0.f ? am[r] * (1.0f / 440.0f) : 1.0f;
#pragma unroll
            for (int j = 0; j < 8; ++j) { const int c = j * 256 + lane * 4; H8[((size_t)(t0 + r) * DM + c) >> 2] = pk4_fp8(hv[r][j][0] * q, hv[r][j][1] * q, hv[r][j][2] * q, hv[r][j][3] * q); } } }
    { const unsigned* wm = (const unsigned*)(A.ws + WS_CTL) + CW_WMAX;
      p1_w8(A.ws + WS_WIN, A.ws + WS_W8, 8192 * 2048 / 8, 440.0f / __uint_as_float(wm[0]), lane, gw, NGW);
      p1_w8(A.ws + WS_WKR, A.ws + WS_WKR8, 256 * 2048 / 8, 440.0f / __uint_as_float(wm[0]), lane, gw, NGW);
      p1_w8(A.ws + WS_WPA, A.ws + WS_WPA8, 2048 * 1024 / 8, 440.0f / __uint_as_float(wm[1]), lane, gw, NGW);
      p1_w8(A.ws + WS_WPB, A.ws + WS_WPB8, 2048 * 1024 / 8, 440.0f / __uint_as_float(wm[2]), lane, gw, NGW);
      p1_w8(A.ws + WS_WO, A.ws + WS_WO8, 2048 * 2048 / 8, 440.0f / __uint_as_float(wm[3]), lane, gw, NGW);
      p1_w8(A.ws + WS_WUQ, A.ws + WS_WUQ8, 1536 * 512 / 8, 440.0f / __uint_as_float(wm[4]), lane, gw, NGW);
      p1_w8(A.ws + WS_WUKV, A.ws + WS_WUKV8, 2048 * 512 / 8, 440.0f / __uint_as_float(wm[5]), lane, gw, NGW); }
}
__device__ __forceinline__ void p7_ln1(const Args& A, int lane, int gw, int NGW) {
    const float* mod = (const float*)(A.ws + WS_MOD); bf16* H = (bf16*)(A.ws + WS_H); float* st = (float*)(A.ws + WS_LN1);
    constexpr int R = 4;
    for (int t0 = gw * R; t0 < TOK; t0 += NGW * R) { const int b = t0 >> 12; const float* sh = mod + ((size_t)b * 6 + 3) * DM; const float* sc = sh + DM;
        f32x4 v[R][8];
#pragma unroll
        for (int r = 0; r < R; ++r)
#pragma unroll
            for (int j = 0; j < 8; ++j) { const v2u w = *(const v2u*)((const bf16*)(A.ws + WS_U1B) + (size_t)(t0 + r) * DM + j * 256 + lane * 4); v[r][j] = (f32x4){bflo(w.x), bfhi(w.x), bflo(w.y), bfhi(w.y)}; }
        float rstd[R], am[R];
#pragma unroll
        for (int r = 0; r < R; ++r) am[r] = 0.f;
#pragma unroll
        for (int r = 0; r < R; ++r) { float s = 0.f;
#pragma unroll
            for (int j = 0; j < 8; ++j) s += (v[r][j][0] + v[r][j][1]) + (v[r][j][2] + v[r][j][3]);
            const float mean = wave_sum(s) * (1.0f / DM); float q = 0.f;
#pragma unroll
            for (int j = 0; j < 8; ++j) { v[r][j] = v[r][j] - mean; q += (v[r][j][0] * v[r][j][0] + v[r][j][1] * v[r][j][1]) + (v[r][j][2] * v[r][j][2] + v[r][j][3] * v[r][j][3]); }
            rstd[r] = 1.0f / sqrtf(wave_sum(q) * (1.0f / DM) + LN_EPS);
            if (lane == 0) { st[(size_t)(t0 + r) * 2] = mean; st[(size_t)(t0 + r) * 2 + 1] = rstd[r]; } }
#pragma unroll
        for (int j = 0; j < 8; ++j) { const int c = j * 256 + lane * 4; const f32x4 g = *(const f32x4*)(A.ln1_g + c), bb = *(const f32x4*)(A.ln1_b + c), s1 = *(const f32x4*)(sc + c), s0 = *(const f32x4*)(sh + c);
#pragma unroll
            for (int r = 0; r < R; ++r) { const f32x4 x1 = v[r][j] * rstd[r] * g + bb; const f32x4 hv = x1 * (s1 + 1.0f) + s0; v2u o; o.x = pk2(hv[0], hv[1]); o.y = pk2(hv[2], hv[3]); *(v2u*)(H + (size_t)(t0 + r) * DM + c) = o;
                v[r][j] = hv; am[r] = fmaxf(am[r], fmaxf(fmaxf(fabsf(hv[0]), fabsf(hv[1])), fmaxf(fabsf(hv[2]), fabsf(hv[3])))); } }
#pragma unroll
        for (int r = 0; r < R; ++r) {
            am[r] = wave_max(am[r]);
            const float inv = am[r] > 0.f ? 119.0f / am[r] : 0.f; int ssum = 0;
#pragma unroll
            for (int j = 0; j < 8; ++j) { unsigned hh = 0u, ll = 0u;
#pragma unroll
                for (int m = 0; m < 4; ++m) { const int x8 = (int)rintf(v[r][j][m] * inv); const int lo = ((x8 + 8) & 15) - 8, hi = (x8 - lo) >> 4; ssum += x8; hh |= ((unsigned)hi & 15u) << (4 * m); ll |= ((unsigned)lo & 15u) << (4 * m); }
                *(unsigned short*)(A.ws + WS_XH + (size_t)(t0 + r) * 1024 + j * 128 + lane * 2) = (unsigned short)hh;
                *(unsigned short*)(A.ws + WS_XL + (size_t)(t0 + r) * 1024 + j * 128 + lane * 2) = (unsigned short)ll; }
            ssum = wave_sum_int(ssum);
            if (lane == 0) { ((float*)(A.ws + WS_SX))[t0 + r] = am[r] * (1.0f / 119.0f); ((int*)(A.ws + WS_S8))[t0 + r] = ssum; } } }
}


__device__ __forceinline__ float max2f(float a, float b) { float r; asm("v_max_f32_e32 %0, %1, %2" : "=v"(r) : "v"(a), "v"(b)); return r; }
__device__ __forceinline__ float min2f(float a, float b) { float r; asm("v_min_f32_e32 %0, %1, %2" : "=v"(r) : "v"(a), "v"(b)); return r; }
#define INS16(L, x) do { _Pragma("unroll") for (int k_ = 0; k_ < 16; ++k_) { const float h_ = max2f(L[k_], x); x = min2f(L[k_], x); L[k_] = h_; } } while (0)
__device__ __forceinline__ void topk16_128(const float* __restrict__ src, float (&L)[16]) {
#pragma unroll
    for (int k = 0; k < 16; ++k) L[k] = -INFINITY;
#pragma unroll 4
    for (int i = 0; i < 32; ++i) { const f32x4 v = *(const f32x4*)(src + 4 * i);
#pragma unroll
        for (int e = 0; e < 4; ++e) { float x = __uint_as_float((__float_as_uint(v[e]) & ~127u) | (unsigned)(4 * i + e)); INS16(L, x); } }
}
__device__ __forceinline__ float dot2bf(unsigned a, unsigned b, float acc) { return __builtin_amdgcn_fdot2_f32_bf16(__builtin_bit_cast(bf16x2_t, a), __builtin_bit_cast(bf16x2_t, b), acc, false); }
__device__ __forceinline__ float dot8(const v4u a, const v4u b, float acc) {
    const unsigned a0 = a[0], a1 = a[1], a2 = a[2], a3 = a[3], b0 = b[0], b1 = b[1], b2 = b[2], b3 = b[3];
    acc = dot2bf(a0, b0, acc); acc = dot2bf(a1, b1, acc); acc = dot2bf(a2, b2, acc); acc = dot2bf(a3, b3, acc);
    return acc;
}

constexpr int RB = 8;
typedef float f32x2g __attribute__((ext_vector_type(2)));
#define P9_LOAD(BUF, TAB, EV, L0) do { _Pragma("unroll") for (int i_ = 0; i_ < RB; ++i_) { const int id_ = __builtin_amdgcn_readlane((EV), (L0) + i_); \
        BUF[i_] = ((const v4u*)((TAB) + (size_t)id_ * 1024))[lane]; } } while (0)
__device__ __forceinline__ float gelu_as(float v) {
    const float av = fabsf(v), t = __builtin_amdgcn_rcpf(av * 0.2316418882f + 1.0f);
    float q = t * 0.5307027145f + (-0.7265760135f); q = q * t + 0.7107068705f; q = q * t + (-0.142248368f); q = q * t + 0.127414796f; q = q * t;
    const float e = __builtin_amdgcn_exp2f((v * v) * (-0.72134752044f)); const float m = v * (q * e);
    return v < 0.f ? m : v - m;
}
typedef __bf16 bf16x2p __attribute__((ext_vector_type(2)));
__device__ __forceinline__ float p9_dot(const v4u d, const v2u (&xq)[8]) {
    float s0 = 0.f, s1 = 0.f;
#pragma unroll
    for (int k = 0; k < 4; ++k) { const unsigned w = d[k]; const unsigned x0 = xq[2 * k][0], x1 = xq[2 * k][1], x2 = xq[2 * k + 1][0], x3 = xq[2 * k + 1][1];
        s0 = __builtin_amdgcn_fdot2_f32_bf16(__builtin_amdgcn_cvt_scalef32_pk_bf16_fp4(w, 1.0f, 0), __builtin_bit_cast(bf16x2p, x0), s0, false);
        s1 = __builtin_amdgcn_fdot2_f32_bf16(__builtin_amdgcn_cvt_scalef32_pk_bf16_fp4(w, 1.0f, 1), __builtin_bit_cast(bf16x2p, x1), s1, false);
        s0 = __builtin_amdgcn_fdot2_f32_bf16(__builtin_amdgcn_cvt_scalef32_pk_bf16_fp4(w, 1.0f, 2), __builtin_bit_cast(bf16x2p, x2), s0, false);
        s1 = __builtin_amdgcn_fdot2_f32_bf16(__builtin_amdgcn_cvt_scalef32_pk_bf16_fp4(w, 1.0f, 3), __builtin_bit_cast(bf16x2p, x3), s1, false); }
    return s0 + s1;
}
__device__ __forceinline__ void p9_axpy(const v4u d, float wgt, f32x2g (&acc)[16]) {
    const f32x2g w2 = {wgt, wgt};
#pragma unroll
    for (int k = 0; k < 4; ++k) { const unsigned w = d[k];
        acc[4 * k]     = __builtin_elementwise_fma(__builtin_amdgcn_cvt_scalef32_pk_f32_fp4(w, 1.0f, 0), w2, acc[4 * k]);
        acc[4 * k + 1] = __builtin_elementwise_fma(__builtin_amdgcn_cvt_scalef32_pk_f32_fp4(w, 1.0f, 1), w2, acc[4 * k + 1]);
        acc[4 * k + 2] = __builtin_elementwise_fma(__builtin_amdgcn_cvt_scalef32_pk_f32_fp4(w, 1.0f, 2), w2, acc[4 * k + 2]);
        acc[4 * k + 3] = __builtin_elementwise_fma(__builtin_amdgcn_cvt_scalef32_pk_f32_fp4(w, 1.0f, 3), w2, acc[4 * k + 3]); }
}
__device__ __forceinline__ float p9_reduce8(const float (&p)[8], int lane) {
    const bool b5 = (lane & 32) != 0, b4 = (lane & 16) != 0, b3 = (lane & 8) != 0; float r[4], s[2];
#pragma unroll
    for (int k = 0; k < 4; ++k) { const float keep = b5 ? p[k + 4] : p[k], send = b5 ? p[k] : p[k + 4]; r[k] = keep + __shfl_xor(send, 32); }
#pragma unroll
    for (int k = 0; k < 2; ++k) { const float keep = b4 ? r[k + 2] : r[k], send = b4 ? r[k] : r[k + 2]; s[k] = keep + __shfl_xor(send, 16); }
    float t; { const float keep = b3 ? s[1] : s[0], send = b3 ? s[0] : s[1]; t = keep + __shfl_xor(send, 8); }
    t += __shfl_xor(t, 4); t += __shfl_xor(t, 2); t += __shfl_xor(t, 1);
    return t;
}
__device__ __forceinline__ void p9a_topk(const Args& A, int lane_in, int gw, int NGW) {
    unsigned char* ws = A.ws; const float* SC = (const float*)(ws + WS_SCORE);
    for (int task = gw; task < TOK / 8; task += NGW) {
        int lane = lane_in; asm volatile("" : "+v"(lane));
        const int tl = lane >> 3, hd = lane & 7; const float* srow = SC + (size_t)(task * 8 + tl) * 2048 + hd * 256;
        float L0[16], L1[16], R[16];
        topk16_128(srow, L0); topk16_128(srow + 128, L1);
#pragma unroll
        for (int k = 0; k < 16; ++k) R[k] = -INFINITY;
#pragma unroll
        for (int i = 0; i < 16; ++i)
#pragma unroll
            for (int j = 0; j < 16; ++j) if ((i + 1) * (j + 1) <= 16) { float x = __uint_as_float((__float_as_uint(L0[i] + L1[j]) & ~255u) | (unsigned)(i * 16 + j)); INS16(R, x); __builtin_amdgcn_sched_barrier(0); }
        const float mx = __uint_as_float(__float_as_uint(R[0]) & ~255u); float ex[16], es = 0.f;
#pragma unroll
        for (int r = 0; r < 16; ++r) { ex[r] = __expf(__uint_as_float(__float_as_uint(R[r]) & ~255u) - mx); es += ex[r]; }
        const float inv = 1.0f / es;
        unsigned idp[8];
#pragma unroll
        for (int r = 0; r < 16; ++r) { const unsigned code = __float_as_uint(R[r]) & 255u, ci = code >> 4, cj = code & 15u; unsigned e1 = 0u, e2 = 0u;
#pragma unroll
            for (int k = 0; k < 16; ++k) { e1 = (ci == (unsigned)k) ? (__float_as_uint(L0[k]) & 127u) : e1; e2 = (cj == (unsigned)k) ? (__float_as_uint(L1[k]) & 127u) : e2; }
            const unsigned e = e1 * 128u + e2; if (r & 1) idp[r >> 1] |= e << 16; else idp[r >> 1] = e; ex[r] *= inv; __builtin_amdgcn_sched_barrier(0); }
        const size_t slot0 = (size_t)(task * 8 + tl) * 128 + hd * 16;
        v4u* ip = (v4u*)(ws + WS_IDS + slot0 * 2); ip[0] = (v4u){idp[0], idp[1], idp[2], idp[3]}; ip[1] = (v4u){idp[4], idp[5], idp[6], idp[7]};
        { unsigned* tp = (unsigned*)(ws + WS_IDT + (size_t)(task * 8 + tl) * 256 + hd * 4);
#pragma unroll
          for (int g = 0; g < 8; ++g) { const unsigned lo = (idp[g >> 1] >> (16 * (g & 1))) & 0xffffu, hi = (idp[4 + (g >> 1)] >> (16 * (g & 1))) & 0xffffu; tp[g * 8] = lo | (hi << 16); } }
        f32x4* gp = (f32x4*)(ws + WS_GATES + slot0 * 4);
#pragma unroll
        for (int k = 0; k < 4; ++k) gp[k] = (f32x4){ex[4 * k], ex[4 * k + 1], ex[4 * k + 2], ex[4 * k + 3]};
    }
}

typedef int v2i __attribute__((ext_vector_type(2)));
__device__ __forceinline__ int dpp_add8(int v) {
    v += __builtin_amdgcn_update_dpp(0, v, 0xB1, 0xF, 0xF, true);
    v += __builtin_amdgcn_update_dpp(0, v, 0x4E, 0xF, 0xF, true);
    v += __builtin_amdgcn_update_dpp(0, v, 0x141, 0xF, 0xF, true);
    return v;
}
#define P10_IDS(IDW, JP) __builtin_amdgcn_ds_swizzle((int)(IDW), 0x18 | ((JP) << 5))
#define P10_LOAD1(BUF, IDW, HALF, JP) do { const unsigned pr_ = (unsigned)P10_IDS(IDW, (HALF) * 4 + (JP)); \
        BUF[2 * (JP)] = *(const v4u*)(UTx + ((pr_ & 0xffffu) * 128u + s16)); BUF[2 * (JP) + 1] = *(const v4u*)(UTx + ((pr_ >> 16) * 128u + s16)); } while (0)
#define P10_LOAD(BUF, IDW, HALF) do { P10_LOAD1(BUF, IDW, HALF, 0); P10_LOAD1(BUF, IDW, HALF, 1); P10_LOAD1(BUF, IDW, HALF, 2); P10_LOAD1(BUF, IDW, HALF, 3); } while (0)
#define P10_DOTS(BUF, HALF) do { _Pragma("unroll") for (int i_ = 0; i_ < 8; ++i_) { int d1_ = 0, d2_ = 0; \
        _Pragma("unroll") for (int k_ = 0; k_ < 4; ++k_) { d1_ = __builtin_amdgcn_sdot8((int)BUF[i_][k_], (int)xh[k_], d1_, false); d2_ = __builtin_amdgcn_sdot8((int)BUF[i_][k_], (int)xl[k_], d2_, false); } \
        res[(HALF) * 8 + i_] = dpp_add8(d1_ * 16 + d2_); } } while (0)
__device__ __forceinline__ void p10_udot(const Args& A, int lane_in, int wave, int bx, int G) {
    unsigned char* ws = A.ws;
    const int x = bx & 7, nblk = (G - x + 7) >> 3, stride = nblk * NWAVES;
    const unsigned char* UTx = ws + WS_UT + (size_t)x * UT_SLICE;
    int lane = lane_in; asm volatile("" : "+v"(lane));
    const unsigned s16 = (unsigned)(lane & 7) * 16u;
    const unsigned* IDS32 = (const unsigned*)(ws + WS_IDS);
    int* PA = (int*)(ws + WS_PA) + (size_t)x * TOK * 128;
    int t = (bx >> 3) * NWAVES + wave; if (t >= TOK) return;
    v4u bufA[8], bufB[8];
    unsigned idw = IDS32[(size_t)t * 64 + lane];
    v4u xh = *(const v4u*)(ws + WS_XH + (size_t)t * 1024 + x * 128 + s16), xl = *(const v4u*)(ws + WS_XL + (size_t)t * 1024 + x * 128 + s16);
    P10_LOAD(bufA, idw, 0); P10_LOAD(bufB, idw, 1);
#pragma unroll 1
    for (;;) {
        const int tn = t + stride; const bool more = tn < TOK;
        unsigned idwn = 0u; v4u xhn = xh, xln = xl;
        if (more) { idwn = IDS32[(size_t)tn * 64 + lane]; xhn = *(const v4u*)(ws + WS_XH + (size_t)tn * 1024 + x * 128 + s16); xln = *(const v4u*)(ws + WS_XL + (size_t)tn * 1024 + x * 128 + s16); }
        int res[16];
        P10_DOTS(bufA, 0);
        if (more) P10_LOAD(bufA, idwn, 0);
        P10_DOTS(bufB, 1);
        if (more) P10_LOAD(bufB, idwn, 1);
        int r0 = res[0], r1 = res[1];
#pragma unroll
        for (int k = 1; k < 8; ++k) { const bool m = (lane & 7) == k; r0 = m ? res[2 * k] : r0; r1 = m ? res[2 * k + 1] : r1; }
        *(v2i*)(PA + (size_t)t * 128 + 2 * lane) = (v2i){r0, r1};
        if (!more) break;
        t = tn; idw = idwn; xh = xhn; xl = xln;
    }
}
#undef P10_IDS
#undef P10_LOAD
#undef P10_LOAD1
#undef P10_DOTS

__device__ __forceinline__ void p11_w(const Args& A, int lane, int gw, int NGW) {
    unsigned char* ws = A.ws; const unsigned* IDS32 = (const unsigned*)(ws + WS_IDS); const int* PA = (const int*)(ws + WS_PA);
    const float* SU = (const float*)(ws + WS_TSCALE); const float* SV = SU + 16384; const float* SX = (const float*)(ws + WS_SX); const int* S8 = (const int*)(ws + WS_S8);
    for (int t = gw; t < TOK; t += NGW) {
        const unsigned idw = IDS32[(size_t)t * 64 + lane]; const int id0 = (int)(idw & 0xffffu), id1 = (int)(idw >> 16);
        int s0 = 0, s1 = 0;
#pragma unroll
        for (int x = 0; x < 8; ++x) { const v2i p = *(const v2i*)(PA + ((size_t)x * TOK + t) * 128 + 2 * lane); s0 += p.x; s1 += p.y; }
        const float sxt = SX[t], half = 0.5f * (float)S8[t];
        const float a0 = SU[id0] * sxt * ((float)s0 + half), a1 = SU[id1] * sxt * ((float)s1 + half);
        const f32x2g gt = *(const f32x2g*)(ws + WS_GATES + ((size_t)t * 128 + 2 * lane) * 4);
        f32x2g w; w.x = gt.x * SV[id0] * gelu_as(a0); w.y = gt.y * SV[id1] * gelu_as(a1);
        float am = fmaxf(fabsf(w.x), fabsf(w.y));
        am = wave_max(am);
        const float sc = am > 0.f ? 224.0f / am : 0.f;
        const int ph = __builtin_amdgcn_cvt_pk_fp8_f32(w.x * sc, w.y * sc, 0, false); const f32x2g bk = __builtin_amdgcn_cvt_pk_f32_fp8(ph, false);
        const int pl = __builtin_amdgcn_cvt_pk_fp8_f32(w.x * sc - bk.x, w.y * sc - bk.y, 0, false);
        *(unsigned short*)(ws + WS_W + (size_t)t * 256 + 2 * lane) = (unsigned short)(ph & 0xffff); *(unsigned short*)(ws + WS_W + (size_t)t * 256 + 128 + 2 * lane) = (unsigned short)(pl & 0xffff);
        if (lane == 0) ((float*)(ws + WS_WSC))[t] = am > 0.f ? am * (1.0f / 224.0f) : 0.f;
    }
}

typedef int i32x8v __attribute__((ext_vector_type(8)));
#define P12_TRRD(dst, ad, off) asm volatile("ds_read_b64_tr_b4 %0, %1 offset:%2" : "=&v"(dst) : "v"(ad), "i"(off) : "memory")
#define P12_DMA(IA, IB) do { _Pragma("unroll") for (int q_ = 0; q_ < 16; ++q_) { const unsigned wd_ = (q_ < 8) ? IA[(q_ & 7) >> 1] : IB[(q_ & 7) >> 1]; const unsigned id_ = (q_ & 1) ? (wd_ >> 16) : (wd_ & 0xffffu); \
        __builtin_amdgcn_global_load_lds((const unsigned*)(VTx + (id_ * 128u + ((q_ & 1) ? cs_odd : cs_even))), (LAS unsigned*)(ldsp + q_ * 1024), 16, 0, 0); } } while (0)
#define P12_RD(J, R) do { \
        P12_TRRD(R[0], tra[(J) >> 1], 8 * ((J) & 1)); P12_TRRD(R[1], tra[(J) >> 1], 2048 + 8 * ((J) & 1)); \
        P12_TRRD(R[2], tra[2 + ((J) >> 1)], 8 * ((J) & 1)); P12_TRRD(R[3], tra[2 + ((J) >> 1)], 2048 + 8 * ((J) & 1)); \
        P12_TRRD(R[4], tra[4 + ((J) >> 1)], 8 * ((J) & 1)); P12_TRRD(R[5], tra[4 + ((J) >> 1)], 2048 + 8 * ((J) & 1)); \
        P12_TRRD(R[6], tra[6 + ((J) >> 1)], 8 * ((J) & 1)); P12_TRRD(R[7], tra[6 + ((J) >> 1)], 2048 + 8 * ((J) & 1)); } while (0)
#define P12_MF1(I, R, W) do { asm volatile("s_waitcnt lgkmcnt(" #W ")" : "+v"(R[2 * (I)]), "+v"(R[2 * (I) + 1])); \
        acc[I] = __builtin_amdgcn_mfma_scale_f32_16x16x128_f8f6f4(aj_, (i32x8v){(int)R[2 * (I)][0], (int)R[2 * (I)][1], (int)R[2 * (I) + 1][0], (int)R[2 * (I) + 1][1], 0, 0, 0, 0}, acc[I], 0, 4, 0, 0x7f7f7f7f, 0, 0x7f7f7f7f); } while (0)
#define P12_AJ(J) do { const bool on_ = avalid && (jl == (J)); aj_[0] = on_ ? (int)a0[0] : 0; aj_[1] = on_ ? (int)a0[1] : 0; aj_[2] = on_ ? (int)a0[2] : 0; aj_[3] = on_ ? (int)a0[3] : 0; \
        aj_[4] = on_ ? (int)a1[0] : 0; aj_[5] = on_ ? (int)a1[1] : 0; aj_[6] = on_ ? (int)a1[2] : 0; aj_[7] = on_ ? (int)a1[3] : 0; } while (0)
#define P12_MMA() do { v2u ra_[8], rb_[8], rc_[8]; i32x8v aj_; \
        P12_RD(0, ra_); P12_RD(1, rb_); \
        P12_AJ(0); P12_MF1(0, ra_, 14); P12_MF1(1, ra_, 12); P12_MF1(2, ra_, 10); P12_MF1(3, ra_, 8); \
        P12_RD(2, rc_); \
        P12_AJ(1); P12_MF1(0, rb_, 14); P12_MF1(1, rb_, 12); P12_MF1(2, rb_, 10); P12_MF1(3, rb_, 8); \
        P12_RD(3, ra_); \
        P12_AJ(2); P12_MF1(0, rc_, 14); P12_MF1(1, rc_, 12); P12_MF1(2, rc_, 10); P12_MF1(3, rc_, 8); \
        P12_AJ(3); P12_MF1(0, ra_, 6); P12_MF1(1, ra_, 4); P12_MF1(2, ra_, 2); P12_MF1(3, ra_, 0); } while (0)
__device__ __forceinline__ float wave_sum_dpp(float v) {
    v += __int_as_float(__builtin_amdgcn_update_dpp(0, __float_as_int(v), 0xB1, 0xF, 0xF, true));
    v += __int_as_float(__builtin_amdgcn_update_dpp(0, __float_as_int(v), 0x4E, 0xF, 0xF, true));
    v += __int_as_float(__builtin_amdgcn_update_dpp(0, __float_as_int(v), 0x141, 0xF, 0xF, true));
    v += __int_as_float(__builtin_amdgcn_update_dpp(0, __float_as_int(v), 0x140, 0xF, 0xF, true));
    { const auto r = __builtin_amdgcn_permlane16_swap(__float_as_uint(v), __float_as_uint(v), false, false); v = __uint_as_float(r[0]) + __uint_as_float(r[1]); }
    { const auto r = __builtin_amdgcn_permlane32_swap(__float_as_uint(v), __float_as_uint(v), false, false); v = __uint_as_float(r[0]) + __uint_as_float(r[1]); }
    return v;
}
__device__ __forceinline__ void p12_vslice(const Args& A, LAS unsigned char* lds, int lane_in, int wave, int bx, int G) {
    unsigned char* ws = A.ws;
    const int x = bx & 7, nblk = (G - x + 7) >> 3, stride = nblk * NWAVES;
    const unsigned char* VTx = ws + WS_VT + (size_t)x * UT_SLICE;
    int lane = lane_in; asm volatile("" : "+v"(lane));
    LAS unsigned char* ldsp = lds + wave * 16384;
    const int gq = lane >> 3, sq = lane & 7;
    const unsigned cs_even = 16u * (unsigned)(sq ^ (gq >> 1)), cs_odd = 16u * (unsigned)(sq ^ (4 + (gq >> 1)));
    const unsigned idoff = (unsigned)gq * 32u;
    const int i16 = lane & 15, kq = lane >> 4;
    unsigned tra[8];
    { const unsigned rowb = (unsigned)(uintptr_t)ldsp + (unsigned)(32 * kq + i16) * 128u, sw = (unsigned)(i16 >> 1) & 7u;
#pragma unroll
      for (int c = 0; c < 8; ++c) tra[c] = rowb + (((unsigned)c ^ sw) << 4); }
    const bool avalid = (i16 & 3) < 2; const int jl = i16 >> 2;
    const unsigned aoff = (unsigned)(i16 & 1) * 128u + (unsigned)kq * 16u;
    const unsigned char* IDT = ws + WS_IDT; const unsigned char* WQ8 = ws + WS_W; const float* WSC = (const float*)(ws + WS_WSC);
    const float* st1 = (const float*)(ws + WS_LN1); const float* mod = (const float*)(ws + WS_MOD); const bf16* U1B = (const bf16*)(ws + WS_U1B); bf16* U2 = (bf16*)(ws + WS_H);
    f32x2g* ST2 = (f32x2g*)(ws + WS_ST2) + (size_t)x * TOK;
    const int c0 = x * 256 + lane;
    float g1[4], b1[4];
#pragma unroll
    for (int i = 0; i < 4; ++i) { g1[i] = A.ln1_g[c0 + 64 * i]; b1[i] = A.ln1_b[c0 + 64 * i]; }
    int t = (bx >> 3) * NWAVES + wave; if (t >= TOK) return;
    v4u ia = *(const v4u*)(IDT + (size_t)t * 256 + idoff), ib = *(const v4u*)(IDT + (size_t)t * 256 + idoff + 16);
    const int t1_ = (t + stride < TOK) ? t + stride : t;
    v4u ia1 = *(const v4u*)(IDT + (size_t)t1_ * 256 + idoff), ib1 = *(const v4u*)(IDT + (size_t)t1_ * 256 + idoff + 16);
    v4u a0 = *(const v4u*)(WQ8 + (size_t)t * 256 + aoff), a1 = *(const v4u*)(WQ8 + (size_t)t * 256 + aoff + 64);
    unsigned uh[4]; float gg[4];
#pragma unroll
    for (int i = 0; i < 4; ++i) { uh[i] = (unsigned)U1B[(size_t)t * DM + c0 + 64 * i]; gg[i] = mod[((size_t)(t >> 12) * 6 + 5) * DM + c0 + 64 * i]; }
    float mean1 = st1[(size_t)t * 2], rstd1 = st1[(size_t)t * 2 + 1], wsc = WSC[t];
    P12_DMA(ia, ib);
#pragma unroll 1
    for (;;) {
        const int tn = t + stride; const bool more = tn < TOK;
        asm volatile("s_waitcnt vmcnt(0)" ::: "memory"); __builtin_amdgcn_sched_barrier(0);
        v4u ia2 = ia1, ib2 = ib1, n0 = a0, n1 = a1; unsigned uhn[4]; float ggn[4], mean1n = mean1, rstd1n = rstd1, wscn = wsc;
        if (tn + stride < TOK) { ia2 = *(const v4u*)(IDT + (size_t)(tn + stride) * 256 + idoff); ib2 = *(const v4u*)(IDT + (size_t)(tn + stride) * 256 + idoff + 16); }
#pragma unroll
        for (int i = 0; i < 4; ++i) { uhn[i] = uh[i]; ggn[i] = gg[i]; }
        if (more) { n0 = *(const v4u*)(WQ8 + (size_t)tn * 256 + aoff); n1 = *(const v4u*)(WQ8 + (size_t)tn * 256 + aoff + 64);
#pragma unroll
                    for (int i = 0; i < 4; ++i) { uhn[i] = (unsigned)U1B[(size_t)tn * DM + c0 + 64 * i]; ggn[i] = mod[((size_t)(tn >> 12) * 6 + 5) * DM + c0 + 64 * i]; }
                    mean1n = st1[(size_t)tn * 2]; rstd1n = st1[(size_t)tn * 2 + 1]; wscn = WSC[tn]; }
        f32x4 acc[4];
#pragma unroll
        for (int i = 0; i < 4; ++i) acc[i] = (f32x4){0.f, 0.f, 0.f, 0.f};
        __builtin_amdgcn_sched_barrier(0);
        P12_MMA();
        __builtin_amdgcn_sched_barrier(0);
        if (more) P12_DMA(ia1, ib1);
        __builtin_amdgcn_sched_barrier(0);
        float s1 = 0.f, s2 = 0.f;
#pragma unroll
        for (int i = 0; i < 4; ++i) { const float p = (acc[i][0] + acc[i][1]) * wsc; const float u = __uint_as_float(uh[i] << 16);
            const float x1 = (u - mean1) * rstd1 * g1[i] + b1[i]; const float u2 = DN_ALPHA * x1 + gg[i] * p; s1 += u2; s2 += u2 * u2;
            U2[(size_t)t * DM + c0 + 64 * i] = (bf16)f2bf(u2); }
        s1 = wave_sum_dpp(s1); s2 = wave_sum_dpp(s2);
        if (lane == 0) ST2[t] = (f32x2g){s1, s2};
        if (!more) break;
        t = tn; ia1 = ia2; ib1 = ib2; a0 = n0; a1 = n1; mean1 = mean1n; rstd1 = rstd1n; wsc = wscn;
#pragma unroll
        for (int i = 0; i < 4; ++i) { uh[i] = uhn[i]; gg[i] = ggn[i]; }
    }
}
#undef P12_TRRD
#undef P12_DMA
#undef P12_MMA
#undef P12_RD
#undef P12_MF1
#undef P12_AJ

__device__ __forceinline__ void p13_ln2(const Args& A, int lane, int gw, int NGW) {
    unsigned char* ws = A.ws; const bf16* U2 = (const bf16*)(ws + WS_H); const f32x2g* ST2 = (const f32x2g*)(ws + WS_ST2);
    constexpr int R = 4;
    for (int t0 = gw * R; t0 < TOK; t0 += NGW * R) {
        v2u u[R][8]; float mean[R], rstd[R];
#pragma unroll
        for (int r = 0; r < R; ++r)
#pragma unroll
            for (int q = 0; q < 8; ++q) u[r][q] = *(const v2u*)(U2 + (size_t)(t0 + r) * DM + q * 256 + lane * 4);
#pragma unroll
        for (int r = 0; r < R; ++r) { float s1 = 0.f, s2 = 0.f;
#pragma unroll
            for (int x = 0; x < 8; ++x) { const f32x2g pp = ST2[(size_t)x * TOK + t0 + r]; s1 += pp.x; s2 += pp.y; }
            mean[r] = s1 * (1.0f / DM); const float var = fmaxf(s2 * (1.0f / DM) - mean[r] * mean[r], 0.f); rstd[r] = 1.0f / sqrtf(var + LN_EPS); }
#pragma unroll
        for (int q = 0; q < 8; ++q) { const int c = q * 256 + lane * 4; const f32x4 g = *(const f32x4*)(A.ln2_g + c), bb = *(const f32x4*)(A.ln2_b + c);
#pragma unroll
            for (int r = 0; r < R; ++r) { const f32x4 v = (f32x4){bflo(u[r][q].x), bfhi(u[r][q].x), bflo(u[r][q].y), bfhi(u[r][q].y)};
                __builtin_nontemporal_store((v - mean[r]) * rstd[r] * g + bb, (f32x4*)(A.out + (size_t)(t0 + r) * DM + c)); } }
    }
}


struct ArgsG {
    const GAS float *x, *c; const GAS int* positions;
    const GAS float *w_ada, *b_ada, *w_in, *b_in, *rel_bias, *q_norm_g, *kv_norm_g, *w_uq, *w_ukv, *w_pa, *w_pb, *w_o, *ln1_g, *ln1_b, *peer_wq, *peer_keys, *peer_u, *peer_v, *ln2_g, *ln2_b;
    GAS float* out; GAS unsigned char* ws; int ph_lo, ph_hi;
};
static_assert(sizeof(ArgsG) == sizeof(Args), "ArgsG mirrors Args");
#define CAS __attribute__((address_space(4)))
__device__ __forceinline__ Args load_args(const CAS ArgsG* p) {
    Args a;
    a.x = (const float*)p->x; a.c = (const float*)p->c; a.positions = (const int*)p->positions; a.w_ada = (const float*)p->w_ada; a.b_ada = (const float*)p->b_ada; a.w_in = (const float*)p->w_in; a.b_in = (const float*)p->b_in;
    a.rel_bias = (const float*)p->rel_bias; a.q_norm_g = (const float*)p->q_norm_g; a.kv_norm_g = (const float*)p->kv_norm_g; a.w_uq = (const float*)p->w_uq; a.w_ukv = (const float*)p->w_ukv; a.w_pa = (const float*)p->w_pa;
    a.w_pb = (const float*)p->w_pb; a.w_o = (const float*)p->w_o; a.ln1_g = (const float*)p->ln1_g; a.ln1_b = (const float*)p->ln1_b; a.peer_wq = (const float*)p->peer_wq; a.peer_keys = (const float*)p->peer_keys;
    a.peer_u = (const float*)p->peer_u; a.peer_v = (const float*)p->peer_v; a.ln2_g = (const float*)p->ln2_g; a.ln2_b = (const float*)p->ln2_b; a.out = (float*)p->out; a.ws = (unsigned char*)p->ws;
    a.ph_lo = p->ph_lo; a.ph_hi = p->ph_hi; return a;
}
__global__ void __launch_bounds__(NWAVES * 64, 2) fwd(Args A_) {
    extern __shared__ __attribute__((aligned(16))) unsigned char lds_raw[];
    LAS unsigned char* lds = (LAS unsigned char*)lds_raw;
    const CAS Args* Ap0 = (const CAS Args*)__builtin_amdgcn_kernarg_segment_ptr();
#define PHASE_ENV() const CAS Args* Ap = Ap0; asm volatile("" : "+s"(Ap)); const Args A = load_args((const CAS ArgsG*)Ap); \
    int wave = wave_s; asm volatile("" : "+s"(wave)); int lane; asm volatile("v_mbcnt_lo_u32_b32 %0, -1, 0\n\tv_mbcnt_hi_u32_b32 %0, -1, %0" : "=v"(lane)); const int tid = wave * 64 + lane; \
    const int G = gridDim.x, bx = blockIdx.x, vcu = (G % 8 == 0) ? (bx % 8) * (G / 8) + bx / 8 : bx, gw = vcu * NWAVES + wave, NGW = G * NWAVES; \
    unsigned char* const ws = A.ws; bf16* const H = (bf16*)(ws + WS_H); (void)lane; (void)gw; (void)NGW; (void)H; (void)vcu
    const int wave_s = __builtin_amdgcn_readfirstlane(threadIdx.x >> 6);
    for (int u = threadIdx.x; u < (LDS_BYTES - RING_BYTES) / 4; u += NWAVES * 64) ((LAS unsigned*)(lds + RING_BYTES))[u] = 0u;
    __syncthreads();
    const int lo = A_.ph_lo, hi = A_.ph_hi; const bool multi = (hi - lo) > 1;
    volatile LAS unsigned* MISC = (volatile LAS unsigned*)(lds + MISC_OFF);
    XcdBarrier bar; bar.bar = (unsigned*)(A_.ws + WS_CTL) + CW_BAR; bar.x = 0; bar.st = MISC + 8; bar.w0 = (wave_s == 0);
    if (multi) bar = xcd_barrier_post((unsigned*)(A_.ws + WS_CTL) + CW_BAR, MISC + 8, wave_s == 0);
#ifdef DBG_PHASE
#define IN(k) ((k) == DBG_PHASE)
#else
#define IN(k) (lo <= (k) && (k) < hi)
#endif
#define GRID_BAR(k) do { if (IN(k) && IN((k) + 1)) xcd_barrier(bar); } while (0)
    if (IN(0)) { { PHASE_ENV(); p0_prologue(A, lds, tid, lane, wave, vcu, G); } GRID_BAR(0); }
    if (IN(1)) { { PHASE_ENV(); p1_modulate(A, lane, gw, NGW); } GRID_BAR(1); }
    if (IN(2)) {
        { PHASE_ENV();
        pg8::Gemm g{(const bf16*)(ws + WS_H8), (const bf16*)(ws + WS_W8), TOK, 8192, 1024}; pg8::StaticOrder S; S.init(TOK, 8192, G, bx);
        pg8::EpiInProj E{(bf16*)(ws + WS_QKVA), (bf16*)(ws + WS_CQ), (bf16*)(ws + WS_CKV), (bf16*)A.out, (float*)(ws + WS_SSQ), (const float*)(ws + WS_BIAS), QSCALE_A, (const float*)(ws + WS_HSC), (const unsigned*)(ws + WS_CTL) + CW_WMAX};
        pg8::gemm_phase<pg8::EpiInProj, pg8::StaticOrder, true, true, true>(lds, g, S, E, tid); }
        GRID_BAR(2);
    }
    if (IN(3)) {
        {
        { PHASE_ENV(); pg8::Gemm g{(const bf16*)(ws + WS_CQ), (const bf16*)(ws + WS_WUQ8), TOK, 1536, 256}; pg8::StaticOrder S; S.init(TOK, 1536, G, bx);
          pg8::EpiQUp E{(bf16*)(ws + WS_QN), (bf16*)(ws + WS_QR), (const float*)(ws + WS_SSQ), (const float*)(ws + WS_CS), QSCALE_B, (const unsigned*)(ws + WS_CTL) + CW_WMAX + 4};
          pg8::gemm_phase<pg8::EpiQUp, pg8::StaticOrder, true, true, true>(lds, g, S, E, tid); }
        { PHASE_ENV(); pg8::Gemm g{(const bf16*)(ws + WS_CKV), (const bf16*)(ws + WS_WUKV8), TOK, 2048, 256}; pg8::StaticOrder S; S.init(TOK, 2048, G, bx);
          pg8::EpiKvUp E{(bf16*)(ws + WS_KN), (bf16*)(ws + WS_VB), (const float*)(ws + WS_SSQ) + (size_t)TOK * 8, (const unsigned*)(ws + WS_CTL) + CW_WMAX + 5};
          pg8::gemm_phase<pg8::EpiKvUp, pg8::StaticOrder, true, true, true>(lds, g, S, E, tid); }
        { PHASE_ENV(); pg8::Gemm g{(const bf16*)(ws + WS_H8), (const bf16*)(ws + WS_WKR8), TOK, 256, 1024}; pg8::StaticOrder S; S.init(TOK, 256, G, bx);
          pg8::EpiKr E{(bf16*)(ws + WS_KR), (const float*)(ws + WS_BIAS) + 8192, (const float*)(ws + WS_CS), (const float*)(ws + WS_HSC), (const unsigned*)(ws + WS_CTL) + CW_WMAX};
          pg8::gemm_phase<pg8::EpiKr, pg8::StaticOrder, true, true, true>(lds, g, S, E, tid); }
        { PHASE_ENV(); const bf16* Q = (const bf16*)(ws + WS_QKVA); const bf16* K = Q + (size_t)TOK * 1024; const bf16* V = K + (size_t)TOK * 1024;
          for (int u = vcu; u < 1024; u += G) { const int bh = u >> 4, qb = u & 15;
              att::attn_unit<0>(lds, bh >> 3, bh & 7, qb, Q, nullptr, K, nullptr, V, (bf16*)(ws + WS_YA), A.rel_bias + (bh & 7) * 320, tid); } }
        }
        GRID_BAR(3);
    }
    if (IN(4)) {
        {
        { PHASE_ENV();
        for (int s2 = 0; vcu + G * (s2 >> 1) < 512; ++s2) { const int it = vcu + G * (s2 >> 1), bh = it >> 3, x = it & 7, qb = (s2 & 1) ? 15 - x : x;
            att::attn_unit<1>(lds, bh >> 3, bh & 7, qb, (const bf16*)(ws + WS_QN), (const bf16*)(ws + WS_QR), (const bf16*)(ws + WS_KN), (const bf16*)(ws + WS_KR), (const bf16*)(ws + WS_VB), (bf16*)(ws + WS_YB), nullptr, tid); } }
        { PHASE_ENV(); pg8::Gemm g{(const bf16*)(ws + WS_YA), (const bf16*)(ws + WS_WPA8), TOK, 2048, 512}; pg8::StaticOrder S; S.init(TOK, 2048, G, bx);
          pg8::EpiGate<0> E{(unsigned char*)H, (const unsigned char*)A.out, nullptr, (const unsigned*)(ws + WS_CTL) + CW_WMAX + 1, ACT_MIX / ACT_Y};
          pg8::gemm_phase<pg8::EpiGate<0>, pg8::StaticOrder, true, true, true>(lds, g, S, E, tid); }
        }
        GRID_BAR(4);
    }
    if (IN(5)) {
        { PHASE_ENV(); pg8::Gemm g{(const bf16*)(ws + WS_YB), (const bf16*)(ws + WS_WPB8), TOK, 2048, 512}; pg8::StaticOrder S; S.init(TOK, 2048, G, bx);
        pg8::EpiGate<1> E{(unsigned char*)H, (const unsigned char*)A.out, ws + WS_H8, (const unsigned*)(ws + WS_CTL) + CW_WMAX + 2, ACT_MIX / ACT_Y};
        pg8::gemm_phase<pg8::EpiGate<1>, pg8::StaticOrder, true, true, true>(lds, g, S, E, tid); }
        GRID_BAR(5);
    }
    if (IN(6)) {
        { PHASE_ENV(); pg8::Gemm g{(const bf16*)(ws + WS_H8), (const bf16*)(ws + WS_WO8), TOK, 2048, 1024}; pg8::StaticOrder S; S.init(TOK, 2048, G, bx);
        pg8::EpiWo E{A.x, (bf16*)(ws + WS_U1B), (const float*)(ws + WS_MOD), DN_ALPHA, (const unsigned*)(ws + WS_CTL) + CW_WMAX + 3, 1.0f / ACT_MIX};
        pg8::gemm_phase<pg8::EpiWo, pg8::StaticOrder, true, true, true>(lds, g, S, E, tid); }
        GRID_BAR(6);
    }
    if (IN(7)) { { PHASE_ENV(); p7_ln1(A, lane, gw, NGW); } GRID_BAR(7); }
    if (IN(8)) {
        { PHASE_ENV(); pg8::Gemm g{H, (const bf16*)(ws + WS_WSK), TOK, 2048, 2048}; pg8::StaticOrder S; S.init(TOK, 2048, G, bx);
        pg8::EpiF32 E{(float*)(ws + WS_SCORE), 2048};
        pg8::gemm_phase<pg8::EpiF32, pg8::StaticOrder, true, true>(lds, g, S, E, tid); }
        GRID_BAR(8);
    }
    if (IN(9)) { { PHASE_ENV(); p9a_topk(A, lane, gw, NGW); } GRID_BAR(9); }
    if (IN(10)) { { PHASE_ENV(); p10_udot(A, lane, wave, bx, G); } GRID_BAR(10); }
    if (IN(11)) { { PHASE_ENV(); p11_w(A, lane, gw, NGW); } GRID_BAR(11); }
    if (IN(12)) { { PHASE_ENV(); p12_vslice(A, lds, lane, wave, bx, G); } GRID_BAR(12); }
    if (IN(13)) { PHASE_ENV(); p13_ln2(A, lane, gw, NGW); }
#undef IN
#undef GRID_BAR
#undef PHASE_ENV
}

#ifndef MK_ONE_LAUNCH
#define MK_ONE_LAUNCH 1
#endif
constexpr int N_PHASES = 14;
extern "C" void kernel_launch(void* const* d_in, const int* in_sizes, int n_in, void* d_out, int out_size, void* d_ws, size_t ws_size, hipStream_t stream) {
    static int grid = 0;
    if (grid == 0) {
        if (n_in != 23 || out_size != TOK * DM || ws_size < WS_END) { fprintf(stderr, "kernel_launch: unexpected shapes (n_in %d, out %d, ws %zu); nothing launched\n", n_in, out_size, ws_size); grid = -1; return; }
        int dev = 0, cus = 0, per_cu = 0;
        if (hipGetDevice(&dev) != hipSuccess || hipDeviceGetAttribute(&cus, hipDeviceAttributeMultiprocessorCount, dev) != hipSuccess) { grid = -1; return; }
        if (hipFuncSetAttribute((const void*)fwd, hipFuncAttributeMaxDynamicSharedMemorySize, LDS_BYTES) != hipSuccess) { fprintf(stderr, "kernel_launch: hipFuncSetAttribute failed\n"); grid = -1; return; }
        if (hipOccupancyMaxActiveBlocksPerMultiprocessor(&per_cu, (const void*)fwd, NWAVES * 64, LDS_BYTES) != hipSuccess || per_cu < 1) fprintf(stderr, "kernel_launch: occupancy query reports %d\n", per_cu);
        (void)hipGetLastError();
        grid = cus;
    }
    if (grid < 0) return;
    (void)hipMemsetAsync((char*)d_ws + WS_CTL, 0, CTL_ZERO_BYTES, stream);
    Args a{};
    a.x = (const float*)d_in[0]; a.c = (const float*)d_in[1]; a.positions = (const int*)d_in[2];
    a.w_ada = (const float*)d_in[3]; a.b_ada = (const float*)d_in[4]; a.w_in = (const float*)d_in[5]; a.b_in = (const float*)d_in[6]; a.rel_bias = (const float*)d_in[7];
    a.q_norm_g = (const float*)d_in[8]; a.kv_norm_g = (const float*)d_in[9]; a.w_uq = (const float*)d_in[10]; a.w_ukv = (const float*)d_in[11]; a.w_pa = (const float*)d_in[12];
    a.w_pb = (const float*)d_in[13]; a.w_o = (const float*)d_in[14]; a.ln1_g = (const float*)d_in[15]; a.ln1_b = (const float*)d_in[16]; a.peer_wq = (const float*)d_in[17];
    a.peer_keys = (const float*)d_in[18]; a.peer_u = (const float*)d_in[19]; a.peer_v = (const float*)d_in[20]; a.ln2_g = (const float*)d_in[21]; a.ln2_b = (const float*)d_in[22];
    a.out = (float*)d_out; a.ws = (unsigned char*)d_ws;
#if MK_ONE_LAUNCH
    a.ph_lo = 0; a.ph_hi = N_PHASES;
    hipLaunchKernelGGL(fwd, dim3(grid), dim3(NWAVES * 64), LDS_BYTES, stream, a);
#else
    for (int p = 0; p < N_PHASES; ++p) { a.ph_lo = p; a.ph_hi = p + 1; hipLaunchKernelGGL(fwd, dim3(grid), dim3(NWAVES * 64), LDS_BYTES, stream, a); }
#endif
}
```

```cpp
#include <hip/hip_runtime.h>
#include <cstdio>
#include <cstdint>
#include <cmath>
namespace pg8 {
#define PG8_LAS __attribute__((address_space(3)))
typedef unsigned short bf16_t;
typedef short bf16x8 __attribute__((ext_vector_type(8)));
typedef float f32x4 __attribute__((ext_vector_type(4)));
typedef unsigned u32x4 __attribute__((ext_vector_type(4)));
constexpr int BM = 256, BK = 64, HALF = 128, HTB = HALF * BK * 2  , STAGE_BYTES = 8 * HTB, NXCD = 8, WGM = 8;

__host__ __device__ __forceinline__ int lds_byte(int r, int c) { const int st = (r >> 4) * 2 + (c >> 5), rr = r & 15, cc = c & 31, ob = rr * 64 + cc * 2; return st * 1024 + (ob ^ (((ob >> 9) & 1) << 5)); }
__host__ __device__ __forceinline__ void stage_rc(int b, int& R, int& C) { const int st = b / 1024, sb = b % 1024, swz = sb ^ (((sb >> 9) & 1) << 5); R = (st >> 1) * 16 + swz / 64; C = (st & 1) * 32 + (swz % 64) / 2; }
__host__ __device__ __forceinline__ int perm32(int rho) { const int n = rho >> 4, i = rho & 15; return 8 * (i >> 2) + 4 * n + (i & 3); }

struct Unit { int pm, pn; };
struct Gemm { const bf16_t* A; const bf16_t* Bt; int M, N, K; };

struct StaticOrder {
    int nM, nN, nwg, G, c;
    __host__ __device__ void init(int M, int N, int G_, int c_) { nM = M / BM; nN = N / BM; nwg = nM * nN; G = G_; c = c_; }
    __host__ __device__ bool next(int i, Unit& u) const {
        const long L = (long)i * G + c; if (L >= nwg) return false;
        int wgid = (int)L; { const int q = nwg / NXCD, r = nwg % NXCD, xcd = wgid % NXCD, off = wgid / NXCD; wgid = (xcd < r ? xcd * (q + 1) : r * (q + 1) + (xcd - r) * q) + off; }
        const int nig = WGM * nN, gid = wgid / nig, fm = gid * WGM, gsz = (nM - fm) < WGM ? (nM - fm) : WGM;
        u.pm = fm + ((wgid % nig) % gsz); u.pn = (wgid % nig) / gsz; return true;
    }
    __device__ __forceinline__ void a_ready(const Unit&) const {}
    __device__ __forceinline__ void done(const Unit&) const {}
};

typedef float f32x2c_t __attribute__((ext_vector_type(2))); typedef __bf16 bf16x2c_t __attribute__((ext_vector_type(2)));
__device__ __forceinline__ unsigned cvt_pk_bf16(float lo, float hi) { const f32x2c_t v = {lo, hi}; const bf16x2c_t b = __builtin_convertvector(v, bf16x2c_t); return __builtin_bit_cast(unsigned, b); }
typedef float f32x2 __attribute__((ext_vector_type(2)));

constexpr int TOK = 32768;
__device__ __forceinline__ u32x4 pack8(const f32x4& v0, const f32x4& v1) { u32x4 w; w.x = cvt_pk_bf16(v0[0], v0[1]); w.y = cvt_pk_bf16(v0[2], v0[3]); w.z = cvt_pk_bf16(v1[0], v1[1]); w.w = cvt_pk_bf16(v1[2], v1[3]); return w; }
__device__ __forceinline__ float bf_lo(unsigned w) { return __uint_as_float(w << 16); }
__device__ __forceinline__ float bf_hi(unsigned w) { return __uint_as_float(w & 0xffff0000u); }
__device__ __forceinline__ float sigmoidf_fast(float v) { return __builtin_amdgcn_rcpf(1.0f + __builtin_amdgcn_exp2f(-1.4426950408889634f * v)); }

__device__ __forceinline__ unsigned pk4f8(float a, float b, float c, float d) { int w = __builtin_amdgcn_cvt_pk_fp8_f32(a, b, 0, false); w = __builtin_amdgcn_cvt_pk_fp8_f32(c, d, w, true); return (unsigned)w; }
struct EpiF32 {
    static constexpr bool PERM = false, AFTER_DRAIN = false;
    float* C; int ldc;
    __device__ __forceinline__ void operator()(const f32x4 (&acc)[2][2][4][2], const Unit& u, int wr, int wc, int fr, int fq) const {
        const int row0 = u.pm * BM + wr * 64 + fr, col0 = u.pn * BM + wc * 32 + 4 * fq;
#pragma unroll
        for (int ai = 0; ai < 2; ++ai)
#pragma unroll
            for (int m = 0; m < 4; ++m) { float* rowp = C + (size_t)(row0 + ai * HALF + m * 16) * ldc + col0;
#pragma unroll
                for (int bj = 0; bj < 2; ++bj)
#pragma unroll
                    for (int n = 0; n < 2; ++n) *(f32x4*)(rowp + bj * HALF + n * 16) = acc[ai][bj][m][n]; }
    }
};
struct EpiInProj {
    static constexpr bool PERM = true, AFTER_DRAIN = false;
    bf16_t* QKV;
    bf16_t* CQ; bf16_t* CKV;
    bf16_t* SG;
    float* SSQ;
    const float* bias;
    float qscale;
    const float* rowscale;
    const unsigned* wmaxbits;
    __device__ __forceinline__ void operator()(const f32x4 (&acc)[2][2][4][2], const Unit& u, int wr, int wc, int fr, int fq) const {
        const int row0 = u.pm * BM + wr * 64 + fr, cl = wc * 32 + 8 * fq, bcol0 = u.pn * BM + cl;
        f32x4 bv[2][2];
#pragma unroll
        for (int bj = 0; bj < 2; ++bj)
#pragma unroll
            for (int n = 0; n < 2; ++n) bv[bj][n] = *(const f32x4*)(bias + bcol0 + bj * HALF + 4 * n);
        const float wsc = __uint_as_float(*wmaxbits) * (1.0f / 440.0f); float rsc[2][4];
#pragma unroll
        for (int ai = 0; ai < 2; ++ai)
#pragma unroll
            for (int m = 0; m < 4; ++m) rsc[ai][m] = rowscale[row0 + ai * HALF + m * 16] * wsc;
        asm volatile("" :: "v"(bv[0][0]), "v"(bv[0][1]), "v"(bv[1][0]), "v"(bv[1][1]), "v"(rsc[0][0]), "v"(rsc[0][1]), "v"(rsc[0][2]), "v"(rsc[0][3]), "v"(rsc[1][0]), "v"(rsc[1][1]), "v"(rsc[1][2]), "v"(rsc[1][3]));
        if (u.pn < 12) {
            const int t = u.pn >> 2; bf16_t* base = QKV + (size_t)t * TOK * 1024 + (u.pn & 3) * 256 + cl; const float sc = (t == 0) ? qscale : 1.0f;
#pragma unroll
            for (int ai = 0; ai < 2; ++ai)
#pragma unroll
                for (int m = 0; m < 4; ++m) { bf16_t* rowp = base + (size_t)(row0 + ai * HALF + m * 16) * 1024;
#pragma unroll
                    for (int bj = 0; bj < 2; ++bj) { const f32x4 v0 = (acc[ai][bj][m][0] * rsc[ai][m] + bv[bj][0]) * sc, v1 = (acc[ai][bj][m][1] * rsc[ai][m] + bv[bj][1]) * sc; *(u32x4*)(rowp + bj * HALF) = pack8(v0, v1); } }
        } else if (u.pn < 16) {
            const int which = (u.pn - 12) >> 1, tl = (u.pn - 12) & 1; unsigned char* base = (unsigned char*)(which ? CKV : CQ) + tl * 256 + cl; float* sq = SSQ + (size_t)which * TOK * 8 + tl * 4 + wc;
#pragma unroll
            for (int ai = 0; ai < 2; ++ai)
#pragma unroll
                for (int m = 0; m < 4; ++m) { const int row = row0 + ai * HALF + m * 16; unsigned char* rowp = base + (size_t)row * 512; float ss = 0.f;
#pragma unroll
                    for (int bj = 0; bj < 2; ++bj) { const f32x4 v0 = acc[ai][bj][m][0] * rsc[ai][m] + bv[bj][0], v1 = acc[ai][bj][m][1] * rsc[ai][m] + bv[bj][1];
                        typedef unsigned u32x2c __attribute__((ext_vector_type(2))); u32x2c o; o.x = pk4f8(v0[0] * 16.0f, v0[1] * 16.0f, v0[2] * 16.0f, v0[3] * 16.0f); o.y = pk4f8(v1[0] * 16.0f, v1[1] * 16.0f, v1[2] * 16.0f, v1[3] * 16.0f);
                        *(u32x2c*)(rowp + bj * HALF) = o;
                        ss += (v0[0] * v0[0] + v0[1] * v0[1]) + (v0[2] * v0[2] + v0[3] * v0[3]) + (v1[0] * v1[0] + v1[1] * v1[1]) + (v1[2] * v1[2] + v1[3] * v1[3]); }
                    ss += __int_as_float(__builtin_amdgcn_ds_swizzle(__float_as_int(ss), 0x401F));
                    { auto rr_ = __builtin_amdgcn_permlane32_swap(__float_as_uint(ss), __float_as_uint(ss), false, false); ss = __uint_as_float(rr_[0]) + __uint_as_float(rr_[1]); }
                    if (fq == 0) sq[(size_t)row * 8] = ss; }
        } else {
            unsigned char* base = (unsigned char*)SG + (u.pn - 16) * 256 + cl;
#pragma unroll
            for (int ai = 0; ai < 2; ++ai)
#pragma unroll
                for (int m = 0; m < 4; ++m) { unsigned char* rowp = base + (size_t)(row0 + ai * HALF + m * 16) * 4096;
#pragma unroll
                    for (int bj = 0; bj < 2; ++bj) { f32x4 v0 = acc[ai][bj][m][0] * rsc[ai][m] + bv[bj][0], v1 = acc[ai][bj][m][1] * rsc[ai][m] + bv[bj][1];
#pragma unroll
                        for (int j = 0; j < 4; ++j) { v0[j] = sigmoidf_fast(v0[j]); v1[j] = sigmoidf_fast(v1[j]); }
                        typedef unsigned u32x2c __attribute__((ext_vector_type(2))); u32x2c o; o.x = pk4f8(v0[0], v0[1], v0[2], v0[3]); o.y = pk4f8(v1[0], v1[1], v1[2], v1[3]);
                        *(u32x2c*)(rowp + bj * HALF) = o; } }
        }
    }
};
__device__ __forceinline__ float row_rs(const float* ssq_row, float inv_n, float eps) {
    const f32x4 a = *(const f32x4*)ssq_row, b = *(const f32x4*)(ssq_row + 4);
    const float s = ((a[0] + a[1]) + (a[2] + a[3])) + ((b[0] + b[1]) + (b[2] + b[3]));
    return 1.0f / sqrtf(s * inv_n + eps);
}
__device__ __forceinline__ void rope8(f32x4& v0, f32x4& v1, const float* cs) {
    const f32x4 c0 = *(const f32x4*)cs, c1 = *(const f32x4*)(cs + 4);
    f32x4 o0, o1;
    o0[0] = v0[0] * c0[0] - v0[1] * c0[1]; o0[1] = v0[0] * c0[1] + v0[1] * c0[0]; o0[2] = v0[2] * c0[2] - v0[3] * c0[3]; o0[3] = v0[2] * c0[3] + v0[3] * c0[2];
    o1[0] = v1[0] * c1[0] - v1[1] * c1[1]; o1[1] = v1[0] * c1[1] + v1[1] * c1[0]; o1[2] = v1[2] * c1[2] - v1[3] * c1[3]; o1[3] = v1[2] * c1[3] + v1[3] * c1[2];
    v0 = o0; v1 = o1;
}
struct EpiQUp {
    static constexpr bool PERM = true, AFTER_DRAIN = false;
    bf16_t* Qn; bf16_t* Qr; const float* SSQ; const float* CS; float qscale; const unsigned* wmaxbits;
    __device__ __forceinline__ void operator()(const f32x4 (&acc)[2][2][4][2], const Unit& u, int wr, int wc, int fr, int fq) const {
        const int row0 = u.pm * BM + wr * 64 + fr, cl = wc * 32 + 8 * fq;
        float rs[2][4];
#pragma unroll
        for (int ai = 0; ai < 2; ++ai)
#pragma unroll
            for (int m = 0; m < 4; ++m) rs[ai][m] = row_rs(SSQ + (size_t)(row0 + ai * HALF + m * 16) * 8, 1.0f / 512.0f, 1e-6f) * (qscale * (1.0f / (440.0f * 16.0f)) * __uint_as_float(wmaxbits[fq >> 2]));
        asm volatile("" ::: "memory");
        if (u.pn < 4) {
#pragma unroll
            for (int ai = 0; ai < 2; ++ai)
#pragma unroll
                for (int m = 0; m < 4; ++m) { const int row = row0 + ai * HALF + m * 16; bf16_t* rowp = Qn + (size_t)row * 1024 + u.pn * 256 + cl;
#pragma unroll
                    for (int bj = 0; bj < 2; ++bj) *(u32x4*)(rowp + bj * HALF) = pack8(acc[ai][bj][m][0] * rs[ai][m], acc[ai][bj][m][1] * rs[ai][m]); }
        } else { const int rc = (u.pn - 4) * 256 + cl;
#pragma unroll
            for (int ai = 0; ai < 2; ++ai)
#pragma unroll
                for (int m = 0; m < 4; ++m) { const int row = row0 + ai * HALF + m * 16;
#pragma unroll
                    for (int bj = 0; bj < 2; ++bj) { const int c = rc + bj * HALF; f32x4 v0 = acc[ai][bj][m][0] * rs[ai][m], v1 = acc[ai][bj][m][1] * rs[ai][m];
                        rope8(v0, v1, (const float*)((const char*)CS + (unsigned)((row * 32 + ((c & 63) >> 1)) * 8))); *(u32x4*)((char*)Qr + (unsigned)((row * 512 + c) * 2)) = pack8(v0, v1); }
                    if (m & 1) asm volatile("" ::: "memory"); }
        }
    }
};
struct EpiKvUp {
    static constexpr bool PERM = true, AFTER_DRAIN = false;
    bf16_t* Kn; bf16_t* Vb; const float* SSQ; const unsigned* wmaxbits;
    __device__ __forceinline__ void operator()(const f32x4 (&acc)[2][2][4][2], const Unit& u, int wr, int wc, int fr, int fq) const {
        const int row0 = u.pm * BM + wr * 64 + fr, cl = wc * 32 + 8 * fq; bf16_t* base = (u.pn < 4 ? Kn : Vb) + (u.pn & 3) * 256 + cl;
        float rs[2][4];
#pragma unroll
        for (int ai = 0; ai < 2; ++ai)
#pragma unroll
            for (int m = 0; m < 4; ++m) rs[ai][m] = row_rs(SSQ + (size_t)(row0 + ai * HALF + m * 16) * 8, 1.0f / 512.0f, 1e-6f) * ((1.0f / (440.0f * 16.0f)) * __uint_as_float(*wmaxbits));
        asm volatile("" ::: "memory");
#pragma unroll
        for (int ai = 0; ai < 2; ++ai)
#pragma unroll
            for (int m = 0; m < 4; ++m) { const int row = row0 + ai * HALF + m * 16; bf16_t* rowp = base + (size_t)row * 1024;
#pragma unroll
                for (int bj = 0; bj < 2; ++bj) *(u32x4*)(rowp + bj * HALF) = pack8(acc[ai][bj][m][0] * rs[ai][m], acc[ai][bj][m][1] * rs[ai][m]); }
    }
};
struct EpiKr {
    static constexpr bool PERM = true, AFTER_DRAIN = false;
    bf16_t* KR; const float* bias; const float* CS; const float* rowscale; const unsigned* wmaxbits;
    __device__ __forceinline__ void operator()(const f32x4 (&acc)[2][2][4][2], const Unit& u, int wr, int wc, int fr, int fq) const {
        if (wc >= 2) return;
        const int row0 = u.pm * BM + wr * 64 + fr, cl = wc * 32 + 8 * fq; const float wsc = __uint_as_float(*wmaxbits) * (1.0f / 440.0f);
        const f32x4 b0 = *(const f32x4*)(bias + cl), b1 = *(const f32x4*)(bias + cl + 4);
#pragma unroll
        for (int ai = 0; ai < 2; ++ai)
#pragma unroll
            for (int m = 0; m < 4; ++m) { const int row = row0 + ai * HALF + m * 16; const float rs = rowscale[row] * wsc; f32x4 v0 = acc[ai][0][m][0] * rs + b0, v1 = acc[ai][0][m][1] * rs + b1;
                rope8(v0, v1, CS + ((size_t)row * 32 + (cl >> 1)) * 2); *(u32x4*)(KR + (size_t)row * 64 + cl) = pack8(v0, v1);
                if (m & 1) asm volatile("" ::: "memory"); }
    }
};
__device__ __forceinline__ void unpk8f8(unsigned lo, unsigned hi, f32x4& a, f32x4& b) { typedef float f32x2u __attribute__((ext_vector_type(2)));
    const f32x2u p0 = __builtin_amdgcn_cvt_pk_f32_fp8((int)lo, false), p1 = __builtin_amdgcn_cvt_pk_f32_fp8((int)lo, true), p2 = __builtin_amdgcn_cvt_pk_f32_fp8((int)hi, false), p3 = __builtin_amdgcn_cvt_pk_f32_fp8((int)hi, true);
    a = (f32x4){p0[0], p0[1], p1[0], p1[1]}; b = (f32x4){p2[0], p2[1], p3[0], p3[1]}; }
template <int MODE> struct EpiGate {
    static constexpr bool PERM = true, AFTER_DRAIN = false;
    unsigned char* T8; const unsigned char* SG8; unsigned char* MIX8; const unsigned* wmaxbits; float actmul;
    __device__ __forceinline__ void operator()(const f32x4 (&acc)[2][2][4][2], const Unit& u, int wr, int wc, int fr, int fq) const {
        typedef unsigned u32x2e __attribute__((ext_vector_type(2)));
        const int row0 = u.pm * BM + wr * 64 + fr, col0 = u.pn * BM + wc * 32 + 8 * fq; const float sc = __uint_as_float(*wmaxbits) * (1.0f / 440.0f) * actmul;
#pragma unroll
        for (int ai = 0; ai < 2; ++ai)
#pragma unroll
            for (int m = 0; m < 4; ++m) { const int row = row0 + ai * HALF + m * 16;
#pragma unroll
                for (int bj = 0; bj < 2; ++bj) { const int c = col0 + bj * HALF; const u32x2e g = *(const u32x2e*)(SG8 + (size_t)row * 4096 + MODE * 2048 + c);
                    f32x4 g0, g1; unpk8f8(g.x, g.y, g0, g1);
                    f32x4 v0 = acc[ai][bj][m][0] * sc * g0, v1 = acc[ai][bj][m][1] * sc * g1;
                    if (MODE == 1) { const u32x2e t = *(const u32x2e*)(T8 + (size_t)row * 2048 + c); f32x4 t0, t1; unpk8f8(t.x, t.y, t0, t1); v0 = v0 + t0; v1 = v1 + t1; }
                    u32x2e o; o.x = pk4f8(v0[0], v0[1], v0[2], v0[3]); o.y = pk4f8(v1[0], v1[1], v1[2], v1[3]);
                    *(u32x2e*)((MODE == 0 ? T8 : MIX8) + (size_t)row * 2048 + c) = o; } }
    }
};
struct EpiWo {
    static constexpr bool PERM = true, AFTER_DRAIN = false;
    const float* X; bf16_t* U1; const float* MOD; float alpha; const unsigned* wmaxbits; float actinv;
    __device__ __forceinline__ void operator()(const f32x4 (&acc)[2][2][4][2], const Unit& u, int wr, int wc, int fr, int fq) const {
        const int row0 = u.pm * BM + wr * 64 + fr, col0 = u.pn * BM + wc * 32 + 8 * fq; const int b = (u.pm * BM) >> 12;
        f32x4 gv[2][2];
#pragma unroll
        for (int bj = 0; bj < 2; ++bj)
#pragma unroll
            for (int n = 0; n < 2; ++n) gv[bj][n] = *(const f32x4*)(MOD + ((size_t)b * 6 + 2) * 2048 + col0 + bj * HALF + n * 4) * (__uint_as_float(*wmaxbits) * (1.0f / 440.0f) * actinv);
#pragma unroll
        for (int ai = 0; ai < 2; ++ai)
#pragma unroll
            for (int m = 0; m < 4; ++m) { const size_t off = (size_t)(row0 + ai * HALF + m * 16) * 2048 + col0;
#pragma unroll
                for (int bj = 0; bj < 2; ++bj) { const f32x4 x0 = *(const f32x4*)(X + off + bj * HALF), x1 = *(const f32x4*)(X + off + bj * HALF + 4);
                    const f32x4 v0 = x0 * alpha + gv[bj][0] * acc[ai][bj][m][0], v1 = x1 * alpha + gv[bj][1] * acc[ai][bj][m][1];
                    *(u32x4*)(U1 + off + bj * HALF) = pack8(v0, v1); }
                asm volatile("" ::: "memory"); }
    }
};

__device__ __forceinline__ bf16x8 lds_rd16(const PG8_LAS bf16x8* __restrict__ p) { return *p; }
typedef int i32x4g __attribute__((ext_vector_type(4))); typedef int i32x8g __attribute__((ext_vector_type(8)));
template <class Epi, class Sched, bool ALIGN_EPI = false, bool SP2 = false, bool F8 = false>
__device__ __forceinline__ void gemm_phase(PG8_LAS unsigned char* lds, const Gemm g, const Sched& S, const Epi& E, const int tid) {
    const int wid = __builtin_amdgcn_readfirstlane(tid >> 6), lane = tid & 63, wr = wid >> 2, wc = wid & 3, fr = lane & 15, fq = lane >> 4;
    const int K = g.K, nt = K / BK;
    unsigned voffA[2], voffB[2];
#pragma unroll
    for (int i = 0; i < 2; ++i) { int R, C; stage_rc(tid * 16 + i * 8192, R, C); const int Rb = Epi::PERM ? ((R & ~31) + perm32(R & 31)) : R;
        voffA[i] = (unsigned)(R * K + C) * 2u; voffB[i] = (unsigned)(Rb * K + C) * 2u; }
    const size_t kstep = (size_t)(BK * 2);
    const size_t hstep = (size_t)HALF * K * 2;
    const size_t tstep = 2 * hstep;
    const unsigned ldsbase_u = (unsigned)(size_t)lds;
    const unsigned ldsw = (unsigned)wid * 1024u;
    const int aoff = lds_byte(wr * 64 + fr, fq * 8), boff = lds_byte(wc * 32 + fr, fq * 8);
#define PG8_SA(b, h) (((b) * 2 + (h)) * HTB)
#define PG8_SB(b, h) ((4 + (b) * 2 + (h)) * HTB)
#define PG8_STAGE(bufoff, gbase, voff) do { _Pragma("unroll") for (int _i = 0; _i < 2; ++_i) { unsigned keep_; \
        asm volatile("s_mov_b32 %0, m0\n\ts_mov_b32 m0, %3\n\ts_nop 0\n\tglobal_load_lds_dwordx4 %1, %2\n\ts_mov_b32 m0, %0" \
                     : "=&s"(keep_) : "v"((voff)[_i]), "s"((const char*)(gbase)), "s"(ldsbase_u + (unsigned)(bufoff) + ldsw + (unsigned)(_i * 8192)) : "memory"); } } while (0)
#define PG8_LDA(dst, b, h) do { _Pragma("unroll") for (int m = 0; m < 4; ++m) _Pragma("unroll") for (int k = 0; k < 2; ++k) dst[m][k] = lds_rd16((const PG8_LAS bf16x8*)(lds + PG8_SA(b, h) + aoff + m * 2048 + k * 1024)); } while (0)
#define PG8_LDB(dst, b, h) do { _Pragma("unroll") for (int n = 0; n < 2; ++n) _Pragma("unroll") for (int k = 0; k < 2; ++k) dst[n][k] = lds_rd16((const PG8_LAS bf16x8*)(lds + PG8_SB(b, h) + boff + n * 2048 + k * 1024)); } while (0)
#define PG8_MMA(ai, bj, At, Bt) do { __builtin_amdgcn_s_setprio(1); _Pragma("unroll") for (int m = 0; m < 4; ++m) _Pragma("unroll") for (int n = 0; n < 2; ++n) { \
        if constexpr (F8) { const i32x8g a8_ = __builtin_shufflevector(__builtin_bit_cast(i32x4g, At[m][0]), __builtin_bit_cast(i32x4g, At[m][1]), 0, 1, 2, 3, 4, 5, 6, 7); \
                            const i32x8g b8_ = __builtin_shufflevector(__builtin_bit_cast(i32x4g, Bt[n][0]), __builtin_bit_cast(i32x4g, Bt[n][1]), 0, 1, 2, 3, 4, 5, 6, 7); \
                            acc[ai][bj][m][n] = __builtin_amdgcn_mfma_scale_f32_16x16x128_f8f6f4(b8_, a8_, acc[ai][bj][m][n], 0, 0, 0, 0x7f7f7f7f, 0, 0x7f7f7f7f); } \
        else { _Pragma("unroll") for (int k = 0; k < 2; ++k) acc[ai][bj][m][n] = __builtin_amdgcn_mfma_f32_16x16x32_bf16(Bt[n][k], At[m][k], acc[ai][bj][m][n], 0, 0, 0); } } \
        __builtin_amdgcn_s_setprio(0); } while (0)
#define PG8_WAIT_V(n) asm volatile("s_waitcnt vmcnt(" #n ")" ::: "memory")
#define PG8_WAIT_L(n) asm volatile("s_waitcnt lgkmcnt(" #n ")" ::: "memory")
#define PG8_BAR __builtin_amdgcn_s_barrier()
#define PG8_SCHED __builtin_amdgcn_sched_barrier(0)
    Unit cur, nxt; int ui = 0;
    if (!S.next(0, cur)) return;
    f32x4 acc[2][2][4][2];
#pragma unroll
    for (int a = 0; a < 2; ++a)
#pragma unroll
        for (int b = 0; b < 2; ++b)
#pragma unroll
            for (int m = 0; m < 4; ++m)
#pragma unroll
                for (int n = 0; n < 2; ++n) acc[a][b][m][n] = (f32x4){0.f, 0.f, 0.f, 0.f};
    bf16x8 At[4][2], B0[2][2], B1[2][2];
    const char* cA = (const char*)g.A + (size_t)cur.pm * tstep; const char* cB = (const char*)g.Bt + (size_t)cur.pn * tstep;
    S.a_ready(cur);
    if constexpr (SP2) {
        PG8_STAGE(PG8_SB(0, 0), cB, voffB); PG8_STAGE(PG8_SB(0, 1), cB + hstep, voffB); PG8_STAGE(PG8_SA(0, 0), cA, voffA); PG8_STAGE(PG8_SA(0, 1), cA + hstep, voffA);
        if (wr == 1) PG8_BAR;
        PG8_WAIT_V(2); PG8_BAR;
        PG8_STAGE(PG8_SB(1, 0), cB + kstep, voffB); PG8_STAGE(PG8_SA(1, 0), cA + kstep, voffA); PG8_STAGE(PG8_SB(1, 1), cB + hstep + kstep, voffB);
        PG8_WAIT_V(6); PG8_BAR;
    } else {
        PG8_STAGE(PG8_SB(0, 0), cB, voffB); PG8_STAGE(PG8_SA(0, 0), cA, voffA); PG8_STAGE(PG8_SB(0, 1), cB + hstep, voffB); PG8_STAGE(PG8_SA(0, 1), cA + hstep, voffA);
        if (wr == 1) PG8_BAR;
        PG8_WAIT_V(4); PG8_BAR;
        PG8_STAGE(PG8_SB(1, 0), cB + kstep, voffB); PG8_STAGE(PG8_SA(1, 0), cA + kstep, voffA); PG8_STAGE(PG8_SB(1, 1), cB + hstep + kstep, voffB);
        PG8_WAIT_V(6); PG8_BAR;
    }
    for (;;) {
        const bool has_next = S.next(ui + 1, nxt);
        const char* nA = has_next ? (const char*)g.A + (size_t)nxt.pm * tstep : cA; const char* nB = has_next ? (const char*)g.Bt + (size_t)nxt.pn * tstep : cB;
#pragma unroll 1
        for (int t = 0; t < nt; t += 2) {
            const bool last = (t == nt - 2);
            const char* a1 = cA + (size_t)(t + 1) * kstep;
            const char* a2 = last ? nA : cA + (size_t)(t + 2) * kstep; const char* b2 = last ? nB : cB + (size_t)(t + 2) * kstep;
            const char* a3 = a2 + kstep; const char* b3 = b2 + kstep;
            if (last && has_next) S.a_ready(nxt);
            if constexpr (SP2) {
            PG8_LDB(B0, 0, 0); PG8_LDB(B1, 0, 1); PG8_SCHED; PG8_LDA(At, 0, 0); PG8_STAGE(PG8_SA(1, 1), a1 + hstep, voffA);
            PG8_WAIT_V(8); PG8_WAIT_L(0); PG8_BAR; PG8_MMA(0, 0, At, B0); PG8_MMA(0, 1, At, B1); PG8_BAR; PG8_SCHED;
            PG8_LDA(At, 0, 1); PG8_STAGE(PG8_SB(0, 0), b2, voffB); PG8_STAGE(PG8_SB(0, 1), b2 + hstep, voffB); PG8_STAGE(PG8_SA(0, 0), a2, voffA);
            PG8_WAIT_V(8); PG8_WAIT_L(0); PG8_BAR; PG8_MMA(1, 0, At, B0); PG8_MMA(1, 1, At, B1); PG8_BAR; PG8_SCHED;
            PG8_LDB(B0, 1, 0); PG8_LDB(B1, 1, 1); PG8_SCHED; PG8_LDA(At, 1, 0); PG8_STAGE(PG8_SA(0, 1), a2 + hstep, voffA);
            PG8_WAIT_V(8); PG8_WAIT_L(0); PG8_BAR; PG8_MMA(0, 0, At, B0); PG8_MMA(0, 1, At, B1); PG8_BAR; PG8_SCHED;
            PG8_LDA(At, 1, 1); PG8_STAGE(PG8_SB(1, 0), b3, voffB); PG8_STAGE(PG8_SB(1, 1), b3 + hstep, voffB); PG8_STAGE(PG8_SA(1, 0), a3, voffA);
            PG8_WAIT_V(8); PG8_WAIT_L(0); PG8_BAR; PG8_MMA(1, 0, At, B0); PG8_MMA(1, 1, At, B1); PG8_BAR; PG8_SCHED;
            } else {
            PG8_LDB(B0, 0, 0); PG8_SCHED; PG8_LDA(At, 0, 0); PG8_STAGE(PG8_SA(1, 1), a1 + hstep, voffA);
            PG8_WAIT_L(8); PG8_BAR; PG8_WAIT_L(0); PG8_MMA(0, 0, At, B0); PG8_BAR; PG8_SCHED;
            PG8_LDB(B1, 0, 1); PG8_STAGE(PG8_SB(0, 0), b2, voffB);
            PG8_BAR; PG8_WAIT_L(0); PG8_MMA(0, 1, At, B1); PG8_BAR;
            PG8_LDA(At, 0, 1); PG8_STAGE(PG8_SA(0, 0), a2, voffA);
            PG8_BAR; PG8_WAIT_L(0); PG8_MMA(1, 0, At, B0); PG8_BAR; PG8_SCHED;
            PG8_STAGE(PG8_SB(0, 1), b2 + hstep, voffB);
            PG8_WAIT_V(6); PG8_BAR; PG8_MMA(1, 1, At, B1); PG8_BAR;
            PG8_LDB(B0, 1, 0); PG8_SCHED; PG8_LDA(At, 1, 0); PG8_STAGE(PG8_SA(0, 1), a2 + hstep, voffA);
            PG8_WAIT_L(8); PG8_BAR; PG8_WAIT_L(0); PG8_MMA(0, 0, At, B0); PG8_BAR; PG8_SCHED;
            PG8_LDB(B1, 1, 1); PG8_STAGE(PG8_SB(1, 0), b3, voffB);
            PG8_BAR; PG8_WAIT_L(0); PG8_MMA(0, 1, At, B1); PG8_BAR;
            PG8_LDA(At, 1, 1); PG8_STAGE(PG8_SA(1, 0), a3, voffA);
            PG8_BAR; PG8_WAIT_L(0); PG8_MMA(1, 0, At, B0); PG8_BAR; PG8_SCHED;
            PG8_STAGE(PG8_SB(1, 1), b3 + hstep, voffB);
            PG8_WAIT_V(6); PG8_BAR; PG8_MMA(1, 1, At, B1); PG8_BAR;
            }
        }
        if constexpr (ALIGN_EPI) { if (wr == 0) PG8_BAR; }
        if constexpr (!Epi::AFTER_DRAIN) { int ln_; asm volatile("v_mbcnt_lo_u32_b32 %0, -1, 0\n\tv_mbcnt_hi_u32_b32 %0, -1, %0" : "=v"(ln_));
            E(acc, cur, wr, wc, ln_ & 15, ln_ >> 4); S.done(cur); }
        if (!has_next) break;
#pragma unroll
        for (int a = 0; a < 2; ++a)
#pragma unroll
            for (int b = 0; b < 2; ++b)
#pragma unroll
                for (int m = 0; m < 4; ++m)
#pragma unroll
                    for (int n = 0; n < 2; ++n) acc[a][b][m][n] = (f32x4){0.f, 0.f, 0.f, 0.f};
        cur = nxt; cA = nA; cB = nB; ++ui;
        if constexpr (ALIGN_EPI) { if (wr == 1) PG8_BAR; }
    }
    PG8_WAIT_V(0);
    if constexpr (!ALIGN_EPI) { if (wr == 0) PG8_BAR; }
    PG8_BAR;
    if constexpr (Epi::AFTER_DRAIN) { E.fused(acc, cur, wr, wc, fr, fq, lds, wid, lane); S.done(cur); }
#undef PG8_SA
#undef PG8_SB
#undef PG8_STAGE
#undef PG8_LDA
#undef PG8_LDB
#undef PG8_MMA
#undef PG8_WAIT_V
#undef PG8_WAIT_L
#undef PG8_BAR
#undef PG8_SCHED
}
}

constexpr int NB = 8, SEQ = 4096, DM = 2048, TOK = NB * SEQ;
constexpr int NWAVES = 8;
constexpr float LN_EPS = 1e-5f;
constexpr float DN_ALPHA = 1.189207115002721f;
constexpr float LOG2E = 1.4426950408889634f;
constexpr float QSCALE_A = 0.08838834764831845f * LOG2E;
constexpr float QSCALE_B = 0.07216878364870322f * LOG2E;

constexpr size_t MiB = 1u << 20;
constexpr size_t WS_CTL = 0, CTL_ZERO_BYTES = 1 * MiB;
constexpr size_t WS_WIN = 1 * MiB;
constexpr size_t WS_WKR = 33 * MiB;
constexpr size_t WS_WUQ = 34 * MiB;
constexpr size_t WS_WUKV = 36 * MiB;
constexpr size_t WS_WPA = 38 * MiB;
constexpr size_t WS_WPB = 42 * MiB;
constexpr size_t WS_WO = 46 * MiB;
constexpr size_t WS_WSK = 54 * MiB;
constexpr size_t WS_MOD = 62 * MiB;
constexpr size_t WS_BIAS = 62 * MiB + 512 * 1024;
constexpr size_t WS_LN1 = 63 * MiB;
constexpr size_t WS_UT = 64 * MiB;
constexpr size_t WS_VT = 96 * MiB;
constexpr size_t WS_TSCALE = 62 * MiB + 768 * 1024;
constexpr size_t WS_W8 = 80 * MiB;
constexpr size_t WS_HSC = 63 * MiB + 512 * 1024;
constexpr size_t WS_WUQ8 = 121 * MiB;
constexpr size_t WS_WUKV8 = 122 * MiB;
constexpr size_t WS_WKR8 = 112 * MiB;
constexpr size_t WS_WPA8 = 113 * MiB;
constexpr size_t WS_WPB8 = 115 * MiB;
constexpr size_t WS_WO8 = 117 * MiB;
constexpr size_t WS_H8 = 128 * MiB;
constexpr size_t WS_H = 192 * MiB;
constexpr size_t WS_QKVA = 320 * MiB;
constexpr size_t WS_SCORE = 320 * MiB;
constexpr size_t WS_CQ = 512 * MiB;
constexpr size_t WS_CKV = 544 * MiB;
constexpr size_t WS_U1B = 576 * MiB;
constexpr size_t WS_QN = 576 * MiB;
constexpr size_t WS_QR = 640 * MiB;
constexpr size_t WS_KN = 672 * MiB;
constexpr size_t WS_VB = 736 * MiB;
constexpr size_t WS_KR = 800 * MiB;
constexpr size_t WS_YA = 804 * MiB;
constexpr size_t WS_YB = 868 * MiB;
constexpr size_t WS_CS = 932 * MiB;
constexpr size_t WS_SSQ = 940 * MiB;
constexpr size_t WS_END = 942 * MiB;
constexpr size_t WS_IDS = 736 * MiB;
constexpr size_t WS_GATES = 744 * MiB;
constexpr size_t WS_W = 760 * MiB;
constexpr size_t WS_WSC = 768 * MiB;
constexpr size_t WS_SX = 776 * MiB;
constexpr size_t WS_S8 = 776 * MiB + 128 * 1024;
constexpr size_t WS_PA = 320 * MiB;
constexpr size_t WS_XH = 804 * MiB;
constexpr size_t WS_XL = 836 * MiB;
constexpr size_t WS_ST2 = 778 * MiB;
constexpr size_t WS_IDT = 780 * MiB;
constexpr size_t UT_SLICE = 2 * MiB;
constexpr int CW_BAR = 4096;
constexpr int CW_WMAX = 8;
constexpr float ACT_C = 16.0f;
constexpr float ACT_Y = 32.0f, ACT_MIX = 64.0f;
constexpr int CW_WMAX0 = 8;

constexpr int RING_BYTES = 131072;
constexpr int MISC_OFF = RING_BYTES + 320;
constexpr int LDS_BYTES = 147456;

#define GAS __attribute__((address_space(1)))
#define LAS __attribute__((address_space(3)))
typedef unsigned short bf16;
typedef unsigned v4u __attribute__((ext_vector_type(4)));
typedef unsigned v2u __attribute__((ext_vector_type(2)));
typedef float f32x4 __attribute__((ext_vector_type(4)));
typedef float f32x16 __attribute__((ext_vector_type(16)));
typedef short bf16x8 __attribute__((ext_vector_type(8)));
typedef short s16x4 __attribute__((ext_vector_type(4)));
typedef __bf16 bf16x2_t __attribute__((ext_vector_type(2)));
#define LDS_WAIT() asm volatile("s_waitcnt lgkmcnt(0)" ::: "memory")
#define VM_WAIT() asm volatile("s_waitcnt vmcnt(0)" ::: "memory")
__device__ __forceinline__ unsigned f2bf(float f) { unsigned u = __builtin_bit_cast(unsigned, f); return (u + 0x7fffu + ((u >> 16) & 1u)) >> 16; }
__device__ __forceinline__ unsigned pk2(float lo, float hi) { return f2bf(lo) | (f2bf(hi) << 16); }
#define WRED_DPP(v, ctrl) __builtin_amdgcn_update_dpp(0, (v), (ctrl), 0xF, 0xF, true)
__device__ __forceinline__ float wave_sum(float v) {
    v += __int_as_float(WRED_DPP(__float_as_int(v), 0xB1)); v += __int_as_float(WRED_DPP(__float_as_int(v), 0x4E));
    v += __int_as_float(WRED_DPP(__float_as_int(v), 0x141)); v += __int_as_float(WRED_DPP(__float_as_int(v), 0x140));
    { const auto r = __builtin_amdgcn_permlane16_swap(__float_as_uint(v), __float_as_uint(v), false, false); v = __uint_as_float(r[0]) + __uint_as_float(r[1]); }
    { const auto r = __builtin_amdgcn_permlane32_swap(__float_as_uint(v), __float_as_uint(v), false, false); v = __uint_as_float(r[0]) + __uint_as_float(r[1]); }
    return v;
}
__device__ __forceinline__ float wave_max(float v) {
    v = fmaxf(v, __int_as_float(WRED_DPP(__float_as_int(v), 0xB1))); v = fmaxf(v, __int_as_float(WRED_DPP(__float_as_int(v), 0x4E)));
    v = fmaxf(v, __int_as_float(WRED_DPP(__float_as_int(v), 0x141))); v = fmaxf(v, __int_as_float(WRED_DPP(__float_as_int(v), 0x140)));
    { const auto r = __builtin_amdgcn_permlane16_swap(__float_as_uint(v), __float_as_uint(v), false, false); v = fmaxf(__uint_as_float(r[0]), __uint_as_float(r[1])); }
    { const auto r = __builtin_amdgcn_permlane32_swap(__float_as_uint(v), __float_as_uint(v), false, false); v = fmaxf(__uint_as_float(r[0]), __uint_as_float(r[1])); }
    return v;
}
__device__ __forceinline__ int wave_sum_int(int v) {
    v += WRED_DPP(v, 0xB1); v += WRED_DPP(v, 0x4E); v += WRED_DPP(v, 0x141); v += WRED_DPP(v, 0x140);
    { const auto r = __builtin_amdgcn_permlane16_swap((unsigned)v, (unsigned)v, false, false); v = (int)(r[0] + r[1]); }
    { const auto r = __builtin_amdgcn_permlane32_swap((unsigned)v, (unsigned)v, false, false); v = (int)(r[0] + r[1]); }
    return v;
}
__device__ __forceinline__ float bflo(unsigned w) { return __uint_as_float(w << 16); }
__device__ __forceinline__ float bfhi(unsigned w) { return __uint_as_float(w & 0xffff0000u); }

#define XB_TMO      128
#define XB_XCNT(j)  (256  + 64 * (j))
#define XB_XSUB(j)  (1280 + 64 * (j))
#define XB_XGEN(j)  (2304 + 64 * (j))
#define XB_TOP      3328
#define XB_TOPGEN   3392
#define XCD_BAR_WORDS 3456
#define XB_SPIN_CAP (1u << 18)

__device__ __forceinline__ unsigned xb_ld(unsigned* p)              { return __hip_atomic_load(p, __ATOMIC_RELAXED, __HIP_MEMORY_SCOPE_AGENT); }
__device__ __forceinline__ unsigned xb_add(unsigned* p, unsigned v) { return __hip_atomic_fetch_add(p, v, __ATOMIC_RELAXED, __HIP_MEMORY_SCOPE_AGENT); }
__device__ __forceinline__ unsigned xb_xcc_id() { return (unsigned)__builtin_amdgcn_s_getreg((3 << 11) | 20) & 0xFu; }
#define XB_SPIN(cond, bar) do { unsigned _sp = 0; while (cond) { __builtin_amdgcn_s_sleep(1); \
    if ((++_sp & 255u) == 0u) { if (xb_ld(&(bar)[XB_TMO])) break; if (_sp > XB_SPIN_CAP) { atomicAdd(&(bar)[XB_TMO], 1u); break; } } } } while (0)

struct XcdBarrier {
    unsigned* bar; unsigned x;
    volatile LAS unsigned* st;
    bool w0;
};
__device__ __forceinline__ bool xb_thread0(bool w0) { return w0 && __builtin_amdgcn_mbcnt_hi(~0u, __builtin_amdgcn_mbcnt_lo(~0u, 0u)) == 0u; }

__device__ __forceinline__ XcdBarrier xcd_barrier_post(unsigned* bar, volatile LAS unsigned* st, bool w0) {
    XcdBarrier b; b.bar = bar; b.x = xb_xcc_id(); b.st = st; b.w0 = w0;
    if (xb_thread0(w0)) (void)xb_add(&bar[XB_XCNT(b.x)], 1u);
    return b;
}
__device__ __forceinline__ void xcd_barrier_complete(unsigned* bar, unsigned x, unsigned& nloc, unsigned& nx) {
    const unsigned G = gridDim.x * gridDim.y * gridDim.z;
    unsigned sum, cnt, mine, sp = 0u;
    for (;;) {
        sum = 0u; cnt = 0u; mine = 0u;
#pragma unroll
        for (unsigned j = 0; j < 16; ++j) { const unsigned c = xb_ld(&bar[XB_XCNT(j)]); sum += c; cnt += (c > 0u) ? 1u : 0u; mine = (j == x) ? c : mine; }
        if (sum == G) break;
        __builtin_amdgcn_s_sleep(1);
        if ((++sp & 255u) == 0u) { if (xb_ld(&bar[XB_TMO])) break; if (sp > XB_SPIN_CAP) { atomicAdd(&bar[XB_TMO], 1u); break; } }
    }
    nloc = mine > 0u ? mine : 1u; nx = cnt > 0u ? cnt : 1u;
}

__device__ __forceinline__ void xcd_barrier(const XcdBarrier& b) {
    asm volatile("s_waitcnt vmcnt(0)" ::: "memory");
    __syncthreads();
    if (xb_thread0(b.w0)) {
        unsigned* bar = b.bar;
        __builtin_amdgcn_s_waitcnt(0);
        unsigned nloc = b.st[0], nx = b.st[1];
        if (nloc == 0u) { xcd_barrier_complete(bar, b.x, nloc, nx); b.st[0] = nloc; b.st[1] = nx; }
        const unsigned old = xb_add(&bar[XB_XSUB(b.x)], 1u);
        const unsigned gen = old / nloc;
        if (old + 1u == (gen + 1u) * nloc) {
            __builtin_amdgcn_fence(__ATOMIC_RELEASE, "agent");
            asm volatile("s_waitcnt vmcnt(0)" ::: "memory");
            const unsigned og = xb_add(&bar[XB_TOP], 1u);
            const unsigned tg = og / nx;
            if (og + 1u == (tg + 1u) * nx) xb_add(&bar[XB_TOPGEN], 1u);
            else XB_SPIN(xb_ld(&bar[XB_TOPGEN]) == tg, bar);
            __builtin_amdgcn_fence(__ATOMIC_ACQUIRE, "agent");
            xb_add(&bar[XB_XGEN(b.x)], 1u);
            asm volatile("s_waitcnt vmcnt(0)" ::: "memory");
        } else {
            XB_SPIN(xb_ld(&bar[XB_XGEN(b.x)]) == gen, bar);
            __builtin_amdgcn_fence(__ATOMIC_ACQUIRE, "agent");
            asm volatile("s_waitcnt vmcnt(0)" ::: "memory");
        }
    }
    __syncthreads();
}

namespace att {
constexpr int SHM_V = 16384, SHM_KN = 16384, SHM_KR = 8192, BUFB = SHM_V + SHM_KN + SHM_KR;
constexpr int OFF_V = 0, OFF_KN = SHM_V, OFF_KR = SHM_V + SHM_KN;
constexpr int NSLOT = 3;
constexpr int OFF_WS = NSLOT * BUFB, OFF_BIAS = OFF_WS + 2048, ATT_LDS = OFF_BIAS + 1280;
static_assert(ATT_LDS <= RING_BYTES, "attention LDS");
#define KSWZ(row, colB) ((row) * 256 + ((colB) ^ (((row) & 15) << 4)))
#define KRSWZ(row, colB) ((row) * 128 + ((colB) ^ ((((row) >> 1) & 7) << 4)))
__device__ __forceinline__ int v_st(int k, int c) { const int kk = (k & ~0xC) | ((k & 4) << 1) | ((k & 8) >> 1); return ((kk >> 3) * 4 + (c >> 5)) * 512 + ((kk & 7) * 32 + (c & 31)) * 2; }
__device__ __forceinline__ int v_rd_base(int lane) { return ((lane & 3) << 3) | (((lane >> 2) & 3) << 6) | (((lane >> 4) & 1) << 5) | (((lane >> 5) & 1) << 8); }
__device__ __forceinline__ int crow(int r, int hi) { return (r & 3) + 8 * (r >> 2) + 4 * hi; }
__device__ __forceinline__ unsigned cvtpk(float lo, float hi) { return pg8::cvt_pk_bf16(lo, hi); }
constexpr float THR = 8.0f;

template <int MODE>
__device__ __forceinline__ void attn_unit(LAS unsigned char* lds, int b, int h, int qb, const bf16* __restrict__ Qn, const bf16* __restrict__ Qr, const bf16* __restrict__ Kn,
                                          const bf16* __restrict__ Kr, const bf16* __restrict__ V, bf16* __restrict__ O, const float* __restrict__ relb, const int tid_in) {
    constexpr int ND = MODE ? 12 : 8;
    int tid = tid_in; asm volatile("" : "+v"(tid));
    const int wid = __builtin_amdgcn_readfirstlane(tid >> 6), lane = tid & 63, r32 = lane & 31, hi = lane >> 5;
    const int tb = b * SEQ, cw = 4 * qb + (wid >> 1);
    const int j_lo = MODE ? 0 : (4 * qb - 8 > 0 ? 4 * qb - 8 : 0), j_hi = 4 * qb + 4, NTL = j_hi - j_lo;
    bf16x8 qr[ND];
    { const size_t qrow = (size_t)(tb + 256 * qb + 32 * wid + r32);
#pragma unroll
      for (int d0 = 0; d0 < 8; ++d0) qr[d0] = *(const bf16x8*)(Qn + qrow * 1024 + h * 128 + d0 * 16 + hi * 8);
      if constexpr (MODE == 1) {
#pragma unroll
          for (int d0 = 0; d0 < 4; ++d0) qr[8 + d0] = *(const bf16x8*)(Qr + qrow * 512 + h * 64 + d0 * 16 + hi * 8); } }
    unsigned gk[2], gv[2], gkr;
#pragma unroll
    for (int i = 0; i < 2; ++i) { const int p = 2 * wid + i; const int row = 4 * p + (lane >> 4), colB = ((lane & 15) << 4) ^ ((row & 15) << 4);
        gk[i] = (unsigned)(row * 2048 + colB);
        const int st = 2 * p + (lane >> 5), kk = (st >> 2) * 8 + ((lane & 31) >> 2), c = (st & 3) * 32 + (lane & 3) * 8, k = (kk & ~0xC) | ((kk & 4) << 1) | ((kk & 8) >> 1);
        gv[i] = (unsigned)(k * 2048 + c * 2); }
    { const int row = 8 * wid + (lane >> 3), colB = ((lane & 7) << 4) ^ (((row >> 1) & 7) << 4); gkr = (unsigned)(row * 128 + colB); }
    const char* Kg = (const char*)(Kn + (size_t)tb * 1024 + h * 128); const char* Vg = (const char*)(V + (size_t)tb * 1024 + h * 128); const char* Krg = (const char*)(Kr + (size_t)tb * 64);
#define ATT_STAGE(j, bo) do { const size_t to_ = (size_t)(j) * (64 * 2048); \
        __builtin_amdgcn_global_load_lds((const unsigned*)(Kg + to_ + gk[0]), (LAS unsigned*)(lds + (bo) + OFF_KN + wid * 2048), 16, 0, 0); \
        __builtin_amdgcn_global_load_lds((const unsigned*)(Kg + to_ + gk[1]), (LAS unsigned*)(lds + (bo) + OFF_KN + wid * 2048 + 1024), 16, 0, 0); \
        __builtin_amdgcn_global_load_lds((const unsigned*)(Vg + to_ + gv[0]), (LAS unsigned*)(lds + (bo) + OFF_V + wid * 2048), 16, 0, 0); \
        __builtin_amdgcn_global_load_lds((const unsigned*)(Vg + to_ + gv[1]), (LAS unsigned*)(lds + (bo) + OFF_V + wid * 2048 + 1024), 16, 0, 0); \
        if constexpr (MODE == 1) __builtin_amdgcn_global_load_lds((const unsigned*)(Krg + (size_t)(j) * (64 * 128) + gkr), (LAS unsigned*)(lds + (bo) + OFF_KR + wid * 1024), 16, 0, 0); } while (0)
    float m_reg = -1e30f, l_reg = 0.f; f32x16 o[4] = {};
    LAS float* li_l = (LAS float*)(lds + OFF_WS) + wid * 64; LAS float* al_l = li_l + 32;
    const LAS float* biasL = (const LAS float*)(lds + OFF_BIAS);
    if constexpr (MODE == 0) { if (tid < 320) ((LAS float*)(lds + OFF_BIAS))[tid] = relb[tid] * LOG2E; }
    int kb[8], krb[4];
#pragma unroll
    for (int dd = 0; dd < 4; ++dd) { kb[dd] = OFF_KN + KSWZ(r32, (dd * 16 + hi * 8) * 2); kb[4 + dd] = OFF_KN + KSWZ(r32, 128 + (dd * 16 + hi * 8) * 2); krb[dd] = OFF_KR + KRSWZ(r32, dd * 32 + hi * 16); }
    const unsigned vb0 = (unsigned)(uintptr_t)lds + OFF_V + v_rd_base(lane);
    constexpr int NDMA = MODE ? 5 : 4;
    ATT_STAGE(j_lo, 0);
    if (NTL > 1) { ATT_STAGE(j_lo + 1, BUFB); asm volatile("s_waitcnt vmcnt(%0)" :: "i"(NDMA) : "memory"); } else VM_WAIT();
    __syncthreads();
    int bo = 0, bo2 = 2 * BUFB;
    for (int t = 0; t < NTL; ++t) {
        const int j = j_lo + t;
        if (t + 2 < NTL) ATT_STAGE(j + 2, bo2);
        const bool act = MODE ? (j <= cw) : (j <= cw && j >= cw - 8);
        if (act) {
            f32x16 p0 = {}, p1 = {};
            { bf16x8 kf[2][2];
              unsigned kad[8], krad[4];
#pragma unroll
              for (int dd = 0; dd < 4; ++dd) { kad[dd] = (unsigned)(uintptr_t)lds + (unsigned)bo + (unsigned)kb[dd]; kad[4 + dd] = (unsigned)(uintptr_t)lds + (unsigned)bo + (unsigned)kb[4 + dd]; krad[dd] = (unsigned)(uintptr_t)lds + (unsigned)bo + (unsigned)krb[dd]; }
#define ATT_KRD(dst, ad, off) asm volatile("ds_read_b128 %0, %1 offset:%2" : "=&v"(dst) : "v"(ad), "i"(off) : "memory")
#define ATT_KLD(d0_, s_) do { if ((d0_) < 8) { ATT_KRD(kf[s_][0], kad[(d0_) & 7], 0); ATT_KRD(kf[s_][1], kad[(d0_) & 7], 32 * 256); } \
                                  else { ATT_KRD(kf[s_][0], krad[((d0_) - 8) & 3], 0); ATT_KRD(kf[s_][1], krad[((d0_) - 8) & 3], 32 * 128); } } while (0)
              ATT_KLD(0, 0);
#pragma unroll
              for (int d0 = 0; d0 < ND; ++d0) {
                  if (d0 + 1 < ND) { ATT_KLD(d0 + 1, (d0 + 1) & 1); asm volatile("s_waitcnt lgkmcnt(2)" ::: "memory"); } else { asm volatile("s_waitcnt lgkmcnt(0)" ::: "memory"); }
                  __builtin_amdgcn_sched_barrier(0);
                  p0 = __builtin_amdgcn_mfma_f32_32x32x16_bf16(kf[d0 & 1][0], qr[d0], p0, 0, 0, 0); p1 = __builtin_amdgcn_mfma_f32_32x32x16_bf16(kf[d0 & 1][1], qr[d0], p1, 0, 0, 0);
                  __builtin_amdgcn_sched_barrier(0); }
#undef ATT_KLD
#undef ATT_KRD
            }
            if constexpr (MODE == 0) {
                const int dc = cw - j;
                if (dc >= 5) { const float bc = biasL[319];
#pragma unroll
                    for (int r = 0; r < 16; ++r) { p0[r] += bc; p1[r] += bc; } }
                else { const int base = 64 * dc + 32 * (wid & 1) + r32 - 4 * hi;
#pragma unroll
                    for (int r = 0; r < 16; ++r) { const int rel0 = base - ((r & 3) + 8 * (r >> 2)); int i0 = rel0 < -63 ? -63 : rel0; i0 = i0 > 256 ? 256 : i0; int i1 = rel0 - 32 < -63 ? -63 : rel0 - 32; i1 = i1 > 256 ? 256 : i1;
                        p0[r] += biasL[i0 + 63]; p1[r] += biasL[i1 + 63]; } }
            }
            float pmax = p0[0];
#pragma unroll
            for (int r = 1; r < 16; ++r) pmax = fmaxf(pmax, p0[r]);
#pragma unroll
            for (int r = 0; r < 16; ++r) pmax = fmaxf(pmax, p1[r]);
            { auto rr = __builtin_amdgcn_permlane32_swap(__float_as_uint(pmax), __float_as_uint(pmax), false, false); pmax = fmaxf(__uint_as_float(rr[0]), __uint_as_float(rr[1])); }
            float mn, alpha;
            if (__all((pmax - m_reg) <= THR)) { mn = m_reg; alpha = 1.f; }
            else { mn = fmaxf(m_reg, pmax); alpha = __builtin_amdgcn_exp2f(m_reg - mn); m_reg = mn; }
#pragma unroll
            for (int r = 0; r < 16; ++r) { p0[r] = __builtin_amdgcn_exp2f(p0[r] - mn); p1[r] = __builtin_amdgcn_exp2f(p1[r] - mn); }
            float ps = 0.f;
#pragma unroll
            for (int r = 0; r < 16; ++r) ps += p0[r];
#pragma unroll
            for (int r = 0; r < 16; ++r) ps += p1[r];
            { auto rr = __builtin_amdgcn_permlane32_swap(__float_as_uint(ps), __float_as_uint(ps), false, false); ps = __uint_as_float(rr[0]) + __uint_as_float(rr[1]); }
            l_reg = l_reg * alpha + ps;
            bf16x8 pa0, pa1, pa2, pa3;
#define ATT_PK4(P, B_, OUT) do { unsigned a0 = cvtpk(P[B_+0], P[B_+1]), a1 = cvtpk(P[B_+2], P[B_+3]); unsigned b0 = cvtpk(P[B_+4], P[B_+5]), b1 = cvtpk(P[B_+6], P[B_+7]); \
        auto r0 = __builtin_amdgcn_permlane32_swap(a0, b0, false, false); auto r1 = __builtin_amdgcn_permlane32_swap(a1, b1, false, false); \
        v4u w = {r0[0], r1[0], r0[1], r1[1]}; OUT = __builtin_bit_cast(bf16x8, w); } while (0)
            ATT_PK4(p0, 0, pa0); ATT_PK4(p0, 8, pa1); ATT_PK4(p1, 0, pa2); ATT_PK4(p1, 8, pa3);
#undef ATT_PK4
            if (__any(alpha < 1.f)) { if (hi == 0) al_l[r32] = alpha; LDS_WAIT();
#pragma unroll
                for (int r = 0; r < 16; ++r) { const float a = al_l[crow(r, hi)];
#pragma unroll
                    for (int d = 0; d < 4; ++d) o[d][r] *= a; } }
            const unsigned vb = vb0 + (unsigned)bo;
#define ATT_TRRD(dst, off) asm volatile("ds_read_b64_tr_b16 %0, %1 offset:%2" : "=&v"(dst) : "v"(vb), "i"(off) : "memory")
#define ATT_VLD(d0, L) do { constexpr int b_ = (d0) * 512; ATT_TRRD(L[0], b_); ATT_TRRD(L[4], b_ + 2048); ATT_TRRD(L[1], b_ + 4096); ATT_TRRD(L[5], b_ + 6144); ATT_TRRD(L[2], b_ + 8192); ATT_TRRD(L[6], b_ + 10240); ATT_TRRD(L[3], b_ + 12288); ATT_TRRD(L[7], b_ + 14336); } while (0)
#define ATT_PVM(d0, L) do { \
        o[d0] = __builtin_amdgcn_mfma_f32_32x32x16_bf16(pa0, (bf16x8){L[0][0], L[0][1], L[0][2], L[0][3], L[4][0], L[4][1], L[4][2], L[4][3]}, o[d0], 0, 0, 0); \
        o[d0] = __builtin_amdgcn_mfma_f32_32x32x16_bf16(pa1, (bf16x8){L[1][0], L[1][1], L[1][2], L[1][3], L[5][0], L[5][1], L[5][2], L[5][3]}, o[d0], 0, 0, 0); \
        o[d0] = __builtin_amdgcn_mfma_f32_32x32x16_bf16(pa2, (bf16x8){L[2][0], L[2][1], L[2][2], L[2][3], L[6][0], L[6][1], L[6][2], L[6][3]}, o[d0], 0, 0, 0); \
        o[d0] = __builtin_amdgcn_mfma_f32_32x32x16_bf16(pa3, (bf16x8){L[3][0], L[3][1], L[3][2], L[3][3], L[7][0], L[7][1], L[7][2], L[7][3]}, o[d0], 0, 0, 0); } while (0)
            { s16x4 va[8], vb_[8];
              ATT_VLD(0, va);
              ATT_VLD(1, vb_); asm volatile("s_waitcnt lgkmcnt(8)" ::: "memory"); __builtin_amdgcn_sched_barrier(0); ATT_PVM(0, va); __builtin_amdgcn_sched_barrier(0);
              ATT_VLD(2, va);  asm volatile("s_waitcnt lgkmcnt(8)" ::: "memory"); __builtin_amdgcn_sched_barrier(0); ATT_PVM(1, vb_); __builtin_amdgcn_sched_barrier(0);
              ATT_VLD(3, vb_); asm volatile("s_waitcnt lgkmcnt(8)" ::: "memory"); __builtin_amdgcn_sched_barrier(0); ATT_PVM(2, va); __builtin_amdgcn_sched_barrier(0);
              asm volatile("s_waitcnt lgkmcnt(0)" ::: "memory"); __builtin_amdgcn_sched_barrier(0); ATT_PVM(3, vb_); }
#undef ATT_VLD
#undef ATT_PVM
#undef ATT_TRRD
        }
        if (t + 2 < NTL) asm volatile("s_waitcnt vmcnt(%0)" :: "i"(NDMA) : "memory"); else VM_WAIT();
        asm volatile("s_waitcnt lgkmcnt(0)" ::: "memory"); __builtin_amdgcn_s_barrier(); asm volatile("" ::: "memory");
        bo = (bo == 2 * BUFB) ? 0 : bo + BUFB; bo2 = (bo2 == 2 * BUFB) ? 0 : bo2 + BUFB;
    }
    if (hi == 0) li_l[r32] = l_reg; LDS_WAIT();
    { LAS unsigned char* ost = lds + wid * 4096;
#pragma unroll
      for (int r = 0; r < 16; ++r) { const int orow = crow(r, hi); const float rl = __builtin_amdgcn_rcpf(li_l[orow]) * ACT_Y;
#pragma unroll
          for (int d0 = 0; d0 < 4; ++d0) { const float v = o[d0][r] * rl; ost[orow * 128 + d0 * 32 + r32] = (unsigned char)(__builtin_amdgcn_cvt_pk_fp8_f32(v, v, 0, false) & 0xff); } }
      LDS_WAIT();
      unsigned char* Ow = (unsigned char*)O + (size_t)(tb + 256 * qb + 32 * wid) * 1024 + h * 128;
#pragma unroll
      for (int k = 0; k < 4; ++k) { const int idx = lane + 64 * k, row = idx >> 3, ch = idx & 7;
          const v4u val = *(const LAS v4u*)(lds + wid * 4096 + row * 128 + ch * 16);
          *(v4u*)(Ow + (size_t)row * 1024 + ch * 16) = val; } }
    __syncthreads();
#undef ATT_STAGE
}
#undef KSWZ
#undef KRSWZ
}


struct Args {
    const float *x, *c; const int* positions;
    const float *w_ada, *b_ada, *w_in, *b_in, *rel_bias, *q_norm_g, *kv_norm_g, *w_uq, *w_ukv, *w_pa, *w_pb, *w_o, *ln1_g, *ln1_b, *peer_wq, *peer_keys, *peer_u, *peer_v, *ln2_g, *ln2_b;
    float* out; unsigned char* ws; int ph_lo, ph_hi;
};

template <class SrcCol>
__device__ __forceinline__ void transpose_item(const float* __restrict__ W, int K, int N, bf16* __restrict__ WT, int nblk, LAS float* scr, int item, int lane, SrcCol srccol, const float* __restrict__ kscale, float* amax = nullptr) {
    const int kb = item / nblk, nb = item % nblk, k0 = 64 * kb, n0 = 32 * nb;
    const int scol = srccol(n0 + (lane & 31));
    float am = 0.f, vv[32];
    { const float* wp = W + (size_t)(k0 + (lane >> 5)) * N + scol;
#pragma unroll
      for (int i = 0; i < 32; ++i) vv[i] = __builtin_nontemporal_load(wp + (size_t)(2 * i) * N); }
#pragma unroll
    for (int i = 0; i < 32; ++i) { const int kk = 2 * i + (lane >> 5); float v = vv[i]; if (kscale) v *= kscale[k0 + kk]; scr[kk * 33 + (lane & 31)] = v; am = fmaxf(am, fabsf(v)); }
    if (amax) *amax = fmaxf(*amax, am);
    LDS_WAIT(); asm volatile("" ::: "memory");
    const int c = lane & 7;
#pragma unroll
    for (int j = 0; j < 4; ++j) { const int n = (lane >> 3) + 8 * j; const LAS float* s = scr + (8 * c) * 33 + n;
        v4u o; o.x = pk2(s[0 * 33], s[1 * 33]); o.y = pk2(s[2 * 33], s[3 * 33]); o.z = pk2(s[4 * 33], s[5 * 33]); o.w = pk2(s[6 * 33], s[7 * 33]);
        *(v4u*)(WT + (size_t)(n0 + n) * K + k0 + 8 * c) = o; }
    LDS_WAIT(); asm volatile("" ::: "memory");
}
struct ColIn { __device__ int operator()(int n) const { return n < 4096 ? n : n + 64; } };
struct ColKr { __device__ int operator()(int n) const { return 4096 + (n >> 1) + 32 * (n & 1); } };
struct ColUq { __device__ int operator()(int n) const { if (n < 1024) return (n >> 7) * 192 + (n & 127); const int r = n - 1024, hh = r >> 6, o = r & 63; return hh * 192 + 128 + (o >> 1) + 32 * (o & 1); } };
struct ColUkv { __device__ int operator()(int n) const { return n < 1024 ? (n >> 7) * 256 + (n & 127) : ((n - 1024) >> 7) * 256 + 128 + (n & 127); } };
struct ColId { __device__ int operator()(int n) const { return n; } };

__device__ __forceinline__ void p0_prologue(const Args& A, LAS unsigned char* lds, int tid, int lane, int wave, int vcu, int G) {
    unsigned char* ws = A.ws;
    {
        LAS float* sl = (LAS float*)lds;
        LAS float* red = (LAS float*)(lds + 65536);
        for (int i = tid; i < NB * DM; i += NWAVES * 64) { const int b = i >> 11, k = i & 2047; const float v = A.c[i]; sl[k * 8 + b] = v / (1.0f + __expf(-v)); }
        __syncthreads();
        float* mod = (float*)(ws + WS_MOD);
        for (int cb = blockIdx.x; cb < 256; cb += G) {
            const int r = lane / 12, c4 = lane % 12; const int col = cb * 48 + c4 * 4;
            float acc[8][4];
#pragma unroll
            for (int b = 0; b < 8; ++b)
#pragma unroll
                for (int i = 0; i < 4; ++i) acc[b][i] = 0.f;
            if (r < 5) {
#pragma unroll 4
                for (int kk = r; kk < 256; kk += 5) { const int k = wave * 256 + kk;
                    const f32x4 wv = __builtin_nontemporal_load((const f32x4*)(A.w_ada + (size_t)k * (6 * DM) + col));
                    const f32x4 s0 = *(const LAS f32x4*)(sl + k * 8), s1 = *(const LAS f32x4*)(sl + k * 8 + 4);
#pragma unroll
                    for (int i = 0; i < 4; ++i) { acc[0][i] += s0[0] * wv[i]; acc[1][i] += s0[1] * wv[i]; acc[2][i] += s0[2] * wv[i]; acc[3][i] += s0[3] * wv[i];
                                                  acc[4][i] += s1[0] * wv[i]; acc[5][i] += s1[1] * wv[i]; acc[6][i] += s1[2] * wv[i]; acc[7][i] += s1[3] * wv[i]; } }
#pragma unroll
                for (int i = 0; i < 4; ++i)
#pragma unroll
                    for (int b = 0; b < 8; ++b) red[((wave * 5 + r) * 48 + c4 * 4 + i) * 8 + b] = acc[b][i];
            }
            __syncthreads();
            if (tid < 384) { const int cc = tid >> 3, b = tid & 7; float s = 0.f;
                for (int p = 0; p < 40; ++p) s += red[(p * 48 + cc) * 8 + b];
                const int col2 = cb * 48 + cc; mod[(size_t)b * (6 * DM) + col2] = s + A.b_ada[col2]; }
            __syncthreads();
        }
    }
    const int gw = vcu * NWAVES + wave, NGW = G * NWAVES;
    {
        LAS float* scr = (LAS float*)(lds + wave * 16384);
        constexpr int I_IN = 32 * 256, I_KR = 32 * 2, I_UQ = 8 * 48, I_UKV = 8 * 64, I_PA = 16 * 64, I_PB = 16 * 64, I_O = 32 * 64;
        constexpr int NITEMS = I_IN + I_KR + I_UQ + I_UKV + I_PA + I_PB + I_O;
        float amx[6] = {0.f, 0.f, 0.f, 0.f, 0.f, 0.f};
        for (int it = gw; it < NITEMS; it += NGW) {
            int r = it;
            if (r < I_IN) { transpose_item(A.w_in, 2048, 8256, (bf16*)(ws + WS_WIN), 256, scr, r, lane, ColIn(), nullptr, &amx[0]); continue; } r -= I_IN;
            if (r < I_KR) { transpose_item(A.w_in, 2048, 8256, (bf16*)(ws + WS_WKR), 2, scr, r, lane, ColKr(), nullptr); continue; } r -= I_KR;
            if (r < I_UQ) { transpose_item(A.w_uq, 512, 1536, (bf16*)(ws + WS_WUQ), 48, scr, r, lane, ColUq(), A.q_norm_g, &amx[4]); continue; } r -= I_UQ;
            if (r < I_UKV) { transpose_item(A.w_ukv, 512, 2048, (bf16*)(ws + WS_WUKV), 64, scr, r, lane, ColUkv(), A.kv_norm_g, &amx[5]); continue; } r -= I_UKV;
            if (r < I_PA) { transpose_item(A.w_pa, 1024, 2048, (bf16*)(ws + WS_WPA), 64, scr, r, lane, ColId(), nullptr, &amx[1]); continue; } r -= I_PA;
            if (r < I_PB) { transpose_item(A.w_pb, 1024, 2048, (bf16*)(ws + WS_WPB), 64, scr, r, lane, ColId(), nullptr, &amx[2]); continue; } r -= I_PB;
            transpose_item(A.w_o, 2048, 2048, (bf16*)(ws + WS_WO), 64, scr, r, lane, ColId(), nullptr, &amx[3]);
        }
        { v4u* z = (v4u*)(ws + WS_WKR + (size_t)64 * 2048 * 2); const int n16 = 192 * 2048 * 2 / 16;
          for (int i = blockIdx.x * (NWAVES * 64) + tid; i < n16; i += G * NWAVES * 64) z[i] = (v4u){0u, 0u, 0u, 0u}; }
#pragma unroll
        for (int m = 0; m < 6; ++m) {
            amx[m] = wave_max(amx[m]); }
        if (lane == 0) {
#pragma unroll
            for (int m = 0; m < 6; ++m) scr[2112 + m] = amx[m]; }
    }
    __syncthreads();
    if (tid < 6) { float am = 0.f;
#pragma unroll
        for (int w = 0; w < NWAVES; ++w) am = fmaxf(am, ((LAS float*)(lds + w * 16384))[2112 + tid]);
        atomicMax((unsigned*)(ws + WS_CTL) + CW_WMAX + tid, __float_as_uint(am)); }
    __syncthreads();
    {
        bf16* wsk = (bf16*)(ws + WS_WSK);
        const int m16 = lane & 15, kq = lane >> 4;
        for (int it = gw; it < 16 * 128; it += NGW) {
            const int hp = it >> 7, k0 = (it & 127) * 16;
            bf16x8 af[4];
#pragma unroll
            for (int ks = 0; ks < 4; ++ks) { const float* p = A.peer_wq + (size_t)(k0 + m16) * 2048 + hp * 128 + 32 * ks + 8 * kq; const f32x4 x0 = *(const f32x4*)p, x1 = *(const f32x4*)(p + 4);
                const v4u w = {pg8::cvt_pk_bf16(x0[0], x0[1]), pg8::cvt_pk_bf16(x0[2], x0[3]), pg8::cvt_pk_bf16(x1[0], x1[1]), pg8::cvt_pk_bf16(x1[2], x1[3])}; af[ks] = __builtin_bit_cast(bf16x8, w); }
#pragma unroll 2
            for (int nb = 0; nb < 8; ++nb) { f32x4 acc = {0.f, 0.f, 0.f, 0.f};
#pragma unroll
                for (int ks = 0; ks < 4; ++ks) { const float* p = A.peer_keys + (size_t)hp * 16384 + (size_t)(nb * 16 + m16) * 128 + 32 * ks + 8 * kq; const f32x4 x0 = *(const f32x4*)p, x1 = *(const f32x4*)(p + 4);
                    const v4u w = {pg8::cvt_pk_bf16(x0[0], x0[1]), pg8::cvt_pk_bf16(x0[2], x0[3]), pg8::cvt_pk_bf16(x1[0], x1[1]), pg8::cvt_pk_bf16(x1[2], x1[3])};
                    acc = __builtin_amdgcn_mfma_f32_16x16x32_bf16(af[ks], __builtin_bit_cast(bf16x8, w), acc, 0, 0, 0); }
                v2u o; o.x = pk2(acc[0], acc[1]); o.y = pk2(acc[2], acc[3]);
                *(v2u*)(wsk + (size_t)(hp * 128 + nb * 16 + m16) * 2048 + k0 + 4 * kq) = o; }
        }
    }
#pragma unroll 2
    for (int rw = gw; rw < 2 * 16384; rw += NGW) {
        const float* src = (rw < 16384 ? A.peer_u : A.peer_v) + (size_t)(rw & 16383) * 2048;
        unsigned char* dst = ws + (rw < 16384 ? WS_UT : WS_VT) + (size_t)(rw & 16383) * 1024;
        f32x4 v[8]; float am = 0.f;
#pragma unroll
        for (int q = 0; q < 8; ++q) { v[q] = __builtin_nontemporal_load((const f32x4*)(src + q * 256 + lane * 4)); am = fmaxf(am, fmaxf(fmaxf(fabsf(v[q][0]), fabsf(v[q][1])), fmaxf(fabsf(v[q][2]), fabsf(v[q][3])))); }
        if (rw < 16384) {
            float ss = 0.f;
#pragma unroll
            for (int q = 0; q < 8; ++q) ss += (v[q][0] * v[q][0] + v[q][1] * v[q][1]) + (v[q][2] * v[q][2] + v[q][3] * v[q][3]);
            ss = wave_sum(ss);
            const float step = 0.3352f * sqrtf(ss * (1.0f / 2048.0f)), inv = ss > 0.f ? 1.0f / step : 0.f;
            if (lane == 0) ((float*)(ws + WS_TSCALE))[rw] = step;
#pragma unroll
            for (int q = 0; q < 8; ++q) { unsigned h = 0u;
#pragma unroll
                for (int m = 0; m < 4; ++m) { int qi = (int)floorf(v[q][m] * inv); qi = qi < -8 ? -8 : (qi > 7 ? 7 : qi); h |= ((unsigned)qi & 15u) << (4 * m); }
                *(unsigned short*)(ws + WS_UT + (size_t)q * UT_SLICE + (size_t)rw * 128 + lane * 2) = (unsigned short)h; }
            continue;
        }
        am = wave_max(am);
        const float sc = am > 0.f ? 6.0f / am : 1.0f;
        if (lane == 0) ((float*)(ws + WS_TSCALE))[rw] = am > 0.f ? am / 6.0f : 1.0f;
        v4u o;
#pragma unroll
        for (int k = 0; k < 4; ++k) { const f32x4 f0 = v[2 * k] * sc, f1 = v[2 * k + 1] * sc; unsigned w = 0u;
            w = __builtin_amdgcn_cvt_scalef32_pk_fp4_f32(w, f0[0], f0[1], 1.0f, 0); w = __builtin_amdgcn_cvt_scalef32_pk_fp4_f32(w, f0[2], f0[3], 1.0f, 1);
            w = __builtin_amdgcn_cvt_scalef32_pk_fp4_f32(w, f1[0], f1[1], 1.0f, 2); w = __builtin_amdgcn_cvt_scalef32_pk_fp4_f32(w, f1[2], f1[3], 1.0f, 3); o[k] = w; }
#pragma unroll
        for (int k = 0; k < 4; ++k) {
            *(unsigned short*)(ws + WS_VT + (size_t)(2 * k) * UT_SLICE + (size_t)(rw & 16383) * 128 + lane * 2) = (unsigned short)(o[k] & 0xffffu);
            *(unsigned short*)(ws + WS_VT + (size_t)(2 * k + 1) * UT_SLICE + (size_t)(rw & 16383) * 128 + lane * 2) = (unsigned short)(o[k] >> 16); }
    }
    {
        float* cs = (float*)(ws + WS_CS);
        for (int i = blockIdx.x * (NWAVES * 64) + tid; i < TOK * 32; i += G * NWAVES * 64) { const int t = i >> 5, j = i & 31;
            const float inv = powf(10000.0f, -(float)(2 * j) / 64.0f); const float ang = (float)A.positions[t] * inv;
            cs[(size_t)i * 2] = cosf(ang); cs[(size_t)i * 2 + 1] = sinf(ang); }
        float* bs = (float*)(ws + WS_BIAS);
        for (int i = blockIdx.x * (NWAVES * 64) + tid; i < 8192 + 64; i += G * NWAVES * 64) bs[i] = i < 8192 ? A.b_in[i < 4096 ? i : i + 64] : A.b_in[4096 + ((i - 8192) >> 1) + 32 * ((i - 8192) & 1)];
    }
}

__device__ __forceinline__ unsigned pk4_fp8(float a, float b, float c, float d) { int w = __builtin_amdgcn_cvt_pk_fp8_f32(a, b, 0, false); w = __builtin_amdgcn_cvt_pk_fp8_f32(c, d, w, true); return (unsigned)w; }
__device__ __forceinline__ void p1_w8(const unsigned char* srcb, unsigned char* dstb, int n8, float wq, int lane, int gw, int NGW) {
    const v4u* src = (const v4u*)srcb; v2u* dst = (v2u*)dstb;
    for (int i = gw * 64 + lane; i < n8; i += NGW * 64) { const v4u w = src[i]; v2u o;
        o.x = pk4_fp8(bflo(w.x) * wq, bfhi(w.x) * wq, bflo(w.y) * wq, bfhi(w.y) * wq); o.y = pk4_fp8(bflo(w.z) * wq, bfhi(w.z) * wq, bflo(w.w) * wq, bfhi(w.w) * wq); dst[i] = o; }
}
__device__ __forceinline__ void p1_modulate(const Args& A, int lane, int gw, int NGW) {
    const float* mod = (const float*)(A.ws + WS_MOD); unsigned* H8 = (unsigned*)(A.ws + WS_H8); float* hsc = (float*)(A.ws + WS_HSC);
    constexpr int R = 4;
    for (int t0 = gw * R; t0 < TOK; t0 += NGW * R) { const int b = t0 >> 12; const float* sh = mod + (size_t)b * (6 * DM); const float* sc = sh + DM;
        f32x4 hv[R][8];
#pragma unroll
        for (int r = 0; r < R; ++r)
#pragma unroll
            for (int j = 0; j < 8; ++j) hv[r][j] = __builtin_nontemporal_load((const f32x4*)(A.x + (size_t)(t0 + r) * DM + j * 256 + lane * 4));
        float am[R];
#pragma unroll
        for (int r = 0; r < R; ++r) am[r] = 0.f;
#pragma unroll
        for (int j = 0; j < 8; ++j) { const int c = j * 256 + lane * 4; const f32x4 s1 = *(const f32x4*)(sc + c) + 1.0f, s0 = *(const f32x4*)(sh + c);
#pragma unroll
            for (int r = 0; r < R; ++r) { hv[r][j] = hv[r][j] * s1 + s0; am[r] = fmaxf(am[r], fmaxf(fmaxf(fabsf(hv[r][j][0]), fabsf(hv[r][j][1])), fmaxf(fabsf(hv[r][j][2]), fabsf(hv[r][j][3])))); } }
#pragma unroll
        for (int r = 0; r < R; ++r) {
            am[r] = wave_max(am[r]);
            const float q = am[r] > 0.f ? 440.0f / am[r] : 1.0f;
            if (lane == 0) hsc[t0 + r] = am[r] > 0.f ? am[r] * (1.0f / 440.0f) : 1.0f;
#pragma unroll
            for (int j = 0; j < 8; ++j) { const int c = j * 256 + lane * 4; H8[((size_t)(t0 + r) * DM + c) >> 2] = pk4_fp8(hv[r][j][0] * q, hv[r][j][1] * q, hv[r][j][2] * q, hv[r][j][3] * q); } } }
    { const unsigned* wm = (const unsigned*)(A.ws + WS_CTL) + CW_WMAX;
      p1_w8(A.ws + WS_WIN, A.ws + WS_W8, 8192 * 2048 / 8, 440.0f / __uint_as_float(wm[0]), lane, gw, NGW);
      p1_w8(A.ws + WS_WKR, A.ws + WS_WKR8, 256 * 2048 / 8, 440.0f / __uint_as_float(wm[0]), lane, gw, NGW);
      p1_w8(A.ws + WS_WPA, A.ws + WS_WPA8, 2048 * 1024 / 8, 440.0f / __uint_as_float(wm[1]), lane, gw, NGW);
      p1_w8(A.ws + WS_WPB, A.ws + WS_WPB8, 2048 * 1024 / 8, 440.0f / __uint_as_float(wm[2]), lane, gw, NGW);
      p1_w8(A.ws + WS_WO, A.ws + WS_WO8, 2048 * 2048 / 8, 440.0f / __uint_as_float(wm[3]), lane, gw, NGW);
      p1_w8(A.ws + WS_WUQ, A.ws + WS_WUQ8, 1536 * 512 / 8, 440.0f / __uint_as_float(wm[4]), lane, gw, NGW);
      p1_w8(A.ws + WS_WUKV, A.ws + WS_WUKV8, 2048 * 512 / 8, 440.0f / __uint_as_float(wm[5]), lane, gw, NGW); }
}
__device__ __forceinline__ void p7_ln1(const Args& A, int lane, int gw, int NGW) {
    const float* mod = (const float*)(A.ws + WS_MOD); bf16* H = (bf16*)(A.ws + WS_H); float* st = (float*)(A.ws + WS_LN1);
    constexpr int R = 4;
    for (int t0 = gw * R; t0 < TOK; t0 += NGW * R) { const int b = t0 >> 12; const float* sh = mod + ((size_t)b * 6 + 3) * DM; const float* sc = sh + DM;
        f32x4 v[R][8];
#pragma unroll
        for (int r = 0; r < R; ++r)
#pragma unroll
            for (int j = 0; j < 8; ++j) { const v2u w = *(const v2u*)((const bf16*)(A.ws + WS_U1B) + (size_t)(t0 + r) * DM + j * 256 + lane * 4); v[r][j] = (f32x4){bflo(w.x), bfhi(w.x), bflo(w.y), bfhi(w.y)}; }
        float rstd[R], am[R];
#pragma unroll
        for (int r = 0; r < R; ++r) am[r] = 0.f;
#pragma unroll
        for (int r = 0; r < R; ++r) { float s = 0.f;
#pragma unroll
            for (int j = 0; j < 8; ++j) s += (v[r][j][0] + v[r][j][1]) + (v[r][j][2] + v[r][j][3]);
            const float mean = wave_sum(s) * (1.0f / DM); float q = 0.f;
#pragma unroll
            for (int j = 0; j < 8; ++j) { v[r][j] = v[r][j] - mean; q += (v[r][j][0] * v[r][j][0] + v[r][j][1] * v[r][j][1]) + (v[r][j][2] * v[r][j][2] + v[r][j][3] * v[r][j][3]); }
            rstd[r] = 1.0f / sqrtf(wave_sum(q) * (1.0f / DM) + LN_EPS);
            if (lane == 0) { st[(size_t)(t0 + r) * 2] = mean; st[(size_t)(t0 + r) * 2 + 1] = rstd[r]; } }
#pragma unroll
        for (int j = 0; j < 8; ++j) { const int c = j * 256 + lane * 4; const f32x4 g = *(const f32x4*)(A.ln1_g + c), bb = *(const f32x4*)(A.ln1_b + c), s1 = *(const f32x4*)(sc + c), s0 = *(const f32x4*)(sh + c);
#pragma unroll
            for (int r = 0; r < R; ++r) { const f32x4 x1 = v[r][j] * rstd[r] * g + bb; const f32x4 hv = x1 * (s1 + 1.0f) + s0; v2u o; o.x = pk2(hv[0], hv[1]); o.y = pk2(hv[2], hv[3]); *(v2u*)(H + (size_t)(t0 + r) * DM + c) = o;
                v[r][j] = hv; am[r] = fmaxf(am[r], fmaxf(fmaxf(fabsf(hv[0]), fabsf(hv[1])), fmaxf(fabsf(hv[2]), fabsf(hv[3])))); } }
#pragma unroll
        for (int r = 0; r < R; ++r) {
            am[r] = wave_max(am[r]);
            const float inv = am[r] > 0.f ? 119.0f / am[r] : 0.f; int ssum = 0;
#pragma unroll
            for (int j = 0; j < 8; ++j) { unsigned hh = 0u, ll = 0u;
#pragma unroll
                for (int m = 0; m < 4; ++m) { const int x8 = (int)rintf(v[r][j][m] * inv); const int lo = ((x8 + 8) & 15) - 8, hi = (x8 - lo) >> 4; ssum += x8; hh |= ((unsigned)hi & 15u) << (4 * m); ll |= ((unsigned)lo & 15u) << (4 * m); }
                *(unsigned short*)(A.ws + WS_XH + (size_t)(t0 + r) * 1024 + j * 128 + lane * 2) = (unsigned short)hh;
                *(unsigned short*)(A.ws + WS_XL + (size_t)(t0 + r) * 1024 + j * 128 + lane * 2) = (unsigned short)ll; }
            ssum = wave_sum_int(ssum);
            if (lane == 0) { ((float*)(A.ws + WS_SX))[t0 + r] = am[r] * (1.0f / 119.0f); ((int*)(A.ws + WS_S8))[t0 + r] = ssum; } } }
}


__device__ __forceinline__ float max2f(float a, float b) { float r; asm("v_max_f32_e32 %0, %1, %2" : "=v"(r) : "v"(a), "v"(b)); return r; }
__device__ __forceinline__ float min2f(float a, float b) { float r; asm("v_min_f32_e32 %0, %1, %2" : "=v"(r) : "v"(a), "v"(b)); return r; }
#define INS16(L, x) do { _Pragma("unroll") for (int k_ = 0; k_ < 16; ++k_) { const float h_ = max2f(L[k_], x); x = min2f(L[k_], x); L[k_] = h_; } } while (0)
__device__ __forceinline__ void topk16_128(const float* __restrict__ src, float (&L)[16]) {
#pragma unroll
    for (int k = 0; k < 16; ++k) L[k] = -INFINITY;
#pragma unroll 4
    for (int i = 0; i < 32; ++i) { const f32x4 v = *(const f32x4*)(src + 4 * i);
#pragma unroll
        for (int e = 0; e < 4; ++e) { float x = __uint_as_float((__float_as_uint(v[e]) & ~127u) | (unsigned)(4 * i + e)); INS16(L, x); } }
}
__device__ __forceinline__ float dot2bf(unsigned a, unsigned b, float acc) { return __builtin_amdgcn_fdot2_f32_bf16(__builtin_bit_cast(bf16x2_t, a), __builtin_bit_cast(bf16x2_t, b), acc, false); }
__device__ __forceinline__ float dot8(const v4u a, const v4u b, float acc) {
    const unsigned a0 = a[0], a1 = a[1], a2 = a[2], a3 = a[3], b0 = b[0], b1 = b[1], b2 = b[2], b3 = b[3];
    acc = dot2bf(a0, b0, acc); acc = dot2bf(a1, b1, acc); acc = dot2bf(a2, b2, acc); acc = dot2bf(a3, b3, acc);
    return acc;
}

constexpr int RB = 8;
typedef float f32x2g __attribute__((ext_vector_type(2)));
#define P9_LOAD(BUF, TAB, EV, L0) do { _Pragma("unroll") for (int i_ = 0; i_ < RB; ++i_) { const int id_ = __builtin_amdgcn_readlane((EV), (L0) + i_); \
        BUF[i_] = ((const v4u*)((TAB) + (size_t)id_ * 1024))[lane]; } } while (0)
__device__ __forceinline__ float gelu_as(float v) {
    const float av = fabsf(v), t = __builtin_amdgcn_rcpf(av * 0.2316418882f + 1.0f);
    float q = t * 0.5307027145f + (-0.7265760135f); q = q * t + 0.7107068705f; q = q * t + (-0.142248368f); q = q * t + 0.127414796f; q = q * t;
    const float e = __builtin_amdgcn_exp2f((v * v) * (-0.72134752044f)); const float m = v * (q * e);
    return v < 0.f ? m : v - m;
}
typedef __bf16 bf16x2p __attribute__((ext_vector_type(2)));
__device__ __forceinline__ float p9_dot(const v4u d, const v2u (&xq)[8]) {
    float s0 = 0.f, s1 = 0.f;
#pragma unroll
    for (int k = 0; k < 4; ++k) { const unsigned w = d[k]; const unsigned x0 = xq[2 * k][0], x1 = xq[2 * k][1], x2 = xq[2 * k + 1][0], x3 = xq[2 * k + 1][1];
        s0 = __builtin_amdgcn_fdot2_f32_bf16(__builtin_amdgcn_cvt_scalef32_pk_bf16_fp4(w, 1.0f, 0), __builtin_bit_cast(bf16x2p, x0), s0, false);
        s1 = __builtin_amdgcn_fdot2_f32_bf16(__builtin_amdgcn_cvt_scalef32_pk_bf16_fp4(w, 1.0f, 1), __builtin_bit_cast(bf16x2p, x1), s1, false);
        s0 = __builtin_amdgcn_fdot2_f32_bf16(__builtin_amdgcn_cvt_scalef32_pk_bf16_fp4(w, 1.0f, 2), __builtin_bit_cast(bf16x2p, x2), s0, false);
        s1 = __builtin_amdgcn_fdot2_f32_bf16(__builtin_amdgcn_cvt_scalef32_pk_bf16_fp4(w, 1.0f, 3), __builtin_bit_cast(bf16x2p, x3), s1, false); }
    return s0 + s1;
}
__device__ __forceinline__ void p9_axpy(const v4u d, float wgt, f32x2g (&acc)[16]) {
    const f32x2g w2 = {wgt, wgt};
#pragma unroll
    for (int k = 0; k < 4; ++k) { const unsigned w = d[k];
        acc[4 * k]     = __builtin_elementwise_fma(__builtin_amdgcn_cvt_scalef32_pk_f32_fp4(w, 1.0f, 0), w2, acc[4 * k]);
        acc[4 * k + 1] = __builtin_elementwise_fma(__builtin_amdgcn_cvt_scalef32_pk_f32_fp4(w, 1.0f, 1), w2, acc[4 * k + 1]);
        acc[4 * k + 2] = __builtin_elementwise_fma(__builtin_amdgcn_cvt_scalef32_pk_f32_fp4(w, 1.0f, 2), w2, acc[4 * k + 2]);
        acc[4 * k + 3] = __builtin_elementwise_fma(__builtin_amdgcn_cvt_scalef32_pk_f32_fp4(w, 1.0f, 3), w2, acc[4 * k + 3]); }
}
__device__ __forceinline__ float p9_reduce8(const float (&p)[8], int lane) {
    const bool b5 = (lane & 32) != 0, b4 = (lane & 16) != 0, b3 = (lane & 8) != 0; float r[4], s[2];
#pragma unroll
    for (int k = 0; k < 4; ++k) { const float keep = b5 ? p[k + 4] : p[k], send = b5 ? p[k] : p[k + 4]; r[k] = keep + __shfl_xor(send, 32); }
#pragma unroll
    for (int k = 0; k < 2; ++k) { const float keep = b4 ? r[k + 2] : r[k], send = b4 ? r[k] : r[k + 2]; s[k] = keep + __shfl_xor(send, 16); }
    float t; { const float keep = b3 ? s[1] : s[0], send = b3 ? s[0] : s[1]; t = keep + __shfl_xor(send, 8); }
    t += __shfl_xor(t, 4); t += __shfl_xor(t, 2); t += __shfl_xor(t, 1);
    return t;
}
__device__ __forceinline__ void p9a_topk(const Args& A, int lane_in, int gw, int NGW) {
    unsigned char* ws = A.ws; const float* SC = (const float*)(ws + WS_SCORE);
    for (int task = gw; task < TOK / 8; task += NGW) {
        int lane = lane_in; asm volatile("" : "+v"(lane));
        const int tl = lane >> 3, hd = lane & 7; const float* srow = SC + (size_t)(task * 8 + tl) * 2048 + hd * 256;
        float L0[16], L1[16], R[16];
        topk16_128(srow, L0); topk16_128(srow + 128, L1);
#pragma unroll
        for (int k = 0; k < 16; ++k) R[k] = -INFINITY;
#pragma unroll
        for (int i = 0; i < 16; ++i)
#pragma unroll
            for (int j = 0; j < 16; ++j) if ((i + 1) * (j + 1) <= 16) { float x = __uint_as_float((__float_as_uint(L0[i] + L1[j]) & ~255u) | (unsigned)(i * 16 + j)); INS16(R, x); __builtin_amdgcn_sched_barrier(0); }
        const float mx = __uint_as_float(__float_as_uint(R[0]) & ~255u); float ex[16], es = 0.f;
#pragma unroll
        for (int r = 0; r < 16; ++r) { ex[r] = __expf(__uint_as_float(__float_as_uint(R[r]) & ~255u) - mx); es += ex[r]; }
        const float inv = 1.0f / es;
        unsigned idp[8];
#pragma unroll
        for (int r = 0; r < 16; ++r) { const unsigned code = __float_as_uint(R[r]) & 255u, ci = code >> 4, cj = code & 15u; unsigned e1 = 0u, e2 = 0u;
#pragma unroll
            for (int k = 0; k < 16; ++k) { e1 = (ci == (unsigned)k) ? (__float_as_uint(L0[k]) & 127u) : e1; e2 = (cj == (unsigned)k) ? (__float_as_uint(L1[k]) & 127u) : e2; }
            const unsigned e = e1 * 128u + e2; if (r & 1) idp[r >> 1] |= e << 16; else idp[r >> 1] = e; ex[r] *= inv; __builtin_amdgcn_sched_barrier(0); }
        const size_t slot0 = (size_t)(task * 8 + tl) * 128 + hd * 16;
        v4u* ip = (v4u*)(ws + WS_IDS + slot0 * 2); ip[0] = (v4u){idp[0], idp[1], idp[2], idp[3]}; ip[1] = (v4u){idp[4], idp[5], idp[6], idp[7]};
        { unsigned* tp = (unsigned*)(ws + WS_IDT + (size_t)(task * 8 + tl) * 256 + hd * 4);
#pragma unroll
          for (int g = 0; g < 8; ++g) { const unsigned lo = (idp[g >> 1] >> (16 * (g & 1))) & 0xffffu, hi = (idp[4 + (g >> 1)] >> (16 * (g & 1))) & 0xffffu; tp[g * 8] = lo | (hi << 16); } }
        f32x4* gp = (f32x4*)(ws + WS_GATES + slot0 * 4);
#pragma unroll
        for (int k = 0; k < 4; ++k) gp[k] = (f32x4){ex[4 * k], ex[4 * k + 1], ex[4 * k + 2], ex[4 * k + 3]};
    }
}

typedef int v2i __attribute__((ext_vector_type(2)));
__device__ __forceinline__ int dpp_add8(int v) {
    v += __builtin_amdgcn_update_dpp(0, v, 0xB1, 0xF, 0xF, true);
    v += __builtin_amdgcn_update_dpp(0, v, 0x4E, 0xF, 0xF, true);
    v += __builtin_amdgcn_update_dpp(0, v, 0x141, 0xF, 0xF, true);
    return v;
}
#define P10_IDS(IDW, JP) __builtin_amdgcn_ds_swizzle((int)(IDW), 0x18 | ((JP) << 5))
#define P10_LOAD1(BUF, IDW, HALF, JP) do { const unsigned pr_ = (unsigned)P10_IDS(IDW, (HALF) * 4 + (JP)); \
        BUF[2 * (JP)] = *(const v4u*)(UTx + ((pr_ & 0xffffu) * 128u + s16)); BUF[2 * (JP) + 1] = *(const v4u*)(UTx + ((pr_ >> 16) * 128u + s16)); } while (0)
#define P10_LOAD(BUF, IDW, HALF) do { P10_LOAD1(BUF, IDW, HALF, 0); P10_LOAD1(BUF, IDW, HALF, 1); P10_LOAD1(BUF, IDW, HALF, 2); P10_LOAD1(BUF, IDW, HALF, 3); } while (0)
#define P10_DOTS(BUF, HALF) do { _Pragma("unroll") for (int i_ = 0; i_ < 8; ++i_) { int d1_ = 0, d2_ = 0; \
        _Pragma("unroll") for (int k_ = 0; k_ < 4; ++k_) { d1_ = __builtin_amdgcn_sdot8((int)BUF[i_][k_], (int)xh[k_], d1_, false); d2_ = __builtin_amdgcn_sdot8((int)BUF[i_][k_], (int)xl[k_], d2_, false); } \
        res[(HALF) * 8 + i_] = dpp_add8(d1_ * 16 + d2_); } } while (0)
__device__ __forceinline__ void p10_udot(const Args& A, int lane_in, int wave, int bx, int G) {
    unsigned char* ws = A.ws;
    const int x = bx & 7, nblk = (G - x + 7) >> 3, stride = nblk * NWAVES;
    const unsigned char* UTx = ws + WS_UT + (size_t)x * UT_SLICE;
    int lane = lane_in; asm volatile("" : "+v"(lane));
    const unsigned s16 = (unsigned)(lane & 7) * 16u;
    const unsigned* IDS32 = (const unsigned*)(ws + WS_IDS);
    int* PA = (int*)(ws + WS_PA) + (size_t)x * TOK * 128;
    int t = (bx >> 3) * NWAVES + wave; if (t >= TOK) return;
    v4u bufA[8], bufB[8];
    unsigned idw = IDS32[(size_t)t * 64 + lane];
    v4u xh = *(const v4u*)(ws + WS_XH + (size_t)t * 1024 + x * 128 + s16), xl = *(const v4u*)(ws + WS_XL + (size_t)t * 1024 + x * 128 + s16);
    P10_LOAD(bufA, idw, 0); P10_LOAD(bufB, idw, 1);
#pragma unroll 1
    for (;;) {
        const int tn = t + stride; const bool more = tn < TOK;
        unsigned idwn = 0u; v4u xhn = xh, xln = xl;
        if (more) { idwn = IDS32[(size_t)tn * 64 + lane]; xhn = *(const v4u*)(ws + WS_XH + (size_t)tn * 1024 + x * 128 + s16); xln = *(const v4u*)(ws + WS_XL + (size_t)tn * 1024 + x * 128 + s16); }
        int res[16];
        P10_DOTS(bufA, 0);
        if (more) P10_LOAD(bufA, idwn, 0);
        P10_DOTS(bufB, 1);
        if (more) P10_LOAD(bufB, idwn, 1);
        int r0 = res[0], r1 = res[1];
#pragma unroll
        for (int k = 1; k < 8; ++k) { const bool m = (lane & 7) == k; r0 = m ? res[2 * k] : r0; r1 = m ? res[2 * k + 1] : r1; }
        *(v2i*)(PA + (size_t)t * 128 + 2 * lane) = (v2i){r0, r1};
        if (!more) break;
        t = tn; idw = idwn; xh = xhn; xl = xln;
    }
}
#undef P10_IDS
#undef P10_LOAD
#undef P10_LOAD1
#undef P10_DOTS

__device__ __forceinline__ void p11_w(const Args& A, int lane, int gw, int NGW) {
    unsigned char* ws = A.ws; const unsigned* IDS32 = (const unsigned*)(ws + WS_IDS); const int* PA = (const int*)(ws + WS_PA);
    const float* SU = (const float*)(ws + WS_TSCALE); const float* SV = SU + 16384; const float* SX = (const float*)(ws + WS_SX); const int* S8 = (const int*)(ws + WS_S8);
    for (int t = gw; t < TOK; t += NGW) {
        const unsigned idw = IDS32[(size_t)t * 64 + lane]; const int id0 = (int)(idw & 0xffffu), id1 = (int)(idw >> 16);
        int s0 = 0, s1 = 0;
#pragma unroll
        for (int x = 0; x < 8; ++x) { const v2i p = *(const v2i*)(PA + ((size_t)x * TOK + t) * 128 + 2 * lane); s0 += p.x; s1 += p.y; }
        const float sxt = SX[t], half = 0.5f * (float)S8[t];
        const float a0 = SU[id0] * sxt * ((float)s0 + half), a1 = SU[id1] * sxt * ((float)s1 + half);
        const f32x2g gt = *(const f32x2g*)(ws + WS_GATES + ((size_t)t * 128 + 2 * lane) * 4);
        f32x2g w; w.x = gt.x * SV[id0] * gelu_as(a0); w.y = gt.y * SV[id1] * gelu_as(a1);
        float am = fmaxf(fabsf(w.x), fabsf(w.y));
        am = wave_max(am);
        const float sc = am > 0.f ? 224.0f / am : 0.f;
        const int ph = __builtin_amdgcn_cvt_pk_fp8_f32(w.x * sc, w.y * sc, 0, false); const f32x2g bk = __builtin_amdgcn_cvt_pk_f32_fp8(ph, false);
        const int pl = __builtin_amdgcn_cvt_pk_fp8_f32(w.x * sc - bk.x, w.y * sc - bk.y, 0, false);
        *(unsigned short*)(ws + WS_W + (size_t)t * 256 + 2 * lane) = (unsigned short)(ph & 0xffff); *(unsigned short*)(ws + WS_W + (size_t)t * 256 + 128 + 2 * lane) = (unsigned short)(pl & 0xffff);
        if (lane == 0) ((float*)(ws + WS_WSC))[t] = am > 0.f ? am * (1.0f / 224.0f) : 0.f;
    }
}

typedef int i32x8v __attribute__((ext_vector_type(8)));
#define P12_TRRD(dst, ad, off) asm volatile("ds_read_b64_tr_b4 %0, %1 offset:%2" : "=&v"(dst) : "v"(ad), "i"(off) : "memory")
#define P12_DMA(IA, IB) do { _Pragma("unroll") for (int q_ = 0; q_ < 16; ++q_) { const unsigned wd_ = (q_ < 8) ? IA[(q_ & 7) >> 1] : IB[(q_ & 7) >> 1]; const unsigned id_ = (q_ & 1) ? (wd_ >> 16) : (wd_ & 0xffffu); \
        __builtin_amdgcn_global_load_lds((const unsigned*)(VTx + (id_ * 128u + ((q_ & 1) ? cs_odd : cs_even))), (LAS unsigned*)(ldsp + q_ * 1024), 16, 0, 0); } } while (0)
#define P12_RD(J, R) do { \
        P12_TRRD(R[0], tra[(J) >> 1], 8 * ((J) & 1)); P12_TRRD(R[1], tra[(J) >> 1], 2048 + 8 * ((J) & 1)); \
        P12_TRRD(R[2], tra[2 + ((J) >> 1)], 8 * ((J) & 1)); P12_TRRD(R[3], tra[2 + ((J) >> 1)], 2048 + 8 * ((J) & 1)); \
        P12_TRRD(R[4], tra[4 + ((J) >> 1)], 8 * ((J) & 1)); P12_TRRD(R[5], tra[4 + ((J) >> 1)], 2048 + 8 * ((J) & 1)); \
        P12_TRRD(R[6], tra[6 + ((J) >> 1)], 8 * ((J) & 1)); P12_TRRD(R[7], tra[6 + ((J) >> 1)], 2048 + 8 * ((J) & 1)); } while (0)
#define P12_MF1(I, R, W) do { asm volatile("s_waitcnt lgkmcnt(" #W ")" : "+v"(R[2 * (I)]), "+v"(R[2 * (I) + 1])); \
        acc[I] = __builtin_amdgcn_mfma_scale_f32_16x16x128_f8f6f4(aj_, (i32x8v){(int)R[2 * (I)][0], (int)R[2 * (I)][1], (int)R[2 * (I) + 1][0], (int)R[2 * (I) + 1][1], 0, 0, 0, 0}, acc[I], 0, 4, 0, 0x7f7f7f7f, 0, 0x7f7f7f7f); } while (0)
#define P12_AJ(J) do { const bool on_ = avalid && (jl == (J)); aj_[0] = on_ ? (int)a0[0] : 0; aj_[1] = on_ ? (int)a0[1] : 0; aj_[2] = on_ ? (int)a0[2] : 0; aj_[3] = on_ ? (int)a0[3] : 0; \
        aj_[4] = on_ ? (int)a1[0] : 0; aj_[5] = on_ ? (int)a1[1] : 0; aj_[6] = on_ ? (int)a1[2] : 0; aj_[7] = on_ ? (int)a1[3] : 0; } while (0)
#define P12_MMA() do { v2u ra_[8], rb_[8], rc_[8]; i32x8v aj_; \
        P12_RD(0, ra_); P12_RD(1, rb_); \
        P12_AJ(0); P12_MF1(0, ra_, 14); P12_MF1(1, ra_, 12); P12_MF1(2, ra_, 10); P12_MF1(3, ra_, 8); \
        P12_RD(2, rc_); \
        P12_AJ(1); P12_MF1(0, rb_, 14); P12_MF1(1, rb_, 12); P12_MF1(2, rb_, 10); P12_MF1(3, rb_, 8); \
        P12_RD(3, ra_); \
        P12_AJ(2); P12_MF1(0, rc_, 14); P12_MF1(1, rc_, 12); P12_MF1(2, rc_, 10); P12_MF1(3, rc_, 8); \
        P12_AJ(3); P12_MF1(0, ra_, 6); P12_MF1(1, ra_, 4); P12_MF1(2, ra_, 2); P12_MF1(3, ra_, 0); } while (0)
__device__ __forceinline__ float wave_sum_dpp(float v) {
    v += __int_as_float(__builtin_amdgcn_update_dpp(0, __float_as_int(v), 0xB1, 0xF, 0xF, true));
    v += __int_as_float(__builtin_amdgcn_update_dpp(0, __float_as_int(v), 0x4E, 0xF, 0xF, true));
    v += __int_as_float(__builtin_amdgcn_update_dpp(0, __float_as_int(v), 0x141, 0xF, 0xF, true));
    v += __int_as_float(__builtin_amdgcn_update_dpp(0, __float_as_int(v), 0x140, 0xF, 0xF, true));
    { const auto r = __builtin_amdgcn_permlane16_swap(__float_as_uint(v), __float_as_uint(v), false, false); v = __uint_as_float(r[0]) + __uint_as_float(r[1]); }
    { const auto r = __builtin_amdgcn_permlane32_swap(__float_as_uint(v), __float_as_uint(v), false, false); v = __uint_as_float(r[0]) + __uint_as_float(r[1]); }
    return v;
}
__device__ __forceinline__ void p12_vslice(const Args& A, LAS unsigned char* lds, int lane_in, int wave, int bx, int G) {
    unsigned char* ws = A.ws;
    const int x = bx & 7, nblk = (G - x + 7) >> 3, stride = nblk * NWAVES;
    const unsigned char* VTx = ws + WS_VT + (size_t)x * UT_SLICE;
    int lane = lane_in; asm volatile("" : "+v"(lane));
    LAS unsigned char* ldsp = lds + wave * 16384;
    const int gq = lane >> 3, sq = lane & 7;
    const unsigned cs_even = 16u * (unsigned)(sq ^ (gq >> 1)), cs_odd = 16u * (unsigned)(sq ^ (4 + (gq >> 1)));
    const unsigned idoff = (unsigned)gq * 32u;
    const int i16 = lane & 15, kq = lane >> 4;
    unsigned tra[8];
    { const unsigned rowb = (unsigned)(uintptr_t)ldsp + (unsigned)(32 * kq + i16) * 128u, sw = (unsigned)(i16 >> 1) & 7u;
#pragma unroll
      for (int c = 0; c < 8; ++c) tra[c] = rowb + (((unsigned)c ^ sw) << 4); }
    const bool avalid = (i16 & 3) < 2; const int jl = i16 >> 2;
    const unsigned aoff = (unsigned)(i16 & 1) * 128u + (unsigned)kq * 16u;
    const unsigned char* IDT = ws + WS_IDT; const unsigned char* WQ8 = ws + WS_W; const float* WSC = (const float*)(ws + WS_WSC);
    const float* st1 = (const float*)(ws + WS_LN1); const float* mod = (const float*)(ws + WS_MOD); const bf16* U1B = (const bf16*)(ws + WS_U1B); bf16* U2 = (bf16*)(ws + WS_H);
    f32x2g* ST2 = (f32x2g*)(ws + WS_ST2) + (size_t)x * TOK;
    const int c0 = x * 256 + lane;
    float g1[4], b1[4];
#pragma unroll
    for (int i = 0; i < 4; ++i) { g1[i] = A.ln1_g[c0 + 64 * i]; b1[i] = A.ln1_b[c0 + 64 * i]; }
    int t = (bx >> 3) * NWAVES + wave; if (t >= TOK) return;
    v4u ia = *(const v4u*)(IDT + (size_t)t * 256 + idoff), ib = *(const v4u*)(IDT + (size_t)t * 256 + idoff + 16);
    const int t1_ = (t + stride < TOK) ? t + stride : t;
    v4u ia1 = *(const v4u*)(IDT + (size_t)t1_ * 256 + idoff), ib1 = *(const v4u*)(IDT + (size_t)t1_ * 256 + idoff + 16);
    v4u a0 = *(const v4u*)(WQ8 + (size_t)t * 256 + aoff), a1 = *(const v4u*)(WQ8 + (size_t)t * 256 + aoff + 64);
    unsigned uh[4]; float gg[4];
#pragma unroll
    for (int i = 0; i < 4; ++i) { uh[i] = (unsigned)U1B[(size_t)t * DM + c0 + 64 * i]; gg[i] = mod[((size_t)(t >> 12) * 6 + 5) * DM + c0 + 64 * i]; }
    float mean1 = st1[(size_t)t * 2], rstd1 = st1[(size_t)t * 2 + 1], wsc = WSC[t];
    P12_DMA(ia, ib);
#pragma unroll 1
    for (;;) {
        const int tn = t + stride; const bool more = tn < TOK;
        asm volatile("s_waitcnt vmcnt(0)" ::: "memory"); __builtin_amdgcn_sched_barrier(0);
        v4u ia2 = ia1, ib2 = ib1, n0 = a0, n1 = a1; unsigned uhn[4]; float ggn[4], mean1n = mean1, rstd1n = rstd1, wscn = wsc;
        if (tn + stride < TOK) { ia2 = *(const v4u*)(IDT + (size_t)(tn + stride) * 256 + idoff); ib2 = *(const v4u*)(IDT + (size_t)(tn + stride) * 256 + idoff + 16); }
#pragma unroll
        for (int i = 0; i < 4; ++i) { uhn[i] = uh[i]; ggn[i] = gg[i]; }
        if (more) { n0 = *(const v4u*)(WQ8 + (size_t)tn * 256 + aoff); n1 = *(const v4u*)(WQ8 + (size_t)tn * 256 + aoff + 64);
#pragma unroll
                    for (int i = 0; i < 4; ++i) { uhn[i] = (unsigned)U1B[(size_t)tn * DM + c0 + 64 * i]; ggn[i] = mod[((size_t)(tn >> 12) * 6 + 5) * DM + c0 + 64 * i]; }
                    mean1n = st1[(size_t)tn * 2]; rstd1n = st1[(size_t)tn * 2 + 1]; wscn = WSC[tn]; }
        f32x4 acc[4];
#pragma unroll
        for (int i = 0; i < 4; ++i) acc[i] = (f32x4){0.f, 0.f, 0.f, 0.f};
        __builtin_amdgcn_sched_barrier(0);
        P12_MMA();
        __builtin_amdgcn_sched_barrier(0);
        if (more) P12_DMA(ia1, ib1);
        __builtin_amdgcn_sched_barrier(0);
        float s1 = 0.f, s2 = 0.f;
#pragma unroll
        for (int i = 0; i < 4; ++i) { const float p = (acc[i][0] + acc[i][1]) * wsc; const float u = __uint_as_float(uh[i] << 16);
            const float x1 = (u - mean1) * rstd1 * g1[i] + b1[i]; const float u2 = DN_ALPHA * x1 + gg[i] * p; s1 += u2; s2 += u2 * u2;
            U2[(size_t)t * DM + c0 + 64 * i] = (bf16)f2bf(u2); }
        s1 = wave_sum_dpp(s1); s2 = wave_sum_dpp(s2);
        if (lane == 0) ST2[t] = (f32x2g){s1, s2};
        if (!more) break;
        t = tn; ia1 = ia2; ib1 = ib2; a0 = n0; a1 = n1; mean1 = mean1n; rstd1 = rstd1n; wsc = wscn;
#pragma unroll
        for (int i = 0; i < 4; ++i) { uh[i] = uhn[i]; gg[i] = ggn[i]; }
    }
}
#undef P12_TRRD
#undef P12_DMA
#undef P12_MMA
#undef P12_RD
#undef P12_MF1
#undef P12_AJ

__device__ __forceinline__ void p13_ln2(const Args& A, int lane, int gw, int NGW) {
    unsigned char* ws = A.ws; const bf16* U2 = (const bf16*)(ws + WS_H); const f32x2g* ST2 = (const f32x2g*)(ws + WS_ST2);
    constexpr int R = 4;
    for (int t0 = gw * R; t0 < TOK; t0 += NGW * R) {
        v2u u[R][8]; float mean[R], rstd[R];
#pragma unroll
        for (int r = 0; r < R; ++r)
#pragma unroll
            for (int q = 0; q < 8; ++q) u[r][q] = *(const v2u*)(U2 + (size_t)(t0 + r) * DM + q * 256 + lane * 4);
#pragma unroll
        for (int r = 0; r < R; ++r) { float s1 = 0.f, s2 = 0.f;
#pragma unroll
            for (int x = 0; x < 8; ++x) { const f32x2g pp = ST2[(size_t)x * TOK + t0 + r]; s1 += pp.x; s2 += pp.y; }
            mean[r] = s1 * (1.0f / DM); const float var = fmaxf(s2 * (1.0f / DM) - mean[r] * mean[r], 0.f); rstd[r] = 1.0f / sqrtf(var + LN_EPS); }
#pragma unroll
        for (int q = 0; q < 8; ++q) { const int c = q * 256 + lane * 4; const f32x4 g = *(const f32x4*)(A.ln2_g + c), bb = *(const f32x4*)(A.ln2_b + c);
#pragma unroll
            for (int r = 0; r < R; ++r) { const f32x4 v = (f32x4){bflo(u[r][q].x), bfhi(u[r][q].x), bflo(u[r][q].y), bfhi(u[r][q].y)};
                __builtin_nontemporal_store((v - mean[r]) * rstd[r] * g + bb, (f32x4*)(A.out + (size_t)(t0 + r) * DM + c)); } }
    }
}


struct ArgsG {
    const GAS float *x, *c; const GAS int* positions;
    const GAS float *w_ada, *b_ada, *w_in, *b_in, *rel_bias, *q_norm_g, *kv_norm_g, *w_uq, *w_ukv, *w_pa, *w_pb, *w_o, *ln1_g, *ln1_b, *peer_wq, *peer_keys, *peer_u, *peer_v, *ln2_g, *ln2_b;
    GAS float* out; GAS unsigned char* ws; int ph_lo, ph_hi;
};
static_assert(sizeof(ArgsG) == sizeof(Args), "ArgsG mirrors Args");
#define CAS __attribute__((address_space(4)))
__device__ __forceinline__ Args load_args(const CAS ArgsG* p) {
    Args a;
    a.x = (const float*)p->x; a.c = (const float*)p->c; a.positions = (const int*)p->positions; a.w_ada = (const float*)p->w_ada; a.b_ada = (const float*)p->b_ada; a.w_in = (const float*)p->w_in; a.b_in = (const float*)p->b_in;
    a.rel_bias = (const float*)p->rel_bias; a.q_norm_g = (const float*)p->q_norm_g; a.kv_norm_g = (const float*)p->kv_norm_g; a.w_uq = (const float*)p->w_uq; a.w_ukv = (const float*)p->w_ukv; a.w_pa = (const float*)p->w_pa;
    a.w_pb = (const float*)p->w_pb; a.w_o = (const float*)p->w_o; a.ln1_g = (const float*)p->ln1_g; a.ln1_b = (const float*)p->ln1_b; a.peer_wq = (const float*)p->peer_wq; a.peer_keys = (const float*)p->peer_keys;
    a.peer_u = (const float*)p->peer_u; a.peer_v = (const float*)p->peer_v; a.ln2_g = (const float*)p->ln2_g; a.ln2_b = (const float*)p->ln2_b; a.out = (float*)p->out; a.ws = (unsigned char*)p->ws;
    a.ph_lo = p->ph_lo; a.ph_hi = p->ph_hi; return a;
}
__global__ void __launch_bounds__(NWAVES * 64, 2) fwd(Args A_) {
    extern __shared__ __attribute__((aligned(16))) unsigned char lds_raw[];
    LAS unsigned char* lds = (LAS unsigned char*)lds_raw;
    const CAS Args* Ap0 = (const CAS Args*)__builtin_amdgcn_kernarg_segment_ptr();
#define PHASE_ENV() const CAS Args* Ap = Ap0; asm volatile("" : "+s"(Ap)); const Args A = load_args((const CAS ArgsG*)Ap); \
    int wave = wave_s; asm volatile("" : "+s"(wave)); int lane; asm volatile("v_mbcnt_lo_u32_b32 %0, -1, 0\n\tv_mbcnt_hi_u32_b32 %0, -1, %0" : "=v"(lane)); const int tid = wave * 64 + lane; \
    const int G = gridDim.x, bx = blockIdx.x, vcu = (G % 8 == 0) ? (bx % 8) * (G / 8) + bx / 8 : bx, gw = vcu * NWAVES + wave, NGW = G * NWAVES; \
    unsigned char* const ws = A.ws; bf16* const H = (bf16*)(ws + WS_H); (void)lane; (void)gw; (void)NGW; (void)H; (void)vcu
    const int wave_s = __builtin_amdgcn_readfirstlane(threadIdx.x >> 6);
    for (int u = threadIdx.x; u < (LDS_BYTES - RING_BYTES) / 4; u += NWAVES * 64) ((LAS unsigned*)(lds + RING_BYTES))[u] = 0u;
    __syncthreads();
    const int lo = A_.ph_lo, hi = A_.ph_hi; const bool multi = (hi - lo) > 1;
    volatile LAS unsigned* MISC = (volatile LAS unsigned*)(lds + MISC_OFF);
    XcdBarrier bar; bar.bar = (unsigned*)(A_.ws + WS_CTL) + CW_BAR; bar.x = 0; bar.st = MISC + 8; bar.w0 = (wave_s == 0);
    if (multi) bar = xcd_barrier_post((unsigned*)(A_.ws + WS_CTL) + CW_BAR, MISC + 8, wave_s == 0);
#ifdef DBG_PHASE
#define IN(k) ((k) == DBG_PHASE)
#else
#define IN(k) (lo <= (k) && (k) < hi)
#endif
#define GRID_BAR(k) do { if (IN(k) && IN((k) + 1)) xcd_barrier(bar); } while (0)
    if (IN(0)) { { PHASE_ENV(); p0_prologue(A, lds, tid, lane, wave, vcu, G); } GRID_BAR(0); }
    if (IN(1)) { { PHASE_ENV(); p1_modulate(A, lane, gw, NGW); } GRID_BAR(1); }
    if (IN(2)) {
        { PHASE_ENV();
        pg8::Gemm g{(const bf16*)(ws + WS_H8), (const bf16*)(ws + WS_W8), TOK, 8192, 1024}; pg8::StaticOrder S; S.init(TOK, 8192, G, bx);
        pg8::EpiInProj E{(bf16*)(ws + WS_QKVA), (bf16*)(ws + WS_CQ), (bf16*)(ws + WS_CKV), (bf16*)A.out, (float*)(ws + WS_SSQ), (const float*)(ws + WS_BIAS), QSCALE_A, (const float*)(ws + WS_HSC), (const unsigned*)(ws + WS_CTL) + CW_WMAX};
        pg8::gemm_phase<pg8::EpiInProj, pg8::StaticOrder, true, true, true>(lds, g, S, E, tid); }
        GRID_BAR(2);
    }
    if (IN(3)) {
        {
        { PHASE_ENV(); pg8::Gemm g{(const bf16*)(ws + WS_CQ), (const bf16*)(ws + WS_WUQ8), TOK, 1536, 256}; pg8::StaticOrder S; S.init(TOK, 1536, G, bx);
          pg8::EpiQUp E{(bf16*)(ws + WS_QN), (bf16*)(ws + WS_QR), (const float*)(ws + WS_SSQ), (const float*)(ws + WS_CS), QSCALE_B, (const unsigned*)(ws + WS_CTL) + CW_WMAX + 4};
          pg8::gemm_phase<pg8::EpiQUp, pg8::StaticOrder, true, true, true>(lds, g, S, E, tid); }
        { PHASE_ENV(); pg8::Gemm g{(const bf16*)(ws + WS_CKV), (const bf16*)(ws + WS_WUKV8), TOK, 2048, 256}; pg8::StaticOrder S; S.init(TOK, 2048, G, bx);
          pg8::EpiKvUp E{(bf16*)(ws + WS_KN), (bf16*)(ws + WS_VB), (const float*)(ws + WS_SSQ) + (size_t)TOK * 8, (const unsigned*)(ws + WS_CTL) + CW_WMAX + 5};
          pg8::gemm_phase<pg8::EpiKvUp, pg8::StaticOrder, true, true, true>(lds, g, S, E, tid); }
        { PHASE_ENV(); pg8::Gemm g{(const bf16*)(ws + WS_H8), (const bf16*)(ws + WS_WKR8), TOK, 256, 1024}; pg8::StaticOrder S; S.init(TOK, 256, G, bx);
          pg8::EpiKr E{(bf16*)(ws + WS_KR), (const float*)(ws + WS_BIAS) + 8192, (const float*)(ws + WS_CS), (const float*)(ws + WS_HSC), (const unsigned*)(ws + WS_CTL) + CW_WMAX};
          pg8::gemm_phase<pg8::EpiKr, pg8::StaticOrder, true, true, true>(lds, g, S, E, tid); }
        { PHASE_ENV(); const bf16* Q = (const bf16*)(ws + WS_QKVA); const bf16* K = Q + (size_t)TOK * 1024; const bf16* V = K + (size_t)TOK * 1024;
          for (int u = vcu; u < 1024; u += G) { const int bh = u >> 4, qb = u & 15;
              att::attn_unit<0>(lds, bh >> 3, bh & 7, qb, Q, nullptr, K, nullptr, V, (bf16*)(ws + WS_YA), A.rel_bias + (bh & 7) * 320, tid); } }
        }
        GRID_BAR(3);
    }
    if (IN(4)) {
        {
        { PHASE_ENV();
        for (int s2 = 0; vcu + G * (s2 >> 1) < 512; ++s2) { const int it = vcu + G * (s2 >> 1), bh = it >> 3, x = it & 7, qb = (s2 & 1) ? 15 - x : x;
            att::attn_unit<1>(lds, bh >> 3, bh & 7, qb, (const bf16*)(ws + WS_QN), (const bf16*)(ws + WS_QR), (const bf16*)(ws + WS_KN), (const bf16*)(ws + WS_KR), (const bf16*)(ws + WS_VB), (bf16*)(ws + WS_YB), nullptr, tid); } }
        { PHASE_ENV(); pg8::Gemm g{(const bf16*)(ws + WS_YA), (const bf16*)(ws + WS_WPA8), TOK, 2048, 512}; pg8::StaticOrder S; S.init(TOK, 2048, G, bx);
          pg8::EpiGate<0> E{(unsigned char*)H, (const unsigned char*)A.out, nullptr, (const unsigned*)(ws + WS_CTL) + CW_WMAX + 1, ACT_MIX / ACT_Y};
          pg8::gemm_phase<pg8::EpiGate<0>, pg8::StaticOrder, true, true, true>(lds, g, S, E, tid); }
        }
        GRID_BAR(4);
    }
    if (IN(5)) {
        { PHASE_ENV(); pg8::Gemm g{(const bf16*)(ws + WS_YB), (const bf16*)(ws + WS_WPB8), TOK, 2048, 512}; pg8::StaticOrder S; S.init(TOK, 2048, G, bx);
        pg8::EpiGate<1> E{(unsigned char*)H, (const unsigned char*)A.out, ws + WS_H8, (const unsigned*)(ws + WS_CTL) + CW_WMAX + 2, ACT_MIX / ACT_Y};
        pg8::gemm_phase<pg8::EpiGate<1>, pg8::StaticOrder, true, true, true>(lds, g, S, E, tid); }
        GRID_BAR(5);
    }
    if (IN(6)) {
        { PHASE_ENV(); pg8::Gemm g{(const bf16*)(ws + WS_H8), (const bf16*)(ws + WS_WO8), TOK, 2048, 1024}; pg8::StaticOrder S; S.init(TOK, 2048, G, bx);
        pg8::EpiWo E{A.x, (bf16*)(ws + WS_U1B), (const float*)(ws + WS_MOD), DN_ALPHA, (const unsigned*)(ws + WS_CTL) + CW_WMAX + 3, 1.0f / ACT_MIX};
        pg8::gemm_phase<pg8::EpiWo, pg8::StaticOrder, true, true, true>(lds, g, S, E, tid); }
        GRID_BAR(6);
    }
    if (IN(7)) { { PHASE_ENV(); p7_ln1(A, lane, gw, NGW); } GRID_BAR(7); }
    if (IN(8)) {
        { PHASE_ENV(); pg8::Gemm g{H, (const bf16*)(ws + WS_WSK), TOK, 2048, 2048}; pg8::StaticOrder S; S.init(TOK, 2048, G, bx);
        pg8::EpiF32 E{(float*)(ws + WS_SCORE), 2048};
        pg8::gemm_phase<pg8::EpiF32, pg8::StaticOrder, true, true>(lds, g, S, E, tid); }
        GRID_BAR(8);
    }
    if (IN(9)) { { PHASE_ENV(); p9a_topk(A, lane, gw, NGW); } GRID_BAR(9); }
    if (IN(10)) { { PHASE_ENV(); p10_udot(A, lane, wave, bx, G); } GRID_BAR(10); }
    if (IN(11)) { { PHASE_ENV(); p11_w(A, lane, gw, NGW); } GRID_BAR(11); }
    if (IN(12)) { { PHASE_ENV(); p12_vslice(A, lds, lane, wave, bx, G); } GRID_BAR(12); }
    if (IN(13)) { PHASE_ENV(); p13_ln2(A, lane, gw, NGW); }
#undef IN
#undef GRID_BAR
#undef PHASE_ENV
}

#ifndef MK_ONE_LAUNCH
#define MK_ONE_LAUNCH 1
#endif
constexpr int N_PHASES = 14;
extern "C" void kernel_launch(void* const* d_in, const int* in_sizes, int n_in, void* d_out, int out_size, void* d_ws, size_t ws_size, hipStream_t stream) {
    static int grid = 0;
    if (grid == 0) {
        if (n_in != 23 || out_size != TOK * DM || ws_size < WS_END) { fprintf(stderr, "kernel_launch: unexpected shapes (n_in %d, out %d, ws %zu); nothing launched\n", n_in, out_size, ws_size); grid = -1; return; }
        int dev = 0, cus = 0, per_cu = 0;
        if (hipGetDevice(&dev) != hipSuccess || hipDeviceGetAttribute(&cus, hipDeviceAttributeMultiprocessorCount, dev) != hipSuccess) { grid = -1; return; }
        if (hipFuncSetAttribute((const void*)fwd, hipFuncAttributeMaxDynamicSharedMemorySize, LDS_BYTES) != hipSuccess) { fprintf(stderr, "kernel_launch: hipFuncSetAttribute failed\n"); grid = -1; return; }
        if (hipOccupancyMaxActiveBlocksPerMultiprocessor(&per_cu, (const void*)fwd, NWAVES * 64, LDS_BYTES) != hipSuccess || per_cu < 1) fprintf(stderr, "kernel_launch: occupancy query reports %d\n", per_cu);
        (void)hipGetLastError();
        grid = cus;
    }
    if (grid < 0) return;
    (void)hipMemsetAsync((char*)d_ws + WS_CTL, 0, CTL_ZERO_BYTES, stream);
    Args a{};
    a.x = (const float*)d_in[0]; a.c = (const float*)d_in[1]; a.positions = (const int*)d_in[2];
    a.w_ada = (const float*)d_in[3]; a.b_ada = (const float*)d_in[4]; a.w_in = (const float*)d_in[5]; a.b_in = (const float*)d_in[6]; a.rel_bias = (const float*)d_in[7];
    a.q_norm_g = (const float*)d_in[8]; a.kv_norm_g = (const float*)d_in[9]; a.w_uq = (const float*)d_in[10]; a.w_ukv = (const float*)d_in[11]; a.w_pa = (const float*)d_in[12];
    a.w_pb = (const float*)d_in[13]; a.w_o = (const float*)d_in[14]; a.ln1_g = (const float*)d_in[15]; a.ln1_b = (const float*)d_in[16]; a.peer_wq = (const float*)d_in[17];
    a.peer_keys = (const float*)d_in[18]; a.peer_u = (const float*)d_in[19]; a.peer_v = (const float*)d_in[20]; a.ln2_g = (const float*)d_in[21]; a.ln2_b = (const float*)d_in[22];
    a.out = (float*)d_out; a.ws = (unsigned char*)d_ws;
#if MK_ONE_LAUNCH
    a.ph_lo = 0; a.ph_hi = N_PHASES;
    hipLaunchKernelGGL(fwd, dim3(grid), dim3(NWAVES * 64), LDS_BYTES, stream, a);
#else
    for (int p = 0; p < N_PHASES; ++p) { a.ph_lo = p; a.ph_hi = p + 1; hipLaunchKernelGGL(fwd, dim3(grid), dim3(NWAVES * 64), LDS_BYTES, stream, a); }
#endif
}
```

```cpp
#include <hip/hip_runtime.h>
#include <cstdio>
#include <cstdint>
#include <cmath>
namespace pg8 {
#define PG8_LAS __attribute__((address_space(3)))
typedef unsigned short bf16_t;
typedef short bf16x8 __attribute__((ext_vector_type(8)));
typedef float f32x4 __attribute__((ext_vector_type(4)));
typedef unsigned u32x4 __attribute__((ext_vector_type(4)));
constexpr int BM = 256, BK = 64, HALF = 128, HTB = HALF * BK * 2  , STAGE_BYTES = 8 * HTB, NXCD = 8, WGM = 8;

__host__ __device__ __forceinline__ int lds_byte(int r, int c) { const int st = (r >> 4) * 2 + (c >> 5), rr = r & 15, cc = c & 31, ob = rr * 64 + cc * 2; return st * 1024 + (ob ^ (((ob >> 9) & 1) << 5)); }
__host__ __device__ __forceinline__ void stage_rc(int b, int& R, int& C) { const int st = b / 1024, sb = b % 1024, swz = sb ^ (((sb >> 9) & 1) << 5); R = (st >> 1) * 16 + swz / 64; C = (st & 1) * 32 + (swz % 64) / 2; }
__host__ __device__ __forceinline__ int perm32(int rho) { const int n = rho >> 4, i = rho & 15; return 8 * (i >> 2) + 4 * n + (i & 3); }

struct Unit { int pm, pn; };
struct Gemm { const bf16_t* A; const bf16_t* Bt; int M, N, K; };

struct StaticOrder {
    int nM, nN, nwg, G, c;
    __host__ __device__ void init(int M, int N, int G_, int c_) { nM = M / BM; nN = N / BM; nwg = nM * nN; G = G_; c = c_; }
    __host__ __device__ bool next(int i, Unit& u) const {
        const long L = (long)i * G + c; if (L >= nwg) return false;
        int wgid = (int)L; { const int q = nwg / NXCD, r = nwg % NXCD, xcd = wgid % NXCD, off = wgid / NXCD; wgid = (xcd < r ? xcd * (q + 1) : r * (q + 1) + (xcd - r) * q) + off; }
        const int nig = WGM * nN, gid = wgid / nig, fm = gid * WGM, gsz = (nM - fm) < WGM ? (nM - fm) : WGM;
        u.pm = fm + ((wgid % nig) % gsz); u.pn = (wgid % nig) / gsz; return true;
    }
    __device__ __forceinline__ void a_ready(const Unit&) const {}
    __device__ __forceinline__ void done(const Unit&) const {}
};

typedef float f32x2c_t __attribute__((ext_vector_type(2))); typedef __bf16 bf16x2c_t __attribute__((ext_vector_type(2)));
__device__ __forceinline__ unsigned cvt_pk_bf16(float lo, float hi) { const f32x2c_t v = {lo, hi}; const bf16x2c_t b = __builtin_convertvector(v, bf16x2c_t); return __builtin_bit_cast(unsigned, b); }
typedef float f32x2 __attribute__((ext_vector_type(2)));

constexpr int TOK = 32768;
__device__ __forceinline__ u32x4 pack8(const f32x4& v0, const f32x4& v1) { u32x4 w; w.x = cvt_pk_bf16(v0[0], v0[1]); w.y = cvt_pk_bf16(v0[2], v0[3]); w.z = cvt_pk_bf16(v1[0], v1[1]); w.w = cvt_pk_bf16(v1[2], v1[3]); return w; }
__device__ __forceinline__ float bf_lo(unsigned w) { return __uint_as_float(w << 16); }
__device__ __forceinline__ float bf_hi(unsigned w) { return __uint_as_float(w & 0xffff0000u); }
__device__ __forceinline__ float sigmoidf_fast(float v) { return __builtin_amdgcn_rcpf(1.0f + __builtin_amdgcn_exp2f(-1.4426950408889634f * v)); }

__device__ __forceinline__ unsigned pk4f8(float a, float b, float c, float d) { int w = __builtin_amdgcn_cvt_pk_fp8_f32(a, b, 0, false); w = __builtin_amdgcn_cvt_pk_fp8_f32(c, d, w, true); return (unsigned)w; }
struct EpiF32 {
    static constexpr bool PERM = false, AFTER_DRAIN = false;
    float* C; int ldc;
    __device__ __forceinline__ void operator()(const f32x4 (&acc)[2][2][4][2], const Unit& u, int wr, int wc, int fr, int fq) const {
        const int row0 = u.pm * BM + wr * 64 + fr, col0 = u.pn * BM + wc * 32 + 4 * fq;
#pragma unroll
        for (int ai = 0; ai < 2; ++ai)
#pragma unroll
            for (int m = 0; m < 4; ++m) { float* rowp = C + (size_t)(row0 + ai * HALF + m * 16) * ldc + col0;
#pragma unroll
                for (int bj = 0; bj < 2; ++bj)
#pragma unroll
                    for (int n = 0; n < 2; ++n) *(f32x4*)(rowp + bj * HALF + n * 16) = acc[ai][bj][m][n]; }
    }
};
struct EpiInProj {
    static constexpr bool PERM = true, AFTER_DRAIN = false;
    bf16_t* QKV;
    bf16_t* CQ; bf16_t* CKV;
    bf16_t* SG;
    float* SSQ;
    const float* bias;
    float qscale;
    const float* rowscale;
    const unsigned* wmaxbits;
    __device__ __forceinline__ void operator()(const f32x4 (&acc)[2][2][4][2], const Unit& u, int wr, int wc, int fr, int fq) const {
        const int row0 = u.pm * BM + wr * 64 + fr, cl = wc * 32 + 8 * fq, bcol0 = u.pn * BM + cl;
        f32x4 bv[2][2];
#pragma unroll
        for (int bj = 0; bj < 2; ++bj)
#pragma unroll
            for (int n = 0; n < 2; ++n) bv[bj][n] = *(const f32x4*)(bias + bcol0 + bj * HALF + 4 * n);
        const float wsc = __uint_as_float(*wmaxbits) * (1.0f / 440.0f); float rsc[2][4];
#pragma unroll
        for (int ai = 0; ai < 2; ++ai)
#pragma unroll
            for (int m = 0; m < 4; ++m) rsc[ai][m] = rowscale[row0 + ai * HALF + m * 16] * wsc;
        asm volatile("" :: "v"(bv[0][0]), "v"(bv[0][1]), "v"(bv[1][0]), "v"(bv[1][1]), "v"(rsc[0][0]), "v"(rsc[0][1]), "v"(rsc[0][2]), "v"(rsc[0][3]), "v"(rsc[1][0]), "v"(rsc[1][1]), "v"(rsc[1][2]), "v"(rsc[1][3]));
        if (u.pn < 12) {
            const int t = u.pn >> 2; bf16_t* base = QKV + (size_t)t * TOK * 1024 + (u.pn & 3) * 256 + cl; const float sc = (t == 0) ? qscale : 1.0f;
#pragma unroll
            for (int ai = 0; ai < 2; ++ai)
#pragma unroll
                for (int m = 0; m < 4; ++m) { bf16_t* rowp = base + (size_t)(row0 + ai * HALF + m * 16) * 1024;
#pragma unroll
                    for (int bj = 0; bj < 2; ++bj) { const f32x4 v0 = (acc[ai][bj][m][0] * rsc[ai][m] + bv[bj][0]) * sc, v1 = (acc[ai][bj][m][1] * rsc[ai][m] + bv[bj][1]) * sc; *(u32x4*)(rowp + bj * HALF) = pack8(v0, v1); } }
        } else if (u.pn < 16) {
            const int which = (u.pn - 12) >> 1, tl = (u.pn - 12) & 1; unsigned char* base = (unsigned char*)(which ? CKV : CQ) + tl * 256 + cl; float* sq = SSQ + (size_t)which * TOK * 8 + tl * 4 + wc;
#pragma unroll
            for (int ai = 0; ai < 2; ++ai)
#pragma unroll
                for (int m = 0; m < 4; ++m) { const int row = row0 + ai * HALF + m * 16; unsigned char* rowp = base + (size_t)row * 512; float ss = 0.f;
#pragma unroll
                    for (int bj = 0; bj < 2; ++bj) { const f32x4 v0 = acc[ai][bj][m][0] * rsc[ai][m] + bv[bj][0], v1 = acc[ai][bj][m][1] * rsc[ai][m] + bv[bj][1];
                        typedef unsigned u32x2c __attribute__((ext_vector_type(2))); u32x2c o; o.x = pk4f8(v0[0] * 16.0f, v0[1] * 16.0f, v0[2] * 16.0f, v0[3] * 16.0f); o.y = pk4f8(v1[0] * 16.0f, v1[1] * 16.0f, v1[2] * 16.0f, v1[3] * 16.0f);
                        *(u32x2c*)(rowp + bj * HALF) = o;
                        ss += (v0[0] * v0[0] + v0[1] * v0[1]) + (v0[2] * v0[2] + v0[3] * v0[3]) + (v1[0] * v1[0] + v1[1] * v1[1]) + (v1[2] * v1[2] + v1[3] * v1[3]); }
                    ss += __int_as_float(__builtin_amdgcn_ds_swizzle(__float_as_int(ss), 0x401F));
                    { auto rr_ = __builtin_amdgcn_permlane32_swap(__float_as_uint(ss), __float_as_uint(ss), false, false); ss = __uint_as_float(rr_[0]) + __uint_as_float(rr_[1]); }
                    if (fq == 0) sq[(size_t)row * 8] = ss; }
        } else {
            unsigned char* base = (unsigned char*)SG + (u.pn - 16) * 256 + cl;
#pragma unroll
            for (int ai = 0; ai < 2; ++ai)
#pragma unroll
                for (int m = 0; m < 4; ++m) { unsigned char* rowp = base + (size_t)(row0 + ai * HALF + m * 16) * 4096;
#pragma unroll
                    for (int bj = 0; bj < 2; ++bj) { f32x4 v0 = acc[ai][bj][m][0] * rsc[ai][m] + bv[bj][0], v1 = acc[ai][bj][m][1] * rsc[ai][m] + bv[bj][1];
#pragma unroll
                        for (int j = 0; j < 4; ++j) { v0[j] = sigmoidf_fast(v0[j]); v1[j] = sigmoidf_fast(v1[j]); }
                        typedef unsigned u32x2c __attribute__((ext_vector_type(2))); u32x2c o; o.x = pk4f8(v0[0], v0[1], v0[2], v0[3]); o.y = pk4f8(v1[0], v1[1], v1[2], v1[3]);
                        *(u32x2c*)(rowp + bj * HALF) = o; } }
        }
    }
};
__device__ __forceinline__ float row_rs(const float* ssq_row, float inv_n, float eps) {
    const f32x4 a = *(const f32x4*)ssq_row, b = *(const f32x4*)(ssq_row + 4);
    const float s = ((a[0] + a[1]) + (a[2] + a[3])) + ((b[0] + b[1]) + (b[2] + b[3]));
    return 1.0f / sqrtf(s * inv_n + eps);
}
__device__ __forceinline__ void rope8(f32x4& v0, f32x4& v1, const float* cs) {
    const f32x4 c0 = *(const f32x4*)cs, c1 = *(const f32x4*)(cs + 4);
    f32x4 o0, o1;
    o0[0] = v0[0] * c0[0] - v0[1] * c0[1]; o0[1] = v0[0] * c0[1] + v0[1] * c0[0]; o0[2] = v0[2] * c0[2] - v0[3] * c0[3]; o0[3] = v0[2] * c0[3] + v0[3] * c0[2];
    o1[0] = v1[0] * c1[0] - v1[1] * c1[1]; o1[1] = v1[0] * c1[1] + v1[1] * c1[0]; o1[2] = v1[2] * c1[2] - v1[3] * c1[3]; o1[3] = v1[2] * c1[3] + v1[3] * c1[2];
    v0 = o0; v1 = o1;
}
struct EpiQUp {
    static constexpr bool PERM = true, AFTER_DRAIN = false;
    bf16_t* Qn; bf16_t* Qr; const float* SSQ; const float* CS; float qscale; const unsigned* wmaxbits;
    __device__ __forceinline__ void operator()(const f32x4 (&acc)[2][2][4][2], const Unit& u, int wr, int wc, int fr, int fq) const {
        const int row0 = u.pm * BM + wr * 64 + fr, cl = wc * 32 + 8 * fq;
        float rs[2][4];
#pragma unroll
        for (int ai = 0; ai < 2; ++ai)
#pragma unroll
            for (int m = 0; m < 4; ++m) rs[ai][m] = row_rs(SSQ + (size_t)(row0 + ai * HALF + m * 16) * 8, 1.0f / 512.0f, 1e-6f) * (qscale * (1.0f / (440.0f * 16.0f)) * __uint_as_float(wmaxbits[fq >> 2]));
        asm volatile("" ::: "memory");
        if (u.pn < 4) {
#pragma unroll
            for (int ai = 0; ai < 2; ++ai)
#pragma unroll
                for (int m = 0; m < 4; ++m) { const int row = row0 + ai * HALF + m * 16; bf16_t* rowp = Qn + (size_t)row * 1024 + u.pn * 256 + cl;
#pragma unroll
                    for (int bj = 0; bj < 2; ++bj) *(u32x4*)(rowp + bj * HALF) = pack8(acc[ai][bj][m][0] * rs[ai][m], acc[ai][bj][m][1] * rs[ai][m]); }
        } else { const int rc = (u.pn - 4) * 256 + cl;
#pragma unroll
            for (int ai = 0; ai < 2; ++ai)
#pragma unroll
                for (int m = 0; m < 4; ++m) { const int row = row0 + ai * HALF + m * 16;
#pragma unroll
                    for (int bj = 0; bj < 2; ++bj) { const int c = rc + bj * HALF; f32x4 v0 = acc[ai][bj][m][0] * rs[ai][m], v1 = acc[ai][bj][m][1] * rs[ai][m];
                        rope8(v0, v1, (const float*)((const char*)CS + (unsigned)((row * 32 + ((c & 63) >> 1)) * 8))); *(u32x4*)((char*)Qr + (unsigned)((row * 512 + c) * 2)) = pack8(v0, v1); }
                    if (m & 1) asm volatile("" ::: "memory"); }
        }
    }
};
struct EpiKvUp {
    static constexpr bool PERM = true, AFTER_DRAIN = false;
    bf16_t* Kn; bf16_t* Vb; const float* SSQ; const unsigned* wmaxbits;
    __device__ __forceinline__ void operator()(const f32x4 (&acc)[2][2][4][2], const Unit& u, int wr, int wc, int fr, int fq) const {
        const int row0 = u.pm * BM + wr * 64 + fr, cl = wc * 32 + 8 * fq; bf16_t* base = (u.pn < 4 ? Kn : Vb) + (u.pn & 3) * 256 + cl;
        float rs[2][4];
#pragma unroll
        for (int ai = 0; ai < 2; ++ai)
#pragma unroll
            for (int m = 0; m < 4; ++m) rs[ai][m] = row_rs(SSQ + (size_t)(row0 + ai * HALF + m * 16) * 8, 1.0f / 512.0f, 1e-6f) * ((1.0f / (440.0f * 16.0f)) * __uint_as_float(*wmaxbits));
        asm volatile("" ::: "memory");
#pragma unroll
        for (int ai = 0; ai < 2; ++ai)
#pragma unroll
            for (int m = 0; m < 4; ++m) { const int row = row0 + ai * HALF + m * 16; bf16_t* rowp = base + (size_t)row * 1024;
#pragma unroll
                for (int bj = 0; bj < 2; ++bj) *(u32x4*)(rowp + bj * HALF) = pack8(acc[ai][bj][m][0] * rs[ai][m], acc[ai][bj][m][1] * rs[ai][m]); }
    }
};
struct EpiKr {
    static constexpr bool PERM = true, AFTER_DRAIN = false;
    bf16_t* KR; const float* bias; const float* CS; const float* rowscale; const unsigned* wmaxbits;
    __device__ __forceinline__ void operator()(const f32x4 (&acc)[2][2][4][2], const Unit& u, int wr, int wc, int fr, int fq) const {
        if (wc >= 2) return;
        const int row0 = u.pm * BM + wr * 64 + fr, cl = wc * 32 + 8 * fq; const float wsc = __uint_as_float(*wmaxbits) * (1.0f / 440.0f);
        const f32x4 b0 = *(const f32x4*)(bias + cl), b1 = *(const f32x4*)(bias + cl + 4);
#pragma unroll
        for (int ai = 0; ai < 2; ++ai)
#pragma unroll
            for (int m = 0; m < 4; ++m) { const int row = row0 + ai * HALF + m * 16; const float rs = rowscale[row] * wsc; f32x4 v0 = acc[ai][0][m][0] * rs + b0, v1 = acc[ai][0][m][1] * rs + b1;
                rope8(v0, v1, CS + ((size_t)row * 32 + (cl >> 1)) * 2); *(u32x4*)(KR + (size_t)row * 64 + cl) = pack8(v0, v1);
                if (m & 1) asm volatile("" ::: "memory"); }
    }
};
__device__ __forceinline__ void unpk8f8(unsigned lo, unsigned hi, f32x4& a, f32x4& b) { typedef float f32x2u __attribute__((ext_vector_type(2)));
    const f32x2u p0 = __builtin_amdgcn_cvt_pk_f32_fp8((int)lo, false), p1 = __builtin_amdgcn_cvt_pk_f32_fp8((int)lo, true), p2 = __builtin_amdgcn_cvt_pk_f32_fp8((int)hi, false), p3 = __builtin_amdgcn_cvt_pk_f32_fp8((int)hi, true);
    a = (f32x4){p0[0], p0[1], p1[0], p1[1]}; b = (f32x4){p2[0], p2[1], p3[0], p3[1]}; }
template <int MODE> struct EpiGate {
    static constexpr bool PERM = true, AFTER_DRAIN = false;
    unsigned char* T8; const unsigned char* SG8; unsigned char* MIX8; const unsigned* wmaxbits; float actmul;
    __device__ __forceinline__ void operator()(const f32x4 (&acc)[2][2][4][2], const Unit& u, int wr, int wc, int fr, int fq) const {
        typedef unsigned u32x2e __attribute__((ext_vector_type(2)));
        const int row0 = u.pm * BM + wr * 64 + fr, col0 = u.pn * BM + wc * 32 + 8 * fq; const float sc = __uint_as_float(*wmaxbits) * (1.0f / 440.0f) * actmul;
#pragma unroll
        for (int ai = 0; ai < 2; ++ai)
#pragma unroll
            for (int m = 0; m < 4; ++m) { const int row = row0 + ai * HALF + m * 16;
#pragma unroll
                for (int bj = 0; bj < 2; ++bj) { const int c = col0 + bj * HALF; const u32x2e g = *(const u32x2e*)(SG8 + (size_t)row * 4096 + MODE * 2048 + c);
                    f32x4 g0, g1; unpk8f8(g.x, g.y, g0, g1);
                    f32x4 v0 = acc[ai][bj][m][0] * sc * g0, v1 = acc[ai][bj][m][1] * sc * g1;
                    if (MODE == 1) { const u32x2e t = *(const u32x2e*)(T8 + (size_t)row * 2048 + c); f32x4 t0, t1; unpk8f8(t.x, t.y, t0, t1); v0 = v0 + t0; v1 = v1 + t1; }
                    u32x2e o; o.x = pk4f8(v0[0], v0[1], v0[2], v0[3]); o.y = pk4f8(v1[0], v1[1], v1[2], v1[3]);
                    *(u32x2e*)((MODE == 0 ? T8 : MIX8) + (size_t)row * 2048 + c) = o; } }
    }
};
struct EpiWo {
    static constexpr bool PERM = true, AFTER_DRAIN = false;
    const float* X; bf16_t* U1; const float* MOD; float alpha; const unsigned* wmaxbits; float actinv;
    __device__ __forceinline__ void operator()(const f32x4 (&acc)[2][2][4][2], const Unit& u, int wr, int wc, int fr, int fq) const {
        const int row0 = u.pm * BM + wr * 64 + fr, col0 = u.pn * BM + wc * 32 + 8 * fq; const int b = (u.pm * BM) >> 12;
        f32x4 gv[2][2];
#pragma unroll
        for (int bj = 0; bj < 2; ++bj)
#pragma unroll
            for (int n = 0; n < 2; ++n) gv[bj][n] = *(const f32x4*)(MOD + ((size_t)b * 6 + 2) * 2048 + col0 + bj * HALF + n * 4) * (__uint_as_float(*wmaxbits) * (1.0f / 440.0f) * actinv);
#pragma unroll
        for (int ai = 0; ai < 2; ++ai)
#pragma unroll
            for (int m = 0; m < 4; ++m) { const size_t off = (size_t)(row0 + ai * HALF + m * 16) * 2048 + col0;
#pragma unroll
                for (int bj = 0; bj < 2; ++bj) { const f32x4 x0 = *(const f32x4*)(X + off + bj * HALF), x1 = *(const f32x4*)(X + off + bj * HALF + 4);
                    const f32x4 v0 = x0 * alpha + gv[bj][0] * acc[ai][bj][m][0], v1 = x1 * alpha + gv[bj][1] * acc[ai][bj][m][1];
                    *(u32x4*)(U1 + off + bj * HALF) = pack8(v0, v1); }
                asm volatile("" ::: "memory"); }
    }
};

__device__ __forceinline__ bf16x8 lds_rd16(const PG8_LAS bf16x8* __restrict__ p) { return *p; }
typedef int i32x4g __attribute__((ext_vector_type(4))); typedef int i32x8g __attribute__((ext_vector_type(8)));
template <class Epi, class Sched, bool ALIGN_EPI = false, bool SP2 = false, bool F8 = false>
__device__ __forceinline__ void gemm_phase(PG8_LAS unsigned char* lds, const Gemm g, const Sched& S, const Epi& E, const int tid) {
    const int wid = __builtin_amdgcn_readfirstlane(tid >> 6), lane = tid & 63, wr = wid >> 2, wc = wid & 3, fr = lane & 15, fq = lane >> 4;
    const int K = g.K, nt = K / BK;
    unsigned voffA[2], voffB[2];
#pragma unroll
    for (int i = 0; i < 2; ++i) { int R, C; stage_rc(tid * 16 + i * 8192, R, C); const int Rb = Epi::PERM ? ((R & ~31) + perm32(R & 31)) : R;
        voffA[i] = (unsigned)(R * K + C) * 2u; voffB[i] = (unsigned)(Rb * K + C) * 2u; }
    const size_t kstep = (size_t)(BK * 2);
    const size_t hstep = (size_t)HALF * K * 2;
    const size_t tstep = 2 * hstep;
    const unsigned ldsbase_u = (unsigned)(size_t)lds;
    const unsigned ldsw = (unsigned)wid * 1024u;
    const int aoff = lds_byte(wr * 64 + fr, fq * 8), boff = lds_byte(wc * 32 + fr, fq * 8);
#define PG8_SA(b, h) (((b) * 2 + (h)) * HTB)
#define PG8_SB(b, h) ((4 + (b) * 2 + (h)) * HTB)
#define PG8_STAGE(bufoff, gbase, voff) do { _Pragma("unroll") for (int _i = 0; _i < 2; ++_i) { unsigned keep_; \
        asm volatile("s_mov_b32 %0, m0\n\ts_mov_b32 m0, %3\n\ts_nop 0\n\tglobal_load_lds_dwordx4 %1, %2\n\ts_mov_b32 m0, %0" \
                     : "=&s"(keep_) : "v"((voff)[_i]), "s"((const char*)(gbase)), "s"(ldsbase_u + (unsigned)(bufoff) + ldsw + (unsigned)(_i * 8192)) : "memory"); } } while (0)
#define PG8_LDA(dst, b, h) do { _Pragma("unroll") for (int m = 0; m < 4; ++m) _Pragma("unroll") for (int k = 0; k < 2; ++k) dst[m][k] = lds_rd16((const PG8_LAS bf16x8*)(lds + PG8_SA(b, h) + aoff + m * 2048 + k * 1024)); } while (0)
#define PG8_LDB(dst, b, h) do { _Pragma("unroll") for (int n = 0; n < 2; ++n) _Pragma("unroll") for (int k = 0; k < 2; ++k) dst[n][k] = lds_rd16((const PG8_LAS bf16x8*)(lds + PG8_SB(b, h) + boff + n * 2048 + k * 1024)); } while (0)
#define PG8_MMA(ai, bj, At, Bt) do { __builtin_amdgcn_s_setprio(1); _Pragma("unroll") for (int m = 0; m < 4; ++m) _Pragma("unroll") for (int n = 0; n < 2; ++n) { \
        if constexpr (F8) { const i32x8g a8_ = __builtin_shufflevector(__builtin_bit_cast(i32x4g, At[m][0]), __builtin_bit_cast(i32x4g, At[m][1]), 0, 1, 2, 3, 4, 5, 6, 7); \
                            const i32x8g b8_ = __builtin_shufflevector(__builtin_bit_cast(i32x4g, Bt[n][0]), __builtin_bit_cast(i32x4g, Bt[n][1]), 0, 1, 2, 3, 4, 5, 6, 7); \
                            acc[ai][bj][m][n] = __builtin_amdgcn_mfma_scale_f32_16x16x128_f8f6f4(b8_, a8_, acc[ai][bj][m][n], 0, 0, 0, 0x7f7f7f7f, 0, 0x7f7f7f7f); } \
        else { _Pragma("unroll") for (int k = 0; k < 2; ++k) acc[ai][bj][m][n] = __builtin_amdgcn_mfma_f32_16x16x32_bf16(Bt[n][k], At[m][k], acc[ai][bj][m][n], 0, 0, 0); } } \
        __builtin_amdgcn_s_setprio(0); } while (0)
#define PG8_WAIT_V(n) asm volatile("s_waitcnt vmcnt(" #n ")" ::: "memory")
#define PG8_WAIT_L(n) asm volatile("s_waitcnt lgkmcnt(" #n ")" ::: "memory")
#define PG8_BAR __builtin_amdgcn_s_barrier()
#define PG8_SCHED __builtin_amdgcn_sched_barrier(0)
    Unit cur, nxt; int ui = 0;
    if (!S.next(0, cur)) return;
    f32x4 acc[2][2][4][2];
#pragma unroll
    for (int a = 0; a < 2; ++a)
#pragma unroll
        for (int b = 0; b < 2; ++b)
#pragma unroll
            for (int m = 0; m < 4; ++m)
#pragma unroll
                for (int n = 0; n < 2; ++n) acc[a][b][m][n] = (f32x4){0.f, 0.f, 0.f, 0.f};
    bf16x8 At[4][2], B0[2][2], B1[2][2];
    const char* cA = (const char*)g.A + (size_t)cur.pm * tstep; const char* cB = (const char*)g.Bt + (size_t)cur.pn * tstep;
    S.a_ready(cur);
    if constexpr (SP2) {
        PG8_STAGE(PG8_SB(0, 0), cB, voffB); PG8_STAGE(PG8_SB(0, 1), cB + hstep, voffB); PG8_STAGE(PG8_SA(0, 0), cA, voffA); PG8_STAGE(PG8_SA(0, 1), cA + hstep, voffA);
        if (wr == 1) PG8_BAR;
        PG8_WAIT_V(2); PG8_BAR;
        PG8_STAGE(PG8_SB(1, 0), cB + kstep, voffB); PG8_STAGE(PG8_SA(1, 0), cA + kstep, voffA); PG8_STAGE(PG8_SB(1, 1), cB + hstep + kstep, voffB);
        PG8_WAIT_V(6); PG8_BAR;
    } else {
        PG8_STAGE(PG8_SB(0, 0), cB, voffB); PG8_STAGE(PG8_SA(0, 0), cA, voffA); PG8_STAGE(PG8_SB(0, 1), cB + hstep, voffB); PG8_STAGE(PG8_SA(0, 1), cA + hstep, voffA);
        if (wr == 1) PG8_BAR;
        PG8_WAIT_V(4); PG8_BAR;
        PG8_STAGE(PG8_SB(1, 0), cB + kstep, voffB); PG8_STAGE(PG8_SA(1, 0), cA + kstep, voffA); PG8_STAGE(PG8_SB(1, 1), cB + hstep + kstep, voffB);
        PG8_WAIT_V(6); PG8_BAR;
    }
    for (;;) {
        const bool has_next = S.next(ui + 1, nxt);
        const char* nA = has_next ? (const char*)g.A + (size_t)nxt.pm * tstep : cA; const char* nB = has_next ? (const char*)g.Bt + (size_t)nxt.pn * tstep : cB;
#pragma unroll 1
        for (int t = 0; t < nt; t += 2) {
            const bool last = (t == nt - 2);
            const char* a1 = cA + (size_t)(t + 1) * kstep;
            const char* a2 = last ? nA : cA + (size_t)(t + 2) * kstep; const char* b2 = last ? nB : cB + (size_t)(t + 2) * kstep;
            const char* a3 = a2 + kstep; const char* b3 = b2 + kstep;
            if (last && has_next) S.a_ready(nxt);
            if constexpr (SP2) {
            PG8_LDB(B0, 0, 0); PG8_LDB(B1, 0, 1); PG8_SCHED; PG8_LDA(At, 0, 0); PG8_STAGE(PG8_SA(1, 1), a1 + hstep, voffA);
            PG8_WAIT_V(8); PG8_WAIT_L(0); PG8_BAR; PG8_MMA(0, 0, At, B0); PG8_MMA(0, 1, At, B1); PG8_BAR; PG8_SCHED;
            PG8_LDA(At, 0, 1); PG8_STAGE(PG8_SB(0, 0), b2, voffB); PG8_STAGE(PG8_SB(0, 1), b2 + hstep, voffB); PG8_STAGE(PG8_SA(0, 0), a2, voffA);
            PG8_WAIT_V(8); PG8_WAIT_L(0); PG8_BAR; PG8_MMA(1, 0, At, B0); PG8_MMA(1, 1, At, B1); PG8_BAR; PG8_SCHED;
            PG8_LDB(B0, 1, 0); PG8_LDB(B1, 1, 1); PG8_SCHED; PG8_LDA(At, 1, 0); PG8_STAGE(PG8_SA(0, 1), a2 + hstep, voffA);
            PG8_WAIT_V(8); PG8_WAIT_L(0); PG8_BAR; PG8_MMA(0, 0, At, B0); PG8_MMA(0, 1, At, B1); PG8_BAR; PG8_SCHED;
            PG8_LDA(At, 1, 1); PG8_STAGE(PG8_SB(1, 0), b3, voffB); PG8_STAGE(PG8_SB(1, 1), b3 + hstep, voffB); PG8_STAGE(PG8_SA(1, 0), a3, voffA);
            PG8_WAIT_V(8); PG8_WAIT_L(0); PG8_BAR; PG8_MMA(1, 0, At, B0); PG8_MMA(1, 1, At, B1); PG8_BAR; PG8_SCHED;
            } else {
            PG8_LDB(B0, 0, 0); PG8_SCHED; PG8_LDA(At, 0, 0); PG8_STAGE(PG8_SA(1, 1), a1 + hstep, voffA);
            PG8_WAIT_L(8); PG8_BAR; PG8_WAIT_L(0); PG8_MMA(0, 0, At, B0); PG8_BAR; PG8_SCHED;
            PG8_LDB(B1, 0, 1); PG8_STAGE(PG8_SB(0, 0), b2, voffB);
            PG8_BAR; PG8_WAIT_L(0); PG8_MMA(0, 1, At, B1); PG8_BAR;
            PG8_LDA(At, 0, 1); PG8_STAGE(PG8_SA(0, 0), a2, voffA);
            PG8_BAR; PG8_WAIT_L(0); PG8_MMA(1, 0, At, B0); PG8_BAR; PG8_SCHED;
            PG8_STAGE(PG8_SB(0, 1), b2 + hstep, voffB);
            PG8_WAIT_V(6); PG8_BAR; PG8_MMA(1, 1, At, B1); PG8_BAR;
            PG8_LDB(B0, 1, 0); PG8_SCHED; PG8_LDA(At, 1, 0); PG8_STAGE(PG8_SA(0, 1), a2 + hstep, voffA);
            PG8_WAIT_L(8); PG8_BAR; PG8_WAIT_L(0); PG8_MMA(0, 0, At, B0); PG8_BAR; PG8_SCHED;
            PG8_LDB(B1, 1, 1); PG8_STAGE(PG8_SB(1, 0), b3, voffB);
            PG8_BAR; PG8_WAIT_L(0); PG8_MMA(0, 1, At, B1); PG8_BAR;
            PG8_LDA(At, 1, 1); PG8_STAGE(PG8_SA(1, 0), a3, voffA);
            PG8_BAR; PG8_WAIT_L(0); PG8_MMA(1, 0, At, B0); PG8_BAR; PG8_SCHED;
            PG8_STAGE(PG8_SB(1, 1), b3 + hstep, voffB);
            PG8_WAIT_V(6); PG8_BAR; PG8_MMA(1, 1, At, B1); PG8_BAR;
            }
        }
        if constexpr (ALIGN_EPI) { if (wr == 0) PG8_BAR; }
        if constexpr (!Epi::AFTER_DRAIN) { int ln_; asm volatile("v_mbcnt_lo_u32_b32 %0, -1, 0\n\tv_mbcnt_hi_u32_b32 %0, -1, %0" : "=v"(ln_));
            E(acc, cur, wr, wc, ln_ & 15, ln_ >> 4); S.done(cur); }
        if (!has_next) break;
#pragma unroll
        for (int a = 0; a < 2; ++a)
#pragma unroll
            for (int b = 0; b < 2; ++b)
#pragma unroll
                for (int m = 0; m < 4; ++m)
#pragma unroll
                    for (int n = 0; n < 2; ++n) acc[a][b][m][n] = (f32x4){0.f, 0.f, 0.f, 0.f};
        cur = nxt; cA = nA; cB = nB; ++ui;
        if constexpr (ALIGN_EPI) { if (wr == 1) PG8_BAR; }
    }
    PG8_WAIT_V(0);
    if constexpr (!ALIGN_EPI) { if (wr == 0) PG8_BAR; }
    PG8_BAR;
    if constexpr (Epi::AFTER_DRAIN) { E.fused(acc, cur, wr, wc, fr, fq, lds, wid, lane); S.done(cur); }
#undef PG8_SA
#undef PG8_SB
#undef PG8_STAGE
#undef PG8_LDA
#undef PG8_LDB
#undef PG8_MMA
#undef PG8_WAIT_V
#undef PG8_WAIT_L
#undef PG8_BAR
#undef PG8_SCHED
}
}

constexpr int NB = 8, SEQ = 4096, DM = 2048, TOK = NB * SEQ;
constexpr int NWAVES = 8;
constexpr float LN_EPS = 1e-5f;
constexpr float DN_ALPHA = 1.189207115002721f;
constexpr float LOG2E = 1.4426950408889634f;
constexpr float QSCALE_A = 0.08838834764831845f * LOG2E;
constexpr float QSCALE_B = 0.07216878364870322f * LOG2E;

constexpr size_t MiB = 1u << 20;
constexpr size_t WS_CTL = 0, CTL_ZERO_BYTES = 1 * MiB;
constexpr size_t WS_WIN = 1 * MiB;
constexpr size_t WS_WKR = 33 * MiB;
constexpr size_t WS_WUQ = 34 * MiB;
constexpr size_t WS_WUKV = 36 * MiB;
constexpr size_t WS_WPA = 38 * MiB;
constexpr size_t WS_WPB = 42 * MiB;
constexpr size_t WS_WO = 46 * MiB;
constexpr size_t WS_WSK = 54 * MiB;
constexpr size_t WS_MOD = 62 * MiB;
constexpr size_t WS_BIAS = 62 * MiB + 512 * 1024;
constexpr size_t WS_LN1 = 63 * MiB;
constexpr size_t WS_UT = 64 * MiB;
constexpr size_t WS_VT = 96 * MiB;
constexpr size_t WS_TSCALE = 62 * MiB + 768 * 1024;
constexpr size_t WS_W8 = 80 * MiB;
constexpr size_t WS_HSC = 63 * MiB + 512 * 1024;
constexpr size_t WS_WUQ8 = 121 * MiB;
constexpr size_t WS_WUKV8 = 122 * MiB;
constexpr size_t WS_WKR8 = 112 * MiB;
constexpr size_t WS_WPA8 = 113 * MiB;
constexpr size_t WS_WPB8 = 115 * MiB;
constexpr size_t WS_WO8 = 117 * MiB;
constexpr size_t WS_H8 = 128 * MiB;
constexpr size_t WS_H = 192 * MiB;
constexpr size_t WS_QKVA = 320 * MiB;
constexpr size_t WS_SCORE = 320 * MiB;
constexpr size_t WS_CQ = 512 * MiB;
constexpr size_t WS_CKV = 544 * MiB;
constexpr size_t WS_U1B = 576 * MiB;
constexpr size_t WS_QN = 576 * MiB;
constexpr size_t WS_QR = 640 * MiB;
constexpr size_t WS_KN = 672 * MiB;
constexpr size_t WS_VB = 736 * MiB;
constexpr size_t WS_KR = 800 * MiB;
constexpr size_t WS_YA = 804 * MiB;
constexpr size_t WS_YB = 868 * MiB;
constexpr size_t WS_CS = 932 * MiB;
constexpr size_t WS_SSQ = 940 * MiB;
constexpr size_t WS_END = 942 * MiB;
constexpr size_t WS_IDS = 736 * MiB;
constexpr size_t WS_GATES = 744 * MiB;
constexpr size_t WS_W = 760 * MiB;
constexpr size_t WS_WSC = 768 * MiB;
constexpr size_t WS_SX = 776 * MiB;
constexpr size_t WS_S8 = 776 * MiB + 128 * 1024;
constexpr size_t WS_PA = 320 * MiB;
constexpr size_t WS_XH = 804 * MiB;
constexpr size_t WS_XL = 836 * MiB;
constexpr size_t WS_ST2 = 778 * MiB;
constexpr size_t WS_IDT = 780 * MiB;
constexpr size_t UT_SLICE = 2 * MiB;
constexpr int CW_BAR = 4096;
constexpr int CW_WMAX = 8;
constexpr float ACT_C = 16.0f;
constexpr float ACT_Y = 32.0f, ACT_MIX = 64.0f;
constexpr int CW_WMAX0 = 8;

constexpr int RING_BYTES = 131072;
constexpr int MISC_OFF = RING_BYTES + 320;
constexpr int LDS_BYTES = 147456;

#define GAS __attribute__((address_space(1)))
#define LAS __attribute__((address_space(3)))
typedef unsigned short bf16;
typedef unsigned v4u __attribute__((ext_vector_type(4)));
typedef unsigned v2u __attribute__((ext_vector_type(2)));
typedef float f32x4 __attribute__((ext_vector_type(4)));
typedef float f32x16 __attribute__((ext_vector_type(16)));
typedef short bf16x8 __attribute__((ext_vector_type(8)));
typedef short s16x4 __attribute__((ext_vector_type(4)));
typedef __bf16 bf16x2_t __attribute__((ext_vector_type(2)));
#define LDS_WAIT() asm volatile("s_waitcnt lgkmcnt(0)" ::: "memory")
#define VM_WAIT() asm volatile("s_waitcnt vmcnt(0)" ::: "memory")
__device__ __forceinline__ unsigned f2bf(float f) { unsigned u = __builtin_bit_cast(unsigned, f); return (u + 0x7fffu + ((u >> 16) & 1u)) >> 16; }
__device__ __forceinline__ unsigned pk2(float lo, float hi) { return f2bf(lo) | (f2bf(hi) << 16); }
#define WRED_DPP(v, ctrl) __builtin_amdgcn_update_dpp(0, (v), (ctrl), 0xF, 0xF, true)
__device__ __forceinline__ float wave_sum(float v) {
    v += __int_as_float(WRED_DPP(__float_as_int(v), 0xB1)); v += __int_as_float(WRED_DPP(__float_as_int(v), 0x4E));
    v += __int_as_float(WRED_DPP(__float_as_int(v), 0x141)); v += __int_as_float(WRED_DPP(__float_as_int(v), 0x140));
    { const auto r = __builtin_amdgcn_permlane16_swap(__float_as_uint(v), __float_as_uint(v), false, false); v = __uint_as_float(r[0]) + __uint_as_float(r[1]); }
    { const auto r = __builtin_amdgcn_permlane32_swap(__float_as_uint(v), __float_as_uint(v), false, false); v = __uint_as_float(r[0]) + __uint_as_float(r[1]); }
    return v;
}
__device__ __forceinline__ float wave_max(float v) {
    v = fmaxf(v, __int_as_float(WRED_DPP(__float_as_int(v), 0xB1))); v = fmaxf(v, __int_as_float(WRED_DPP(__float_as_int(v), 0x4E)));
    v = fmaxf(v, __int_as_float(WRED_DPP(__float_as_int(v), 0x141))); v = fmaxf(v, __int_as_float(WRED_DPP(__float_as_int(v), 0x140)));
    { const auto r = __builtin_amdgcn_permlane16_swap(__float_as_uint(v), __float_as_uint(v), false, false); v = fmaxf(__uint_as_float(r[0]), __uint_as_float(r[1])); }
    { const auto r = __builtin_amdgcn_permlane32_swap(__float_as_uint(v), __float_as_uint(v), false, false); v = fmaxf(__uint_as_float(r[0]), __uint_as_float(r[1])); }
    return v;
}
__device__ __forceinline__ int wave_sum_int(int v) {
    v += WRED_DPP(v, 0xB1); v += WRED_DPP(v, 0x4E); v += WRED_DPP(v, 0x141); v += WRED_DPP(v, 0x140);
    { const auto r = __builtin_amdgcn_permlane16_swap((unsigned)v, (unsigned)v, false, false); v = (int)(r[0] + r[1]); }
    { const auto r = __builtin_amdgcn_permlane32_swap((unsigned)v, (unsigned)v, false, false); v = (int)(r[0] + r[1]); }
    return v;
}
__device__ __forceinline__ float bflo(unsigned w) { return __uint_as_float(w << 16); }
__device__ __forceinline__ float bfhi(unsigned w) { return __uint_as_float(w & 0xffff0000u); }

#define XB_TMO      128
#define XB_XCNT(j)  (256  + 64 * (j))
#define XB_XSUB(j)  (1280 + 64 * (j))
#define XB_XGEN(j)  (2304 + 64 * (j))
#define XB_TOP      3328
#define XB_TOPGEN   3392
#define XCD_BAR_WORDS 3456
#define XB_SPIN_CAP (1u << 18)

__device__ __forceinline__ unsigned xb_ld(unsigned* p)              { return __hip_atomic_load(p, __ATOMIC_RELAXED, __HIP_MEMORY_SCOPE_AGENT); }
__device__ __forceinline__ unsigned xb_add(unsigned* p, unsigned v) { return __hip_atomic_fetch_add(p, v, __ATOMIC_RELAXED, __HIP_MEMORY_SCOPE_AGENT); }
__device__ __forceinline__ unsigned xb_xcc_id() { return (unsigned)__builtin_amdgcn_s_getreg((3 << 11) | 20) & 0xFu; }
#define XB_SPIN(cond, bar) do { unsigned _sp = 0; while (cond) { __builtin_amdgcn_s_sleep(1); \
    if ((++_sp & 255u) == 0u) { if (xb_ld(&(bar)[XB_TMO])) break; if (_sp > XB_SPIN_CAP) { atomicAdd(&(bar)[XB_TMO], 1u); break; } } } } while (0)

struct XcdBarrier {
    unsigned* bar; unsigned x;
    volatile LAS unsigned* st;
    bool w0;
};
__device__ __forceinline__ bool xb_thread0(bool w0) { return w0 && __builtin_amdgcn_mbcnt_hi(~0u, __builtin_amdgcn_mbcnt_lo(~0u, 0u)) == 0u; }

__device__ __forceinline__ XcdBarrier xcd_barrier_post(unsigned* bar, volatile LAS unsigned* st, bool w0) {
    XcdBarrier b; b.bar = bar; b.x = xb_xcc_id(); b.st = st; b.w0 = w0;
    if (xb_thread0(w0)) (void)xb_add(&bar[XB_XCNT(b.x)], 1u);
    return b;
}
__device__ __forceinline__ void xcd_barrier_complete(unsigned* bar, unsigned x, unsigned& nloc, unsigned& nx) {
    const unsigned G = gridDim.x * gridDim.y * gridDim.z;
    unsigned sum, cnt, mine, sp = 0u;
    for (;;) {
        sum = 0u; cnt = 0u; mine = 0u;
#pragma unroll
        for (unsigned j = 0; j < 16; ++j) { const unsigned c = xb_ld(&bar[XB_XCNT(j)]); sum += c; cnt += (c > 0u) ? 1u : 0u; mine = (j == x) ? c : mine; }
        if (sum == G) break;
        __builtin_amdgcn_s_sleep(1);
        if ((++sp & 255u) == 0u) { if (xb_ld(&bar[XB_TMO])) break; if (sp > XB_SPIN_CAP) { atomicAdd(&bar[XB_TMO], 1u); break; } }
    }
    nloc = mine > 0u ? mine : 1u; nx = cnt > 0u ? cnt : 1u;
}

__device__ __forceinline__ void xcd_barrier(const XcdBarrier& b) {
    asm volatile("s_waitcnt vmcnt(0)" ::: "memory");
    __syncthreads();
    if (xb_thread0(b.w0)) {
        unsigned* bar = b.bar;
        __builtin_amdgcn_s_waitcnt(0);
        unsigned nloc = b.st[0], nx = b.st[1];
        if (nloc == 0u) { xcd_barrier_complete(bar, b.x, nloc, nx); b.st[0] = nloc; b.st[1] = nx; }
        const unsigned old = xb_add(&bar[XB_XSUB(b.x)], 1u);
        const unsigned gen = old / nloc;
        if (old + 1u == (gen + 1u) * nloc) {
            __builtin_amdgcn_fence(__ATOMIC_RELEASE, "agent");
            asm volatile("s_waitcnt vmcnt(0)" ::: "memory");
            const unsigned og = xb_add(&bar[XB_TOP], 1u);
            const unsigned tg = og / nx;
            if (og + 1u == (tg + 1u) * nx) xb_add(&bar[XB_TOPGEN], 1u);
            else XB_SPIN(xb_ld(&bar[XB_TOPGEN]) == tg, bar);
            __builtin_amdgcn_fence(__ATOMIC_ACQUIRE, "agent");
            xb_add(&bar[XB_XGEN(b.x)], 1u);
            asm volatile("s_waitcnt vmcnt(0)" ::: "memory");
        } else {
            XB_SPIN(xb_ld(&bar[XB_XGEN(b.x)]) == gen, bar);
            __builtin_amdgcn_fence(__ATOMIC_ACQUIRE, "agent");
            asm volatile("s_waitcnt vmcnt(0)" ::: "memory");
        }
    }
    __syncthreads();
}

namespace att {
constexpr int SHM_V = 16384, SHM_KN = 16384, SHM_KR = 8192, BUFB = SHM_V + SHM_KN + SHM_KR;
constexpr int OFF_V = 0, OFF_KN = SHM_V, OFF_KR = SHM_V + SHM_KN;
constexpr int NSLOT = 3;
constexpr int OFF_WS = NSLOT * BUFB, OFF_BIAS = OFF_WS + 2048, ATT_LDS = OFF_BIAS + 1280;
static_assert(ATT_LDS <= RING_BYTES, "attention LDS");
#define KSWZ(row, colB) ((row) * 256 + ((colB) ^ (((row) & 15) << 4)))
#define KRSWZ(row, colB) ((row) * 128 + ((colB) ^ ((((row) >> 1) & 7) << 4)))
__device__ __forceinline__ int v_st(int k, int c) { const int kk = (k & ~0xC) | ((k & 4) << 1) | ((k & 8) >> 1); return ((kk >> 3) * 4 + (c >> 5)) * 512 + ((kk & 7) * 32 + (c & 31)) * 2; }
__device__ __forceinline__ int v_rd_base(int lane) { return ((lane & 3) << 3) | (((lane >> 2) & 3) << 6) | (((lane >> 4) & 1) << 5) | (((lane >> 5) & 1) << 8); }
__device__ __forceinline__ int crow(int r, int hi) { return (r & 3) + 8 * (r >> 2) + 4 * hi; }
__device__ __forceinline__ unsigned cvtpk(float lo, float hi) { return pg8::cvt_pk_bf16(lo, hi); }
constexpr float THR = 8.0f;

template <int MODE>
__device__ __forceinline__ void attn_unit(LAS unsigned char* lds, int b, int h, int qb, const bf16* __restrict__ Qn, const bf16* __restrict__ Qr, const bf16* __restrict__ Kn,
                                          const bf16* __restrict__ Kr, const bf16* __restrict__ V, bf16* __restrict__ O, const float* __restrict__ relb, const int tid_in) {
    constexpr int ND = MODE ? 12 : 8;
    int tid = tid_in; asm volatile("" : "+v"(tid));
    const int wid = __builtin_amdgcn_readfirstlane(tid >> 6), lane = tid & 63, r32 = lane & 31, hi = lane >> 5;
    const int tb = b * SEQ, cw = 4 * qb + (wid >> 1);
    const int j_lo = MODE ? 0 : (4 * qb - 8 > 0 ? 4 * qb - 8 : 0), j_hi = 4 * qb + 4, NTL = j_hi - j_lo;
    bf16x8 qr[ND];
    { const size_t qrow = (size_t)(tb + 256 * qb + 32 * wid + r32);
#pragma unroll
      for (int d0 = 0; d0 < 8; ++d0) qr[d0] = *(const bf16x8*)(Qn + qrow * 1024 + h * 128 + d0 * 16 + hi * 8);
      if constexpr (MODE == 1) {
#pragma unroll
          for (int d0 = 0; d0 < 4; ++d0) qr[8 + d0] = *(const bf16x8*)(Qr + qrow * 512 + h * 64 + d0 * 16 + hi * 8); } }
    unsigned gk[2], gv[2], gkr;
#pragma unroll
    for (int i = 0; i < 2; ++i) { const int p = 2 * wid + i; const int row = 4 * p + (lane >> 4), colB = ((lane & 15) << 4) ^ ((row & 15) << 4);
        gk[i] = (unsigned)(row * 2048 + colB);
        const int st = 2 * p + (lane >> 5), kk = (st >> 2) * 8 + ((lane & 31) >> 2), c = (st & 3) * 32 + (lane & 3) * 8, k = (kk & ~0xC) | ((kk & 4) << 1) | ((kk & 8) >> 1);
        gv[i] = (unsigned)(k * 2048 + c * 2); }
    { const int row = 8 * wid + (lane >> 3), colB = ((lane & 7) << 4) ^ (((row >> 1) & 7) << 4); gkr = (unsigned)(row * 128 + colB); }
    const char* Kg = (const char*)(Kn + (size_t)tb * 1024 + h * 128); const char* Vg = (const char*)(V + (size_t)tb * 1024 + h * 128); const char* Krg = (const char*)(Kr + (size_t)tb * 64);
#define ATT_STAGE(j, bo) do { const size_t to_ = (size_t)(j) * (64 * 2048); \
        __builtin_amdgcn_global_load_lds((const unsigned*)(Kg + to_ + gk[0]), (LAS unsigned*)(lds + (bo) + OFF_KN + wid * 2048), 16, 0, 0); \
        __builtin_amdgcn_global_load_lds((const unsigned*)(Kg + to_ + gk[1]), (LAS unsigned*)(lds + (bo) + OFF_KN + wid * 2048 + 1024), 16, 0, 0); \
        __builtin_amdgcn_global_load_lds((const unsigned*)(Vg + to_ + gv[0]), (LAS unsigned*)(lds + (bo) + OFF_V + wid * 2048), 16, 0, 0); \
        __builtin_amdgcn_global_load_lds((const unsigned*)(Vg + to_ + gv[1]), (LAS unsigned*)(lds + (bo) + OFF_V + wid * 2048 + 1024), 16, 0, 0); \
        if constexpr (MODE == 1) __builtin_amdgcn_global_load_lds((const unsigned*)(Krg + (size_t)(j) * (64 * 128) + gkr), (LAS unsigned*)(lds + (bo) + OFF_KR + wid * 1024), 16, 0, 0); } while (0)
    float m_reg = -1e30f, l_reg = 0.f; f32x16 o[4] = {};
    LAS float* li_l = (LAS float*)(lds + OFF_WS) + wid * 64; LAS float* al_l = li_l + 32;
    const LAS float* biasL = (const LAS float*)(lds + OFF_BIAS);
    if constexpr (MODE == 0) { if (tid < 320) ((LAS float*)(lds + OFF_BIAS))[tid] = relb[tid] * LOG2E; }
    int kb[8], krb[4];
#pragma unroll
    for (int dd = 0; dd < 4; ++dd) { kb[dd] = OFF_KN + KSWZ(r32, (dd * 16 + hi * 8) * 2); kb[4 + dd] = OFF_KN + KSWZ(r32, 128 + (dd * 16 + hi * 8) * 2); krb[dd] = OFF_KR + KRSWZ(r32, dd * 32 + hi * 16); }
    const unsigned vb0 = (unsigned)(uintptr_t)lds + OFF_V + v_rd_base(lane);
    constexpr int NDMA = MODE ? 5 : 4;
    ATT_STAGE(j_lo, 0);
    if (NTL > 1) { ATT_STAGE(j_lo + 1, BUFB); asm volatile("s_waitcnt vmcnt(%0)" :: "i"(NDMA) : "memory"); } else VM_WAIT();
    __syncthreads();
    int bo = 0, bo2 = 2 * BUFB;
    for (int t = 0; t < NTL; ++t) {
        const int j = j_lo + t;
        if (t + 2 < NTL) ATT_STAGE(j + 2, bo2);
        const bool act = MODE ? (j <= cw) : (j <= cw && j >= cw - 8);
        if (act) {
            f32x16 p0 = {}, p1 = {};
            { bf16x8 kf[2][2];
              unsigned kad[8], krad[4];
#pragma unroll
              for (int dd = 0; dd < 4; ++dd) { kad[dd] = (unsigned)(uintptr_t)lds + (unsigned)bo + (unsigned)kb[dd]; kad[4 + dd] = (unsigned)(uintptr_t)lds + (unsigned)bo + (unsigned)kb[4 + dd]; krad[dd] = (unsigned)(uintptr_t)lds + (unsigned)bo + (unsigned)krb[dd]; }
#define ATT_KRD(dst, ad, off) asm volatile("ds_read_b128 %0, %1 offset:%2" : "=&v"(dst) : "v"(ad), "i"(off) : "memory")
#define ATT_KLD(d0_, s_) do { if ((d0_) < 8) { ATT_KRD(kf[s_][0], kad[(d0_) & 7], 0); ATT_KRD(kf[s_][1], kad[(d0_) & 7], 32 * 256); } \
                                  else { ATT_KRD(kf[s_][0], krad[((d0_) - 8) & 3], 0); ATT_KRD(kf[s_][1], krad[((d0_) - 8) & 3], 32 * 128); } } while (0)
              ATT_KLD(0, 0);
#pragma unroll
              for (int d0 = 0; d0 < ND; ++d0) {
                  if (d0 + 1 < ND) { ATT_KLD(d0 + 1, (d0 + 1) & 1); asm volatile("s_waitcnt lgkmcnt(2)" ::: "memory"); } else { asm volatile("s_waitcnt lgkmcnt(0)" ::: "memory"); }
                  __builtin_amdgcn_sched_barrier(0);
                  p0 = __builtin_amdgcn_mfma_f32_32x32x16_bf16(kf[d0 & 1][0], qr[d0], p0, 0, 0, 0); p1 = __builtin_amdgcn_mfma_f32_32x32x16_bf16(kf[d0 & 1][1], qr[d0], p1, 0, 0, 0);
                  __builtin_amdgcn_sched_barrier(0); }
#undef ATT_KLD
#undef ATT_KRD
            }
            if constexpr (MODE == 0) {
                const int dc = cw - j;
                if (dc >= 5) { const float bc = biasL[319];
#pragma unroll
                    for (int r = 0; r < 16; ++r) { p0[r] += bc; p1[r] += bc; } }
                else { const int base = 64 * dc + 32 * (wid & 1) + r32 - 4 * hi;
#pragma unroll
                    for (int r = 0; r < 16; ++r) { const int rel0 = base - ((r & 3) + 8 * (r >> 2)); int i0 = rel0 < -63 ? -63 : rel0; i0 = i0 > 256 ? 256 : i0; int i1 = rel0 - 32 < -63 ? -63 : rel0 - 32; i1 = i1 > 256 ? 256 : i1;
                        p0[r] += biasL[i0 + 63]; p1[r] += biasL[i1 + 63]; } }
            }
            float pmax = p0[0];
#pragma unroll
            for (int r = 1; r < 16; ++r) pmax = fmaxf(pmax, p0[r]);
#pragma unroll
            for (int r = 0; r < 16; ++r) pmax = fmaxf(pmax, p1[r]);
            { auto rr = __builtin_amdgcn_permlane32_swap(__float_as_uint(pmax), __float_as_uint(pmax), false, false); pmax = fmaxf(__uint_as_float(rr[0]), __uint_as_float(rr[1])); }
            float mn, alpha;
            if (__all((pmax - m_reg) <= THR)) { mn = m_reg; alpha = 1.f; }
            else { mn = fmaxf(m_reg, pmax); alpha = __builtin_amdgcn_exp2f(m_reg - mn); m_reg = mn; }
#pragma unroll
            for (int r = 0; r < 16; ++r) { p0[r] = __builtin_amdgcn_exp2f(p0[r] - mn); p1[r] = __builtin_amdgcn_exp2f(p1[r] - mn); }
            float ps = 0.f;
#pragma unroll
            for (int r = 0; r < 16; ++r) ps += p0[r];
#pragma unroll
            for (int r = 0; r < 16; ++r) ps += p1[r];
            { auto rr = __builtin_amdgcn_permlane32_swap(__float_as_uint(ps), __float_as_uint(ps), false, false); ps = __uint_as_float(rr[0]) + __uint_as_float(rr[1]); }
            l_reg = l_reg * alpha + ps;
            bf16x8 pa0, pa1, pa2, pa3;
#define ATT_PK4(P, B_, OUT) do { unsigned a0 = cvtpk(P[B_+0], P[B_+1]), a1 = cvtpk(P[B_+2], P[B_+3]); unsigned b0 = cvtpk(P[B_+4], P[B_+5]), b1 = cvtpk(P[B_+6], P[B_+7]); \
        auto r0 = __builtin_amdgcn_permlane32_swap(a0, b0, false, false); auto r1 = __builtin_amdgcn_permlane32_swap(a1, b1, false, false); \
        v4u w = {r0[0], r1[0], r0[1], r1[1]}; OUT = __builtin_bit_cast(bf16x8, w); } while (0)
            ATT_PK4(p0, 0, pa0); ATT_PK4(p0, 8, pa1); ATT_PK4(p1, 0, pa2); ATT_PK4(p1, 8, pa3);
#undef ATT_PK4
            if (__any(alpha < 1.f)) { if (hi == 0) al_l[r32] = alpha; LDS_WAIT();
#pragma unroll
                for (int r = 0; r < 16; ++r) { const float a = al_l[crow(r, hi)];
#pragma unroll
                    for (int d = 0; d < 4; ++d) o[d][r] *= a; } }
            const unsigned vb = vb0 + (unsigned)bo;
#define ATT_TRRD(dst, off) asm volatile("ds_read_b64_tr_b16 %0, %1 offset:%2" : "=&v"(dst) : "v"(vb), "i"(off) : "memory")
#define ATT_VLD(d0, L) do { constexpr int b_ = (d0) * 512; ATT_TRRD(L[0], b_); ATT_TRRD(L[4], b_ + 2048); ATT_TRRD(L[1], b_ + 4096); ATT_TRRD(L[5], b_ + 6144); ATT_TRRD(L[2], b_ + 8192); ATT_TRRD(L[6], b_ + 10240); ATT_TRRD(L[3], b_ + 12288); ATT_TRRD(L[7], b_ + 14336); } while (0)
#define ATT_PVM(d0, L) do { \
        o[d0] = __builtin_amdgcn_mfma_f32_32x32x16_bf16(pa0, (bf16x8){L[0][0], L[0][1], L[0][2], L[0][3], L[4][0], L[4][1], L[4][2], L[4][3]}, o[d0], 0, 0, 0); \
        o[d0] = __builtin_amdgcn_mfma_f32_32x32x16_bf16(pa1, (bf16x8){L[1][0], L[1][1], L[1][2], L[1][3], L[5][0], L[5][1], L[5][2], L[5][3]}, o[d0], 0, 0, 0); \
        o[d0] = __builtin_amdgcn_mfma_f32_32x32x16_bf16(pa2, (bf16x8){L[2][0], L[2][1], L[2][2], L[2][3], L[6][0], L[6][1], L[6][2], L[6][3]}, o[d0], 0, 0, 0); \
        o[d0] = __builtin_amdgcn_mfma_f32_32x32x16_bf16(pa3, (bf16x8){L[3][0], L[3][1], L[3][2], L[3][3], L[7][0], L[7][1], L[7][2], L[7][3]}, o[d0], 0, 0, 0); } while (0)
            { s16x4 va[8], vb_[8];
              ATT_VLD(0, va);
              ATT_VLD(1, vb_); asm volatile("s_waitcnt lgkmcnt(8)" ::: "memory"); __builtin_amdgcn_sched_barrier(0); ATT_PVM(0, va); __builtin_amdgcn_sched_barrier(0);
              ATT_VLD(2, va);  asm volatile("s_waitcnt lgkmcnt(8)" ::: "memory"); __builtin_amdgcn_sched_barrier(0); ATT_PVM(1, vb_); __builtin_amdgcn_sched_barrier(0);
              ATT_VLD(3, vb_); asm volatile("s_waitcnt lgkmcnt(8)" ::: "memory"); __builtin_amdgcn_sched_barrier(0); ATT_PVM(2, va); __builtin_amdgcn_sched_barrier(0);
              asm volatile("s_waitcnt lgkmcnt(0)" ::: "memory"); __builtin_amdgcn_sched_barrier(0); ATT_PVM(3, vb_); }
#undef ATT_VLD
#undef ATT_PVM
#undef ATT_TRRD
        }
        if (t + 2 < NTL) asm volatile("s_waitcnt vmcnt(%0)" :: "i"(NDMA) : "memory"); else VM_WAIT();
        asm volatile("s_waitcnt lgkmcnt(0)" ::: "memory"); __builtin_amdgcn_s_barrier(); asm volatile("" ::: "memory");
        bo = (bo == 2 * BUFB) ? 0 : bo + BUFB; bo2 = (bo2 == 2 * BUFB) ? 0 : bo2 + BUFB;
    }
    if (hi == 0) li_l[r32] = l_reg; LDS_WAIT();
    { LAS unsigned char* ost = lds + wid * 4096;
#pragma unroll
      for (int r = 0; r < 16; ++r) { const int orow = crow(r, hi); const float rl = __builtin_amdgcn_rcpf(li_l[orow]) * ACT_Y;
#pragma unroll
          for (int d0 = 0; d0 < 4; ++d0) { const float v = o[d0][r] * rl; ost[orow * 128 + d0 * 32 + r32] = (unsigned char)(__builtin_amdgcn_cvt_pk_fp8_f32(v, v, 0, false) & 0xff); } }
      LDS_WAIT();
      unsigned char* Ow = (unsigned char*)O + (size_t)(tb + 256 * qb + 32 * wid) * 1024 + h * 128;
#pragma unroll
      for (int k = 0; k < 4; ++k) { const int idx = lane + 64 * k, row = idx >> 3, ch = idx & 7;
          const v4u val = *(const LAS v4u*)(lds + wid * 4096 + row * 128 + ch * 16);
          *(v4u*)(Ow + (size_t)row * 1024 + ch * 16) = val; } }
    __syncthreads();
#undef ATT_STAGE
}
#undef KSWZ
#undef KRSWZ
}


struct Args {
    const float *x, *c; const int* positions;
    const float *w_ada, *b_ada, *w_in, *b_in, *rel_bias, *q_norm_g, *kv_norm_g, *w_uq, *w_ukv, *w_pa, *w_pb, *w_o, *ln1_g, *ln1_b, *peer_wq, *peer_keys, *peer_u, *peer_v, *ln2_g, *ln2_b;
    float* out; unsigned char* ws; int ph_lo, ph_hi;
};

template <class SrcCol>
__device__ __forceinline__ void transpose_item(const float* __restrict__ W, int K, int N, bf16* __restrict__ WT, int nblk, LAS float* scr, int item, int lane, SrcCol srccol, const float* __restrict__ kscale, float* amax = nullptr) {
    const int kb = item / nblk, nb = item % nblk, k0 = 64 * kb, n0 = 32 * nb;
    const int scol = srccol(n0 + (lane & 31));
    float am = 0.f, vv[32];
    { const float* wp = W + (size_t)(k0 + (lane >> 5)) * N + scol;
#pragma unroll
      for (int i = 0; i < 32; ++i) vv[i] = __builtin_nontemporal_load(wp + (size_t)(2 * i) * N); }
#pragma unroll
    for (int i = 0; i < 32; ++i) { const int kk = 2 * i + (lane >> 5); float v = vv[i]; if (kscale) v *= kscale[k0 + kk]; scr[kk * 33 + (lane & 31)] = v; am = fmaxf(am, fabsf(v)); }
    if (amax) *amax = fmaxf(*amax, am);
    LDS_WAIT(); asm volatile("" ::: "memory");
    const int c = lane & 7;
#pragma unroll
    for (int j = 0; j < 4; ++j) { const int n = (lane >> 3) + 8 * j; const LAS float* s = scr + (8 * c) * 33 + n;
        v4u o; o.x = pk2(s[0 * 33], s[1 * 33]); o.y = pk2(s[2 * 33], s[3 * 33]); o.z = pk2(s[4 * 33], s[5 * 33]); o.w = pk2(s[6 * 33], s[7 * 33]);
        *(v4u*)(WT + (size_t)(n0 + n) * K + k0 + 8 * c) = o; }
    LDS_WAIT(); asm volatile("" ::: "memory");
}
struct ColIn { __device__ int operator()(int n) const { return n < 4096 ? n : n + 64; } };
struct ColKr { __device__ int operator()(int n) const { return 4096 + (n >> 1) + 32 * (n & 1); } };
struct ColUq { __device__ int operator()(int n) const { if (n < 1024) return (n >> 7) * 192 + (n & 127); const int r = n - 1024, hh = r >> 6, o = r & 63; return hh * 192 + 128 + (o >> 1) + 32 * (o & 1); } };
struct ColUkv { __device__ int operator()(int n) const { return n < 1024 ? (n >> 7) * 256 + (n & 127) : ((n - 1024) >> 7) * 256 + 128 + (n & 127); } };
struct ColId { __device__ int operator()(int n) const { return n; } };

__device__ __forceinline__ void p0_prologue(const Args& A, LAS unsigned char* lds, int tid, int lane, int wave, int vcu, int G) {
    unsigned char* ws = A.ws;
    {
        LAS float* sl = (LAS float*)lds;
        LAS float* red = (LAS float*)(lds + 65536);
        for (int i = tid; i < NB * DM; i += NWAVES * 64) { const int b = i >> 11, k = i & 2047; const float v = A.c[i]; sl[k * 8 + b] = v / (1.0f + __expf(-v)); }
        __syncthreads();
        float* mod = (float*)(ws + WS_MOD);
        for (int cb = blockIdx.x; cb < 256; cb += G) {
            const int r = lane / 12, c4 = lane % 12; const int col = cb * 48 + c4 * 4;
            float acc[8][4];
#pragma unroll
            for (int b = 0; b < 8; ++b)
#pragma unroll
                for (int i = 0; i < 4; ++i) acc[b][i] = 0.f;
            if (r < 5) {
#pragma unroll 4
                for (int kk = r; kk < 256; kk += 5) { const int k = wave * 256 + kk;
                    const f32x4 wv = __builtin_nontemporal_load((const f32x4*)(A.w_ada + (size_t)k * (6 * DM) + col));
                    const f32x4 s0 = *(const LAS f32x4*)(sl + k * 8), s1 = *(const LAS f32x4*)(sl + k * 8 + 4);
#pragma unroll
                    for (int i = 0; i < 4; ++i) { acc[0][i] += s0[0] * wv[i]; acc[1][i] += s0[1] * wv[i]; acc[2][i] += s0[2] * wv[i]; acc[3][i] += s0[3] * wv[i];
                                                  acc[4][i] += s1[0] * wv[i]; acc[5][i] += s1[1] * wv[i]; acc[6][i] += s1[2] * wv[i]; acc[7][i] += s1[3] * wv[i]; } }
#pragma unroll
                for (int i = 0; i < 4; ++i)
#pragma unroll
                    for (int b = 0; b < 8; ++b) red[((wave * 5 + r) * 48 + c4 * 4 + i) * 8 + b] = acc[b][i];
            }
            __syncthreads();
            if (tid < 384) { const int cc = tid >> 3, b = tid & 7; float s = 0.f;
                for (int p = 0; p < 40; ++p) s += red[(p * 48 + cc) * 8 + b];
                const int col2 = cb * 48 + cc; mod[(size_t)b * (6 * DM) + col2] = s + A.b_ada[col2]; }
            __syncthreads();
        }
    }
    const int gw = vcu * NWAVES + wave, NGW = G * NWAVES;
    {
        LAS float* scr = (LAS float*)(lds + wave * 16384);
        constexpr int I_IN = 32 * 256, I_KR = 32 * 2, I_UQ = 8 * 48, I_UKV = 8 * 64, I_PA = 16 * 64, I_PB = 16 * 64, I_O = 32 * 64;
        constexpr int NITEMS = I_IN + I_KR + I_UQ + I_UKV + I_PA + I_PB + I_O;
        float amx[6] = {0.f, 0.f, 0.f, 0.f, 0.f, 0.f};
        for (int it = gw; it < NITEMS; it += NGW) {
            int r = it;
            if (r < I_IN) { transpose_item(A.w_in, 2048, 8256, (bf16*)(ws + WS_WIN), 256, scr, r, lane, ColIn(), nullptr, &amx[0]); continue; } r -= I_IN;
            if (r < I_KR) { transpose_item(A.w_in, 2048, 8256, (bf16*)(ws + WS_WKR), 2, scr, r, lane, ColKr(), nullptr); continue; } r -= I_KR;
            if (r < I_UQ) { transpose_item(A.w_uq, 512, 1536, (bf16*)(ws + WS_WUQ), 48, scr, r, lane, ColUq(), A.q_norm_g, &amx[4]); continue; } r -= I_UQ;
            if (r < I_UKV) { transpose_item(A.w_ukv, 512, 2048, (bf16*)(ws + WS_WUKV), 64, scr, r, lane, ColUkv(), A.kv_norm_g, &amx[5]); continue; } r -= I_UKV;
            if (r < I_PA) { transpose_item(A.w_pa, 1024, 2048, (bf16*)(ws + WS_WPA), 64, scr, r, lane, ColId(), nullptr, &amx[1]); continue; } r -= I_PA;
            if (r < I_PB) { transpose_item(A.w_pb, 1024, 2048, (bf16*)(ws + WS_WPB), 64, scr, r, lane, ColId(), nullptr, &amx[2]); continue; } r -= I_PB;
            transpose_item(A.w_o, 2048, 2048, (bf16*)(ws + WS_WO), 64, scr, r, lane, ColId(), nullptr, &amx[3]);
        }
        { v4u* z = (v4u*)(ws + WS_WKR + (size_t)64 * 2048 * 2); const int n16 = 192 * 2048 * 2 / 16;
          for (int i = blockIdx.x * (NWAVES * 64) + tid; i < n16; i += G * NWAVES * 64) z[i] = (v4u){0u, 0u, 0u, 0u}; }
#pragma unroll
        for (int m = 0; m < 6; ++m) {
            amx[m] = wave_max(amx[m]); }
        if (lane == 0) {
#pragma unroll
            for (int m = 0; m < 6; ++m) scr[2112 + m] = amx[m]; }
    }
    __syncthreads();
    if (tid < 6) { float am = 0.f;
#pragma unroll
        for (int w = 0; w < NWAVES; ++w) am = fmaxf(am, ((LAS float*)(lds + w * 16384))[2112 + tid]);
        atomicMax((unsigned*)(ws + WS_CTL) + CW_WMAX + tid, __float_as_uint(am)); }
    __syncthreads();
    {
        bf16* wsk = (bf16*)(ws + WS_WSK);
        const int m16 = lane & 15, kq = lane >> 4;
        for (int it = gw; it < 16 * 128; it += NGW) {
            const int hp = it >> 7, k0 = (it & 127) * 16;
            bf16x8 af[4];
#pragma unroll
            for (int ks = 0; ks < 4; ++ks) { const float* p = A.peer_wq + (size_t)(k0 + m16) * 2048 + hp * 128 + 32 * ks + 8 * kq; const f32x4 x0 = *(const f32x4*)p, x1 = *(const f32x4*)(p + 4);
                const v4u w = {pg8::cvt_pk_bf16(x0[0], x0[1]), pg8::cvt_pk_bf16(x0[2], x0[3]), pg8::cvt_pk_bf16(x1[0], x1[1]), pg8::cvt_pk_bf16(x1[2], x1[3])}; af[ks] = __builtin_bit_cast(bf16x8, w); }
#pragma unroll 2
            for (int nb = 0; nb < 8; ++nb) { f32x4 acc = {0.f, 0.f, 0.f, 0.f};
#pragma unroll
                for (int ks = 0; ks < 4; ++ks) { const float* p = A.peer_keys + (size_t)hp * 16384 + (size_t)(nb * 16 + m16) * 128 + 32 * ks + 8 * kq; const f32x4 x0 = *(const f32x4*)p, x1 = *(const f32x4*)(p + 4);
                    const v4u w = {pg8::cvt_pk_bf16(x0[0], x0[1]), pg8::cvt_pk_bf16(x0[2], x0[3]), pg8::cvt_pk_bf16(x1[0], x1[1]), pg8::cvt_pk_bf16(x1[2], x1[3])};
                    acc = __builtin_amdgcn_mfma_f32_16x16x32_bf16(af[ks], __builtin_bit_cast(bf16x8, w), acc, 0, 0, 0); }
                v2u o; o.x = pk2(acc[0], acc[1]); o.y = pk2(acc[2], acc[3]);
                *(v2u*)(wsk + (size_t)(hp * 128 + nb * 16 + m16) * 2048 + k0 + 4 * kq) = o; }
        }
    }
#pragma unroll 2
    for (int rw = gw; rw < 2 * 16384; rw += NGW) {
        const float* src = (rw < 16384 ? A.peer_u : A.peer_v) + (size_t)(rw & 16383) * 2048;
        unsigned char* dst = ws + (rw < 16384 ? WS_UT : WS_VT) + (size_t)(rw & 16383) * 1024;
        f32x4 v[8]; float am = 0.f;
#pragma unroll
        for (int q = 0; q < 8; ++q) { v[q] = __builtin_nontemporal_load((const f32x4*)(src + q * 256 + lane * 4)); am = fmaxf(am, fmaxf(fmaxf(fabsf(v[q][0]), fabsf(v[q][1])), fmaxf(fabsf(v[q][2]), fabsf(v[q][3])))); }
        if (rw < 16384) {
            float ss = 0.f;
#pragma unroll
            for (int q = 0; q < 8; ++q) ss += (v[q][0] * v[q][0] + v[q][1] * v[q][1]) + (v[q][2] * v[q][2] + v[q][3] * v[q][3]);
            ss = wave_sum(ss);
            const float step = 0.3352f * sqrtf(ss * (1.0f / 2048.0f)), inv = ss > 0.f ? 1.0f / step : 0.f;
            if (lane == 0) ((float*)(ws + WS_TSCALE))[rw] = step;
#pragma unroll
            for (int q = 0; q < 8; ++q) { unsigned h = 0u;
#pragma unroll
                for (int m = 0; m < 4; ++m) { int qi = (int)floorf(v[q][m] * inv); qi = qi < -8 ? -8 : (qi > 7 ? 7 : qi); h |= ((unsigned)qi & 15u) << (4 * m); }
                *(unsigned short*)(ws + WS_UT + (size_t)q * UT_SLICE + (size_t)rw * 128 + lane * 2) = (unsigned short)h; }
            continue;
        }
        am = wave_max(am);
        const float sc = am > 0.f ? 6.0f / am : 1.0f;
        if (lane == 0) ((float*)(ws + WS_TSCALE))[rw] = am > 0.f ? am / 6.0f : 1.0f;
        v4u o;
#pragma unroll
        for (int k = 0; k < 4; ++k) { const f32x4 f0 = v[2 * k] * sc, f1 = v[2 * k + 1] * sc; unsigned w = 0u;
            w = __builtin_amdgcn_cvt_scalef32_pk_fp4_f32(w, f0[0], f0[1], 1.0f, 0); w = __builtin_amdgcn_cvt_scalef32_pk_fp4_f32(w, f0[2], f0[3], 1.0f, 1);
            w = __builtin_amdgcn_cvt_scalef32_pk_fp4_f32(w, f1[0], f1[1], 1.0f, 2); w = __builtin_amdgcn_cvt_scalef32_pk_fp4_f32(w, f1[2], f1[3], 1.0f, 3); o[k] = w; }
#pragma unroll
        for (int k = 0; k < 4; ++k) {
            *(unsigned short*)(ws + WS_VT + (size_t)(2 * k) * UT_SLICE + (size_t)(rw & 16383) * 128 + lane * 2) = (unsigned short)(o[k] & 0xffffu);
            *(unsigned short*)(ws + WS_VT + (size_t)(2 * k + 1) * UT_SLICE + (size_t)(rw & 16383) * 128 + lane * 2) = (unsigned short)(o[k] >> 16); }
    }
    {
        float* cs = (float*)(ws + WS_CS);
        const float inv = powf(10000.0f, -(float)(2 * (tid & 31)) / 64.0f);
        for (int i = blockIdx.x * (NWAVES * 64) + tid; i < TOK * 32; i += G * NWAVES * 64) { const int t = i >> 5;
            const float ang = (float)A.positions[t] * inv; float sn, cn; sincosf(ang, &sn, &cn);
            *(pg8::f32x2*)(cs + (size_t)i * 2) = (pg8::f32x2){cn, sn}; }
        float* bs = (float*)(ws + WS_BIAS);
        for (int i = blockIdx.x * (NWAVES * 64) + tid; i < 8192 + 64; i += G * NWAVES * 64) bs[i] = i < 8192 ? A.b_in[i < 4096 ? i : i + 64] : A.b_in[4096 + ((i - 8192) >> 1) + 32 * ((i - 8192) & 1)];
    }
}

__device__ __forceinline__ unsigned pk4_fp8(float a, float b, float c, float d) { int w = __builtin_amdgcn_cvt_pk_fp8_f32(a, b, 0, false); w = __builtin_amdgcn_cvt_pk_fp8_f32(c, d, w, true); return (unsigned)w; }
__device__ __forceinline__ void p1_w8(const unsigned char* srcb, unsigned char* dstb, int n8, float wq, int lane, int gw, int NGW) {
    const v4u* src = (const v4u*)srcb; v2u* dst = (v2u*)dstb;
    for (int i = gw * 64 + lane; i < n8; i += NGW * 64) { const v4u w = src[i]; v2u o;
        o.x = pk4_fp8(bflo(w.x) * wq, bfhi(w.x) * wq, bflo(w.y) * wq, bfhi(w.y) * wq); o.y = pk4_fp8(bflo(w.z) * wq, bfhi(w.z) * wq, bflo(w.w) * wq, bfhi(w.w) * wq); dst[i] = o; }
}
__device__ __forceinline__ void p1_modulate(const Args& A, int lane, int gw, int NGW) {
    const float* mod = (const float*)(A.ws + WS_MOD); unsigned* H8 = (unsigned*)(A.ws + WS_H8); float* hsc = (float*)(A.ws + WS_HSC);
    constexpr int R = 4;
    for (int t0 = gw * R; t0 < TOK; t0 += NGW * R) { const int b = t0 >> 12; const float* sh = mod + (size_t)b * (6 * DM); const float* sc = sh + DM;
        f32x4 hv[R][8];
#pragma unroll
        for (int r = 0; r < R; ++r)
#pragma unroll
            for (int j = 0; j < 8; ++j) hv[r][j] = __builtin_nontemporal_load((const f32x4*)(A.x + (size_t)(t0 + r) * DM + j * 256 + lane * 4));
        float am[R];
#pragma unroll
        for (int r = 0; r < R; ++r) am[r] = 0.f;
#pragma unroll
        for (int j = 0; j < 8; ++j) { const int c = j * 256 + lane * 4; const f32x4 s1 = *(const f32x4*)(sc + c) + 1.0f, s0 = *(const f32x4*)(sh + c);
#pragma unroll
            for (int r = 0; r < R; ++r) { hv[r][j] = hv[r][j] * s1 + s0; am[r] = fmaxf(am[r], fmaxf(fmaxf(fabsf(hv[r][j][0]), fabsf(hv[r][j][1])), fmaxf(fabsf(hv[r][j][2]), fabsf(hv[r][j][3])))); } }
#pragma unroll
        for (int r = 0; r < R; ++r) {
            am[r] = wave_max(am[r]);
            const float q = am[r] > 0.f ? 440.0f / am[r] : 1.0f;
            if (lane == 0) hsc[t0 + r] = am[r] > 0.f ? am[r] * (1.0f / 440.0f) : 1.0f;
#pragma unroll
            for (int j = 0; j < 8; ++j) { const int c = j * 256 + lane * 4; H8[((size_t)(t0 + r) * DM + c) >> 2] = pk4_fp8(hv[r][j][0] * q, hv[r][j][1] * q, hv[r][j][2] * q, hv[r][j][3] * q); } } }
    { const unsigned* wm = (const unsigned*)(A.ws + WS_CTL) + CW_WMAX;
      p1_w8(A.ws + WS_WIN, A.ws + WS_W8, 8192 * 2048 / 8, 440.0f / __uint_as_float(wm[0]), lane, gw, NGW);
      p1_w8(A.ws + WS_WKR, A.ws + WS_WKR8, 256 * 2048 / 8, 440.0f / __uint_as_float(wm[0]), lane, gw, NGW);
      p1_w8(A.ws + WS_WPA, A.ws + WS_WPA8, 2048 * 1024 / 8, 440.0f / __uint_as_float(wm[1]), lane, gw, NGW);
      p1_w8(A.ws + WS_WPB, A.ws + WS_WPB8, 2048 * 1024 / 8, 440.0f / __uint_as_float(wm[2]), lane, gw, NGW);
      p1_w8(A.ws + WS_WO, A.ws + WS_WO8, 2048 * 2048 / 8, 440.0f / __uint_as_float(wm[3]), lane, gw, NGW);
      p1_w8(A.ws + WS_WUQ, A.ws + WS_WUQ8, 1536 * 512 / 8, 440.0f / __uint_as_float(wm[4]), lane, gw, NGW);
      p1_w8(A.ws + WS_WUKV, A.ws + WS_WUKV8, 2048 * 512 / 8, 440.0f / __uint_as_float(wm[5]), lane, gw, NGW); }
}
__device__ __forceinline__ void p7_ln1(const Args& A, int lane, int gw, int NGW) {
    const float* mod = (const float*)(A.ws + WS_MOD); bf16* H = (bf16*)(A.ws + WS_H); float* st = (float*)(A.ws + WS_LN1);
    constexpr int R = 4;
    for (int t0 = gw * R; t0 < TOK; t0 += NGW * R) { const int b = t0 >> 12; const float* sh = mod + ((size_t)b * 6 + 3) * DM; const float* sc = sh + DM;
        f32x4 v[R][8];
#pragma unroll
        for (int r = 0; r < R; ++r)
#pragma unroll
            for (int j = 0; j < 8; ++j) { const v2u w = *(const v2u*)((const bf16*)(A.ws + WS_U1B) + (size_t)(t0 + r) * DM + j * 256 + lane * 4); v[r][j] = (f32x4){bflo(w.x), bfhi(w.x), bflo(w.y), bfhi(w.y)}; }
        float rstd[R], am[R];
#pragma unroll
        for (int r = 0; r < R; ++r) am[r] = 0.f;
#pragma unroll
        for (int r = 0; r < R; ++r) { float s = 0.f;
#pragma unroll
            for (int j = 0; j < 8; ++j) s += (v[r][j][0] + v[r][j][1]) + (v[r][j][2] + v[r][j][3]);
            const float mean = wave_sum(s) * (1.0f / DM); float q = 0.f;
#pragma unroll
            for (int j = 0; j < 8; ++j) { v[r][j] = v[r][j] - mean; q += (v[r][j][0] * v[r][j][0] + v[r][j][1] * v[r][j][1]) + (v[r][j][2] * v[r][j][2] + v[r][j][3] * v[r][j][3]); }
            rstd[r] = 1.0f / sqrtf(wave_sum(q) * (1.0f / DM) + LN_EPS);
            if (lane == 0) { st[(size_t)(t0 + r) * 2] = mean; st[(size_t)(t0 + r) * 2 + 1] = rstd[r]; } }
#pragma unroll
        for (int j = 0; j < 8; ++j) { const int c = j * 256 + lane * 4; const f32x4 g = *(const f32x4*)(A.ln1_g + c), bb = *(const f32x4*)(A.ln1_b + c), s1 = *(const f32x4*)(sc + c), s0 = *(const f32x4*)(sh + c);
#pragma unroll
            for (int r = 0; r < R; ++r) { const f32x4 x1 = v[r][j] * rstd[r] * g + bb; const f32x4 hv = x1 * (s1 + 1.0f) + s0; v2u o; o.x = pk2(hv[0], hv[1]); o.y = pk2(hv[2], hv[3]); *(v2u*)(H + (size_t)(t0 + r) * DM + c) = o;
                v[r][j] = hv; am[r] = fmaxf(am[r], fmaxf(fmaxf(fabsf(hv[0]), fabsf(hv[1])), fmaxf(fabsf(hv[2]), fabsf(hv[3])))); } }
#pragma unroll
        for (int r = 0; r < R; ++r) {
            am[r] = wave_max(am[r]);
            const float inv = am[r] > 0.f ? 119.0f / am[r] : 0.f; int ssum = 0;
#pragma unroll
            for (int j = 0; j < 8; ++j) { unsigned hh = 0u, ll = 0u;
#pragma unroll
                for (int m = 0; m < 4; ++m) { const int x8 = (int)rintf(v[r][j][m] * inv); const int lo = ((x8 + 8) & 15) - 8, hi = (x8 - lo) >> 4; ssum += x8; hh |= ((unsigned)hi & 15u) << (4 * m); ll |= ((unsigned)lo & 15u) << (4 * m); }
                *(unsigned short*)(A.ws + WS_XH + (size_t)(t0 + r) * 1024 + j * 128 + lane * 2) = (unsigned short)hh;
                *(unsigned short*)(A.ws + WS_XL + (size_t)(t0 + r) * 1024 + j * 128 + lane * 2) = (unsigned short)ll; }
            ssum = wave_sum_int(ssum);
            if (lane == 0) { ((float*)(A.ws + WS_SX))[t0 + r] = am[r] * (1.0f / 119.0f); ((int*)(A.ws + WS_S8))[t0 + r] = ssum; } } }
}


__device__ __forceinline__ float max2f(float a, float b) { float r; asm("v_max_f32_e32 %0, %1, %2" : "=v"(r) : "v"(a), "v"(b)); return r; }
__device__ __forceinline__ float min2f(float a, float b) { float r; asm("v_min_f32_e32 %0, %1, %2" : "=v"(r) : "v"(a), "v"(b)); return r; }
#define INS16(L, x) do { _Pragma("unroll") for (int k_ = 0; k_ < 16; ++k_) { const float h_ = max2f(L[k_], x); x = min2f(L[k_], x); L[k_] = h_; } } while (0)
__device__ __forceinline__ void topk16_128(const float* __restrict__ src, float (&L)[16]) {
#pragma unroll
    for (int k = 0; k < 16; ++k) L[k] = -INFINITY;
#pragma unroll 4
    for (int i = 0; i < 32; ++i) { const f32x4 v = *(const f32x4*)(src + 4 * i);
#pragma unroll
        for (int e = 0; e < 4; ++e) { float x = __uint_as_float((__float_as_uint(v[e]) & ~127u) | (unsigned)(4 * i + e)); INS16(L, x); } }
}
__device__ __forceinline__ float dot2bf(unsigned a, unsigned b, float acc) { return __builtin_amdgcn_fdot2_f32_bf16(__builtin_bit_cast(bf16x2_t, a), __builtin_bit_cast(bf16x2_t, b), acc, false); }
__device__ __forceinline__ float dot8(const v4u a, const v4u b, float acc) {
    const unsigned a0 = a[0], a1 = a[1], a2 = a[2], a3 = a[3], b0 = b[0], b1 = b[1], b2 = b[2], b3 = b[3];
    acc = dot2bf(a0, b0, acc); acc = dot2bf(a1, b1, acc); acc = dot2bf(a2, b2, acc); acc = dot2bf(a3, b3, acc);
    return acc;
}

constexpr int RB = 8;
typedef float f32x2g __attribute__((ext_vector_type(2)));
#define P9_LOAD(BUF, TAB, EV, L0) do { _Pragma("unroll") for (int i_ = 0; i_ < RB; ++i_) { const int id_ = __builtin_amdgcn_readlane((EV), (L0) + i_); \
        BUF[i_] = ((const v4u*)((TAB) + (size_t)id_ * 1024))[lane]; } } while (0)
__device__ __forceinline__ float gelu_as(float v) {
    const float av = fabsf(v), t = __builtin_amdgcn_rcpf(av * 0.2316418882f + 1.0f);
    float q = t * 0.5307027145f + (-0.7265760135f); q = q * t + 0.7107068705f; q = q * t + (-0.142248368f); q = q * t + 0.127414796f; q = q * t;
    const float e = __builtin_amdgcn_exp2f((v * v) * (-0.72134752044f)); const float m = v * (q * e);
    return v < 0.f ? m : v - m;
}
typedef __bf16 bf16x2p __attribute__((ext_vector_type(2)));
__device__ __forceinline__ float p9_dot(const v4u d, const v2u (&xq)[8]) {
    float s0 = 0.f, s1 = 0.f;
#pragma unroll
    for (int k = 0; k < 4; ++k) { const unsigned w = d[k]; const unsigned x0 = xq[2 * k][0], x1 = xq[2 * k][1], x2 = xq[2 * k + 1][0], x3 = xq[2 * k + 1][1];
        s0 = __builtin_amdgcn_fdot2_f32_bf16(__builtin_amdgcn_cvt_scalef32_pk_bf16_fp4(w, 1.0f, 0), __builtin_bit_cast(bf16x2p, x0), s0, false);
        s1 = __builtin_amdgcn_fdot2_f32_bf16(__builtin_amdgcn_cvt_scalef32_pk_bf16_fp4(w, 1.0f, 1), __builtin_bit_cast(bf16x2p, x1), s1, false);
        s0 = __builtin_amdgcn_fdot2_f32_bf16(__builtin_amdgcn_cvt_scalef32_pk_bf16_fp4(w, 1.0f, 2), __builtin_bit_cast(bf16x2p, x2), s0, false);
        s1 = __builtin_amdgcn_fdot2_f32_bf16(__builtin_amdgcn_cvt_scalef32_pk_bf16_fp4(w, 1.0f, 3), __builtin_bit_cast(bf16x2p, x3), s1, false); }
    return s0 + s1;
}
__device__ __forceinline__ void p9_axpy(const v4u d, float wgt, f32x2g (&acc)[16]) {
    const f32x2g w2 = {wgt, wgt};
#pragma unroll
    for (int k = 0; k < 4; ++k) { const unsigned w = d[k];
        acc[4 * k]     = __builtin_elementwise_fma(__builtin_amdgcn_cvt_scalef32_pk_f32_fp4(w, 1.0f, 0), w2, acc[4 * k]);
        acc[4 * k + 1] = __builtin_elementwise_fma(__builtin_amdgcn_cvt_scalef32_pk_f32_fp4(w, 1.0f, 1), w2, acc[4 * k + 1]);
        acc[4 * k + 2] = __builtin_elementwise_fma(__builtin_amdgcn_cvt_scalef32_pk_f32_fp4(w, 1.0f, 2), w2, acc[4 * k + 2]);
        acc[4 * k + 3] = __builtin_elementwise_fma(__builtin_amdgcn_cvt_scalef32_pk_f32_fp4(w, 1.0f, 3), w2, acc[4 * k + 3]); }
}
__device__ __forceinline__ float p9_reduce8(const float (&p)[8], int lane) {
    const bool b5 = (lane & 32) != 0, b4 = (lane & 16) != 0, b3 = (lane & 8) != 0; float r[4], s[2];
#pragma unroll
    for (int k = 0; k < 4; ++k) { const float keep = b5 ? p[k + 4] : p[k], send = b5 ? p[k] : p[k + 4]; r[k] = keep + __shfl_xor(send, 32); }
#pragma unroll
    for (int k = 0; k < 2; ++k) { const float keep = b4 ? r[k + 2] : r[k], send = b4 ? r[k] : r[k + 2]; s[k] = keep + __shfl_xor(send, 16); }
    float t; { const float keep = b3 ? s[1] : s[0], send = b3 ? s[0] : s[1]; t = keep + __shfl_xor(send, 8); }
    t += __shfl_xor(t, 4); t += __shfl_xor(t, 2); t += __shfl_xor(t, 1);
    return t;
}
__device__ __forceinline__ void p9a_topk(const Args& A, int lane_in, int gw, int NGW) {
    unsigned char* ws = A.ws; const float* SC = (const float*)(ws + WS_SCORE);
    for (int task = gw; task < TOK / 8; task += NGW) {
        int lane = lane_in; asm volatile("" : "+v"(lane));
        const int tl = lane >> 3, hd = lane & 7; const float* srow = SC + (size_t)(task * 8 + tl) * 2048 + hd * 256;
        float L0[16], L1[16], R[16];
        topk16_128(srow, L0); topk16_128(srow + 128, L1);
#pragma unroll
        for (int k = 0; k < 16; ++k) R[k] = -INFINITY;
#pragma unroll
        for (int i = 0; i < 16; ++i)
#pragma unroll
            for (int j = 0; j < 16; ++j) if ((i + 1) * (j + 1) <= 16) { float x = __uint_as_float((__float_as_uint(L0[i] + L1[j]) & ~255u) | (unsigned)(i * 16 + j)); INS16(R, x); __builtin_amdgcn_sched_barrier(0); }
        const float mx = __uint_as_float(__float_as_uint(R[0]) & ~255u); float ex[16], es = 0.f;
#pragma unroll
        for (int r = 0; r < 16; ++r) { ex[r] = __expf(__uint_as_float(__float_as_uint(R[r]) & ~255u) - mx); es += ex[r]; }
        const float inv = 1.0f / es;
        unsigned idp[8];
#pragma unroll
        for (int r = 0; r < 16; ++r) { const unsigned code = __float_as_uint(R[r]) & 255u, ci = code >> 4, cj = code & 15u; unsigned e1 = 0u, e2 = 0u;
#pragma unroll
            for (int k = 0; k < 16; ++k) { e1 = (ci == (unsigned)k) ? (__float_as_uint(L0[k]) & 127u) : e1; e2 = (cj == (unsigned)k) ? (__float_as_uint(L1[k]) & 127u) : e2; }
            const unsigned e = e1 * 128u + e2; if (r & 1) idp[r >> 1] |= e << 16; else idp[r >> 1] = e; ex[r] *= inv; __builtin_amdgcn_sched_barrier(0); }
        const size_t slot0 = (size_t)(task * 8 + tl) * 128 + hd * 16;
        v4u* ip = (v4u*)(ws + WS_IDS + slot0 * 2); ip[0] = (v4u){idp[0], idp[1], idp[2], idp[3]}; ip[1] = (v4u){idp[4], idp[5], idp[6], idp[7]};
        { unsigned* tp = (unsigned*)(ws + WS_IDT + (size_t)(task * 8 + tl) * 256 + hd * 4);
#pragma unroll
          for (int g = 0; g < 8; ++g) { const unsigned lo = (idp[g >> 1] >> (16 * (g & 1))) & 0xffffu, hi = (idp[4 + (g >> 1)] >> (16 * (g & 1))) & 0xffffu; tp[g * 8] = lo | (hi << 16); } }
        f32x4* gp = (f32x4*)(ws + WS_GATES + slot0 * 4);
#pragma unroll
        for (int k = 0; k < 4; ++k) gp[k] = (f32x4){ex[4 * k], ex[4 * k + 1], ex[4 * k + 2], ex[4 * k + 3]};
    }
}

typedef int v2i __attribute__((ext_vector_type(2)));
__device__ __forceinline__ int dpp_add8(int v) {
    v += __builtin_amdgcn_update_dpp(0, v, 0xB1, 0xF, 0xF, true);
    v += __builtin_amdgcn_update_dpp(0, v, 0x4E, 0xF, 0xF, true);
    v += __builtin_amdgcn_update_dpp(0, v, 0x141, 0xF, 0xF, true);
    return v;
}
#define P10_IDS(IDW, JP) __builtin_amdgcn_ds_swizzle((int)(IDW), 0x18 | ((JP) << 5))
#define P10_LOAD1(BUF, IDW, HALF, JP) do { const unsigned pr_ = (unsigned)P10_IDS(IDW, (HALF) * 4 + (JP)); \
        BUF[2 * (JP)] = *(const v4u*)(UTx + ((pr_ & 0xffffu) * 128u + s16)); BUF[2 * (JP) + 1] = *(const v4u*)(UTx + ((pr_ >> 16) * 128u + s16)); } while (0)
#define P10_LOAD(BUF, IDW, HALF) do { P10_LOAD1(BUF, IDW, HALF, 0); P10_LOAD1(BUF, IDW, HALF, 1); P10_LOAD1(BUF, IDW, HALF, 2); P10_LOAD1(BUF, IDW, HALF, 3); } while (0)
#define P10_DOTS(BUF, HALF) do { _Pragma("unroll") for (int i_ = 0; i_ < 8; ++i_) { int d1_ = 0, d2_ = 0; \
        _Pragma("unroll") for (int k_ = 0; k_ < 4; ++k_) { d1_ = __builtin_amdgcn_sdot8((int)BUF[i_][k_], (int)xh[k_], d1_, false); d2_ = __builtin_amdgcn_sdot8((int)BUF[i_][k_], (int)xl[k_], d2_, false); } \
        res[(HALF) * 8 + i_] = dpp_add8(d1_ * 16 + d2_); } } while (0)
__device__ __forceinline__ void p10_udot(const Args& A, int lane_in, int wave, int bx, int G) {
    unsigned char* ws = A.ws;
    const int x = bx & 7, nblk = (G - x + 7) >> 3, stride = nblk * NWAVES;
    const unsigned char* UTx = ws + WS_UT + (size_t)x * UT_SLICE;
    int lane = lane_in; asm volatile("" : "+v"(lane));
    const unsigned s16 = (unsigned)(lane & 7) * 16u;
    const unsigned* IDS32 = (const unsigned*)(ws + WS_IDS);
    int* PA = (int*)(ws + WS_PA) + (size_t)x * TOK * 128;
    int t = (bx >> 3) * NWAVES + wave; if (t >= TOK) return;
    v4u bufA[8], bufB[8];
    unsigned idw = IDS32[(size_t)t * 64 + lane];
    v4u xh = *(const v4u*)(ws + WS_XH + (size_t)t * 1024 + x * 128 + s16), xl = *(const v4u*)(ws + WS_XL + (size_t)t * 1024 + x * 128 + s16);
    P10_LOAD(bufA, idw, 0); P10_LOAD(bufB, idw, 1);
#pragma unroll 1
    for (;;) {
        const int tn = t + stride; const bool more = tn < TOK;
        unsigned idwn = 0u; v4u xhn = xh, xln = xl;
        if (more) { idwn = IDS32[(size_t)tn * 64 + lane]; xhn = *(const v4u*)(ws + WS_XH + (size_t)tn * 1024 + x * 128 + s16); xln = *(const v4u*)(ws + WS_XL + (size_t)tn * 1024 + x * 128 + s16); }
        int res[16];
        P10_DOTS(bufA, 0);
        if (more) P10_LOAD(bufA, idwn, 0);
        P10_DOTS(bufB, 1);
        if (more) P10_LOAD(bufB, idwn, 1);
        int r0 = res[0], r1 = res[1];
#pragma unroll
        for (int k = 1; k < 8; ++k) { const bool m = (lane & 7) == k; r0 = m ? res[2 * k] : r0; r1 = m ? res[2 * k + 1] : r1; }
        *(v2i*)(PA + (size_t)t * 128 + 2 * lane) = (v2i){r0, r1};
        if (!more) break;
        t = tn; idw = idwn; xh = xhn; xl = xln;
    }
}
#undef P10_IDS
#undef P10_LOAD
#undef P10_LOAD1
#undef P10_DOTS

__device__ __forceinline__ void p11_w(const Args& A, int lane, int gw, int NGW) {
    unsigned char* ws = A.ws; const unsigned* IDS32 = (const unsigned*)(ws + WS_IDS); const int* PA = (const int*)(ws + WS_PA);
    const float* SU = (const float*)(ws + WS_TSCALE); const float* SV = SU + 16384; const float* SX = (const float*)(ws + WS_SX); const int* S8 = (const int*)(ws + WS_S8);
    for (int t = gw; t < TOK; t += NGW) {
        const unsigned idw = IDS32[(size_t)t * 64 + lane]; const int id0 = (int)(idw & 0xffffu), id1 = (int)(idw >> 16);
        int s0 = 0, s1 = 0;
#pragma unroll
        for (int x = 0; x < 8; ++x) { const v2i p = *(const v2i*)(PA + ((size_t)x * TOK + t) * 128 + 2 * lane); s0 += p.x; s1 += p.y; }
        const float sxt = SX[t], half = 0.5f * (float)S8[t];
        const float a0 = SU[id0] * sxt * ((float)s0 + half), a1 = SU[id1] * sxt * ((float)s1 + half);
        const f32x2g gt = *(const f32x2g*)(ws + WS_GATES + ((size_t)t * 128 + 2 * lane) * 4);
        f32x2g w; w.x = gt.x * SV[id0] * gelu_as(a0); w.y = gt.y * SV[id1] * gelu_as(a1);
        float am = fmaxf(fabsf(w.x), fabsf(w.y));
        am = wave_max(am);
        const float sc = am > 0.f ? 224.0f / am : 0.f;
        const int ph = __builtin_amdgcn_cvt_pk_fp8_f32(w.x * sc, w.y * sc, 0, false); const f32x2g bk = __builtin_amdgcn_cvt_pk_f32_fp8(ph, false);
        const int pl = __builtin_amdgcn_cvt_pk_fp8_f32(w.x * sc - bk.x, w.y * sc - bk.y, 0, false);
        *(unsigned short*)(ws + WS_W + (size_t)t * 256 + 2 * lane) = (unsigned short)(ph & 0xffff); *(unsigned short*)(ws + WS_W + (size_t)t * 256 + 128 + 2 * lane) = (unsigned short)(pl & 0xffff);
        if (lane == 0) ((float*)(ws + WS_WSC))[t] = am > 0.f ? am * (1.0f / 224.0f) : 0.f;
    }
}

typedef int i32x8v __attribute__((ext_vector_type(8)));
#define P12_TRRD(dst, ad, off) asm volatile("ds_read_b64_tr_b4 %0, %1 offset:%2" : "=&v"(dst) : "v"(ad), "i"(off) : "memory")
#define P12_DMA(IA, IB) do { _Pragma("unroll") for (int q_ = 0; q_ < 16; ++q_) { const unsigned wd_ = (q_ < 8) ? IA[(q_ & 7) >> 1] : IB[(q_ & 7) >> 1]; const unsigned id_ = (q_ & 1) ? (wd_ >> 16) : (wd_ & 0xffffu); \
        __builtin_amdgcn_global_load_lds((const unsigned*)(VTx + (id_ * 128u + ((q_ & 1) ? cs_odd : cs_even))), (LAS unsigned*)(ldsp + q_ * 1024), 16, 0, 0); } } while (0)
#define P12_RD(J, R) do { \
        P12_TRRD(R[0], tra[(J) >> 1], 8 * ((J) & 1)); P12_TRRD(R[1], tra[(J) >> 1], 2048 + 8 * ((J) & 1)); \
        P12_TRRD(R[2], tra[2 + ((J) >> 1)], 8 * ((J) & 1)); P12_TRRD(R[3], tra[2 + ((J) >> 1)], 2048 + 8 * ((J) & 1)); \
        P12_TRRD(R[4], tra[4 + ((J) >> 1)], 8 * ((J) & 1)); P12_TRRD(R[5], tra[4 + ((J) >> 1)], 2048 + 8 * ((J) & 1)); \
        P12_TRRD(R[6], tra[6 + ((J) >> 1)], 8 * ((J) & 1)); P12_TRRD(R[7], tra[6 + ((J) >> 1)], 2048 + 8 * ((J) & 1)); } while (0)
#define P12_MF1(I, R, W) do { asm volatile("s_waitcnt lgkmcnt(" #W ")" : "+v"(R[2 * (I)]), "+v"(R[2 * (I) + 1])); \
        acc[I] = __builtin_amdgcn_mfma_scale_f32_16x16x128_f8f6f4(aj_, (i32x8v){(int)R[2 * (I)][0], (int)R[2 * (I)][1], (int)R[2 * (I) + 1][0], (int)R[2 * (I) + 1][1], 0, 0, 0, 0}, acc[I], 0, 4, 0, 0x7f7f7f7f, 0, 0x7f7f7f7f); } while (0)
#define P12_AJ(J) do { const bool on_ = avalid && (jl == (J)); aj_[0] = on_ ? (int)a0[0] : 0; aj_[1] = on_ ? (int)a0[1] : 0; aj_[2] = on_ ? (int)a0[2] : 0; aj_[3] = on_ ? (int)a0[3] : 0; \
        aj_[4] = on_ ? (int)a1[0] : 0; aj_[5] = on_ ? (int)a1[1] : 0; aj_[6] = on_ ? (int)a1[2] : 0; aj_[7] = on_ ? (int)a1[3] : 0; } while (0)
#define P12_MMA() do { v2u ra_[8], rb_[8], rc_[8]; i32x8v aj_; \
        P12_RD(0, ra_); P12_RD(1, rb_); \
        P12_AJ(0); P12_MF1(0, ra_, 14); P12_MF1(1, ra_, 12); P12_MF1(2, ra_, 10); P12_MF1(3, ra_, 8); \
        P12_RD(2, rc_); \
        P12_AJ(1); P12_MF1(0, rb_, 14); P12_MF1(1, rb_, 12); P12_MF1(2, rb_, 10); P12_MF1(3, rb_, 8); \
        P12_RD(3, ra_); \
        P12_AJ(2); P12_MF1(0, rc_, 14); P12_MF1(1, rc_, 12); P12_MF1(2, rc_, 10); P12_MF1(3, rc_, 8); \
        P12_AJ(3); P12_MF1(0, ra_, 6); P12_MF1(1, ra_, 4); P12_MF1(2, ra_, 2); P12_MF1(3, ra_, 0); } while (0)
__device__ __forceinline__ float wave_sum_dpp(float v) {
    v += __int_as_float(__builtin_amdgcn_update_dpp(0, __float_as_int(v), 0xB1, 0xF, 0xF, true));
    v += __int_as_float(__builtin_amdgcn_update_dpp(0, __float_as_int(v), 0x4E, 0xF, 0xF, true));
    v += __int_as_float(__builtin_amdgcn_update_dpp(0, __float_as_int(v), 0x141, 0xF, 0xF, true));
    v += __int_as_float(__builtin_amdgcn_update_dpp(0, __float_as_int(v), 0x140, 0xF, 0xF, true));
    { const auto r = __builtin_amdgcn_permlane16_swap(__float_as_uint(v), __float_as_uint(v), false, false); v = __uint_as_float(r[0]) + __uint_as_float(r[1]); }
    { const auto r = __builtin_amdgcn_permlane32_swap(__float_as_uint(v), __float_as_uint(v), false, false); v = __uint_as_float(r[0]) + __uint_as_float(r[1]); }
    return v;
}
__device__ __forceinline__ void p12_vslice(const Args& A, LAS unsigned char* lds, int lane_in, int wave, int bx, int G) {
    unsigned char* ws = A.ws;
    const int x = bx & 7, nblk = (G - x + 7) >> 3, stride = nblk * NWAVES;
    const unsigned char* VTx = ws + WS_VT + (size_t)x * UT_SLICE;
    int lane = lane_in; asm volatile("" : "+v"(lane));
    LAS unsigned char* ldsp = lds + wave * 16384;
    const int gq = lane >> 3, sq = lane & 7;
    const unsigned cs_even = 16u * (unsigned)(sq ^ (gq >> 1)), cs_odd = 16u * (unsigned)(sq ^ (4 + (gq >> 1)));
    const unsigned idoff = (unsigned)gq * 32u;
    const int i16 = lane & 15, kq = lane >> 4;
    unsigned tra[8];
    { const unsigned rowb = (unsigned)(uintptr_t)ldsp + (unsigned)(32 * kq + i16) * 128u, sw = (unsigned)(i16 >> 1) & 7u;
#pragma unroll
      for (int c = 0; c < 8; ++c) tra[c] = rowb + (((unsigned)c ^ sw) << 4); }
    const bool avalid = (i16 & 3) < 2; const int jl = i16 >> 2;
    const unsigned aoff = (unsigned)(i16 & 1) * 128u + (unsigned)kq * 16u;
    const unsigned char* IDT = ws + WS_IDT; const unsigned char* WQ8 = ws + WS_W; const float* WSC = (const float*)(ws + WS_WSC);
    const float* st1 = (const float*)(ws + WS_LN1); const float* mod = (const float*)(ws + WS_MOD); const bf16* U1B = (const bf16*)(ws + WS_U1B); bf16* U2 = (bf16*)(ws + WS_H);
    f32x2g* ST2 = (f32x2g*)(ws + WS_ST2) + (size_t)x * TOK;
    const int c0 = x * 256 + lane;
    float g1[4], b1[4];
#pragma unroll
    for (int i = 0; i < 4; ++i) { g1[i] = A.ln1_g[c0 + 64 * i]; b1[i] = A.ln1_b[c0 + 64 * i]; }
    int t = (bx >> 3) * NWAVES + wave; if (t >= TOK) return;
    v4u ia = *(const v4u*)(IDT + (size_t)t * 256 + idoff), ib = *(const v4u*)(IDT + (size_t)t * 256 + idoff + 16);
    const int t1_ = (t + stride < TOK) ? t + stride : t;
    v4u ia1 = *(const v4u*)(IDT + (size_t)t1_ * 256 + idoff), ib1 = *(const v4u*)(IDT + (size_t)t1_ * 256 + idoff + 16);
    v4u a0 = *(const v4u*)(WQ8 + (size_t)t * 256 + aoff), a1 = *(const v4u*)(WQ8 + (size_t)t * 256 + aoff + 64);
    unsigned uh[4]; float gg[4];
#pragma unroll
    for (int i = 0; i < 4; ++i) { uh[i] = (unsigned)U1B[(size_t)t * DM + c0 + 64 * i]; gg[i] = mod[((size_t)(t >> 12) * 6 + 5) * DM + c0 + 64 * i]; }
    float mean1 = st1[(size_t)t * 2], rstd1 = st1[(size_t)t * 2 + 1], wsc = WSC[t];
    P12_DMA(ia, ib);
#pragma unroll 1
    for (;;) {
        const int tn = t + stride; const bool more = tn < TOK;
        asm volatile("s_waitcnt vmcnt(0)" ::: "memory"); __builtin_amdgcn_sched_barrier(0);
        v4u ia2 = ia1, ib2 = ib1, n0 = a0, n1 = a1; unsigned uhn[4]; float ggn[4], mean1n = mean1, rstd1n = rstd1, wscn = wsc;
        if (tn + stride < TOK) { ia2 = *(const v4u*)(IDT + (size_t)(tn + stride) * 256 + idoff); ib2 = *(const v4u*)(IDT + (size_t)(tn + stride) * 256 + idoff + 16); }
#pragma unroll
        for (int i = 0; i < 4; ++i) { uhn[i] = uh[i]; ggn[i] = gg[i]; }
        if (more) { n0 = *(const v4u*)(WQ8 + (size_t)tn * 256 + aoff); n1 = *(const v4u*)(WQ8 + (size_t)tn * 256 + aoff + 64);
#pragma unroll
                    for (int i = 0; i < 4; ++i) { uhn[i] = (unsigned)U1B[(size_t)tn * DM + c0 + 64 * i]; ggn[i] = mod[((size_t)(tn >> 12) * 6 + 5) * DM + c0 + 64 * i]; }
                    mean1n = st1[(size_t)tn * 2]; rstd1n = st1[(size_t)tn * 2 + 1]; wscn = WSC[tn]; }
        f32x4 acc[4];
#pragma unroll
        for (int i = 0; i < 4; ++i) acc[i] = (f32x4){0.f, 0.f, 0.f, 0.f};
        __builtin_amdgcn_sched_barrier(0);
        P12_MMA();
        __builtin_amdgcn_sched_barrier(0);
        if (more) P12_DMA(ia1, ib1);
        __builtin_amdgcn_sched_barrier(0);
        float s1 = 0.f, s2 = 0.f;
#pragma unroll
        for (int i = 0; i < 4; ++i) { const float p = (acc[i][0] + acc[i][1]) * wsc; const float u = __uint_as_float(uh[i] << 16);
            const float x1 = (u - mean1) * rstd1 * g1[i] + b1[i]; const float u2 = DN_ALPHA * x1 + gg[i] * p; s1 += u2; s2 += u2 * u2;
            U2[(size_t)t * DM + c0 + 64 * i] = (bf16)f2bf(u2); }
        s1 = wave_sum_dpp(s1); s2 = wave_sum_dpp(s2);
        if (lane == 0) ST2[t] = (f32x2g){s1, s2};
        if (!more) break;
        t = tn; ia1 = ia2; ib1 = ib2; a0 = n0; a1 = n1; mean1 = mean1n; rstd1 = rstd1n; wsc = wscn;
#pragma unroll
        for (int i = 0; i < 4; ++i) { uh[i] = uhn[i]; gg[i] = ggn[i]; }
    }
}
#undef P12_TRRD
#undef P12_DMA
#undef P12_MMA
#undef P12_RD
#undef P12_MF1
#undef P12_AJ

__device__ __forceinline__ void p13_ln2(const Args& A, int lane, int gw, int NGW) {
    unsigned char* ws = A.ws; const bf16* U2 = (const bf16*)(ws + WS_H); const f32x2g* ST2 = (const f32x2g*)(ws + WS_ST2);
    constexpr int R = 4;
    for (int t0 = gw * R; t0 < TOK; t0 += NGW * R) {
        v2u u[R][8]; float mean[R], rstd[R];
#pragma unroll
        for (int r = 0; r < R; ++r)
#pragma unroll
            for (int q = 0; q < 8; ++q) u[r][q] = *(const v2u*)(U2 + (size_t)(t0 + r) * DM + q * 256 + lane * 4);
#pragma unroll
        for (int r = 0; r < R; ++r) { float s1 = 0.f, s2 = 0.f;
#pragma unroll
            for (int x = 0; x < 8; ++x) { const f32x2g pp = ST2[(size_t)x * TOK + t0 + r]; s1 += pp.x; s2 += pp.y; }
            mean[r] = s1 * (1.0f / DM); const float var = fmaxf(s2 * (1.0f / DM) - mean[r] * mean[r], 0.f); rstd[r] = 1.0f / sqrtf(var + LN_EPS); }
#pragma unroll
        for (int q = 0; q < 8; ++q) { const int c = q * 256 + lane * 4; const f32x4 g = *(const f32x4*)(A.ln2_g + c), bb = *(const f32x4*)(A.ln2_b + c);
#pragma unroll
            for (int r = 0; r < R; ++r) { const f32x4 v = (f32x4){bflo(u[r][q].x), bfhi(u[r][q].x), bflo(u[r][q].y), bfhi(u[r][q].y)};
                __builtin_nontemporal_store((v - mean[r]) * rstd[r] * g + bb, (f32x4*)(A.out + (size_t)(t0 + r) * DM + c)); } }
    }
}


struct ArgsG {
    const GAS float *x, *c; const GAS int* positions;
    const GAS float *w_ada, *b_ada, *w_in, *b_in, *rel_bias, *q_norm_g, *kv_norm_g, *w_uq, *w_ukv, *w_pa, *w_pb, *w_o, *ln1_g, *ln1_b, *peer_wq, *peer_keys, *peer_u, *peer_v, *ln2_g, *ln2_b;
    GAS float* out; GAS unsigned char* ws; int ph_lo, ph_hi;
};
static_assert(sizeof(ArgsG) == sizeof(Args), "ArgsG mirrors Args");
#define CAS __attribute__((address_space(4)))
__device__ __forceinline__ Args load_args(const CAS ArgsG* p) {
    Args a;
    a.x = (const float*)p->x; a.c = (const float*)p->c; a.positions = (const int*)p->positions; a.w_ada = (const float*)p->w_ada; a.b_ada = (const float*)p->b_ada; a.w_in = (const float*)p->w_in; a.b_in = (const float*)p->b_in;
    a.rel_bias = (const float*)p->rel_bias; a.q_norm_g = (const float*)p->q_norm_g; a.kv_norm_g = (const float*)p->kv_norm_g; a.w_uq = (const float*)p->w_uq; a.w_ukv = (const float*)p->w_ukv; a.w_pa = (const float*)p->w_pa;
    a.w_pb = (const float*)p->w_pb; a.w_o = (const float*)p->w_o; a.ln1_g = (const float*)p->ln1_g; a.ln1_b = (const float*)p->ln1_b; a.peer_wq = (const float*)p->peer_wq; a.peer_keys = (const float*)p->peer_keys;
    a.peer_u = (const float*)p->peer_u; a.peer_v = (const float*)p->peer_v; a.ln2_g = (const float*)p->ln2_g; a.ln2_b = (const float*)p->ln2_b; a.out = (float*)p->out; a.ws = (unsigned char*)p->ws;
    a.ph_lo = p->ph_lo; a.ph_hi = p->ph_hi; return a;
}
__global__ void __launch_bounds__(NWAVES * 64, 2) fwd(Args A_) {
    extern __shared__ __attribute__((aligned(16))) unsigned char lds_raw[];
    LAS unsigned char* lds = (LAS unsigned char*)lds_raw;
    const CAS Args* Ap0 = (const CAS Args*)__builtin_amdgcn_kernarg_segment_ptr();
#define PHASE_ENV() const CAS Args* Ap = Ap0; asm volatile("" : "+s"(Ap)); const Args A = load_args((const CAS ArgsG*)Ap); \
    int wave = wave_s; asm volatile("" : "+s"(wave)); int lane; asm volatile("v_mbcnt_lo_u32_b32 %0, -1, 0\n\tv_mbcnt_hi_u32_b32 %0, -1, %0" : "=v"(lane)); const int tid = wave * 64 + lane; \
    const int G = gridDim.x, bx = blockIdx.x, vcu = (G % 8 == 0) ? (bx % 8) * (G / 8) + bx / 8 : bx, gw = vcu * NWAVES + wave, NGW = G * NWAVES; \
    unsigned char* const ws = A.ws; bf16* const H = (bf16*)(ws + WS_H); (void)lane; (void)gw; (void)NGW; (void)H; (void)vcu
    const int wave_s = __builtin_amdgcn_readfirstlane(threadIdx.x >> 6);
    for (int u = threadIdx.x; u < (LDS_BYTES - RING_BYTES) / 4; u += NWAVES * 64) ((LAS unsigned*)(lds + RING_BYTES))[u] = 0u;
    __syncthreads();
    const int lo = A_.ph_lo, hi = A_.ph_hi; const bool multi = (hi - lo) > 1;
    volatile LAS unsigned* MISC = (volatile LAS unsigned*)(lds + MISC_OFF);
    XcdBarrier bar; bar.bar = (unsigned*)(A_.ws + WS_CTL) + CW_BAR; bar.x = 0; bar.st = MISC + 8; bar.w0 = (wave_s == 0);
    if (multi) bar = xcd_barrier_post((unsigned*)(A_.ws + WS_CTL) + CW_BAR, MISC + 8, wave_s == 0);
#ifdef DBG_PHASE
#define IN(k) ((k) == DBG_PHASE)
#else
#define IN(k) (lo <= (k) && (k) < hi)
#endif
#define GRID_BAR(k) do { if (IN(k) && IN((k) + 1)) xcd_barrier(bar); } while (0)
    if (IN(0)) { { PHASE_ENV(); p0_prologue(A, lds, tid, lane, wave, vcu, G); } GRID_BAR(0); }
    if (IN(1)) { { PHASE_ENV(); p1_modulate(A, lane, gw, NGW); } GRID_BAR(1); }
    if (IN(2)) {
        { PHASE_ENV();
        pg8::Gemm g{(const bf16*)(ws + WS_H8), (const bf16*)(ws + WS_W8), TOK, 8192, 1024}; pg8::StaticOrder S; S.init(TOK, 8192, G, bx);
        pg8::EpiInProj E{(bf16*)(ws + WS_QKVA), (bf16*)(ws + WS_CQ), (bf16*)(ws + WS_CKV), (bf16*)A.out, (float*)(ws + WS_SSQ), (const float*)(ws + WS_BIAS), QSCALE_A, (const float*)(ws + WS_HSC), (const unsigned*)(ws + WS_CTL) + CW_WMAX};
        pg8::gemm_phase<pg8::EpiInProj, pg8::StaticOrder, true, true, true>(lds, g, S, E, tid); }
        GRID_BAR(2);
    }
    if (IN(3)) {
        {
        { PHASE_ENV(); pg8::Gemm g{(const bf16*)(ws + WS_CQ), (const bf16*)(ws + WS_WUQ8), TOK, 1536, 256}; pg8::StaticOrder S; S.init(TOK, 1536, G, bx);
          pg8::EpiQUp E{(bf16*)(ws + WS_QN), (bf16*)(ws + WS_QR), (const float*)(ws + WS_SSQ), (const float*)(ws + WS_CS), QSCALE_B, (const unsigned*)(ws + WS_CTL) + CW_WMAX + 4};
          pg8::gemm_phase<pg8::EpiQUp, pg8::StaticOrder, true, true, true>(lds, g, S, E, tid); }
        { PHASE_ENV(); pg8::Gemm g{(const bf16*)(ws + WS_CKV), (const bf16*)(ws + WS_WUKV8), TOK, 2048, 256}; pg8::StaticOrder S; S.init(TOK, 2048, G, bx);
          pg8::EpiKvUp E{(bf16*)(ws + WS_KN), (bf16*)(ws + WS_VB), (const float*)(ws + WS_SSQ) + (size_t)TOK * 8, (const unsigned*)(ws + WS_CTL) + CW_WMAX + 5};
          pg8::gemm_phase<pg8::EpiKvUp, pg8::StaticOrder, true, true, true>(lds, g, S, E, tid); }
        { PHASE_ENV(); pg8::Gemm g{(const bf16*)(ws + WS_H8), (const bf16*)(ws + WS_WKR8), TOK, 256, 1024}; pg8::StaticOrder S; S.init(TOK, 256, G, bx);
          pg8::EpiKr E{(bf16*)(ws + WS_KR), (const float*)(ws + WS_BIAS) + 8192, (const float*)(ws + WS_CS), (const float*)(ws + WS_HSC), (const unsigned*)(ws + WS_CTL) + CW_WMAX};
          pg8::gemm_phase<pg8::EpiKr, pg8::StaticOrder, true, true, true>(lds, g, S, E, tid); }
        { PHASE_ENV(); const bf16* Q = (const bf16*)(ws + WS_QKVA); const bf16* K = Q + (size_t)TOK * 1024; const bf16* V = K + (size_t)TOK * 1024;
          for (int u = vcu; u < 1024; u += G) { const int bh = u >> 4, qb = u & 15;
              att::attn_unit<0>(lds, bh >> 3, bh & 7, qb, Q, nullptr, K, nullptr, V, (bf16*)(ws + WS_YA), A.rel_bias + (bh & 7) * 320, tid); } }
        }
        GRID_BAR(3);
    }
    if (IN(4)) {
        {
        { PHASE_ENV();
        for (int s2 = 0; vcu + G * (s2 >> 1) < 512; ++s2) { const int it = vcu + G * (s2 >> 1), bh = it >> 3, x = it & 7, qb = (s2 & 1) ? 15 - x : x;
            att::attn_unit<1>(lds, bh >> 3, bh & 7, qb, (const bf16*)(ws + WS_QN), (const bf16*)(ws + WS_QR), (const bf16*)(ws + WS_KN), (const bf16*)(ws + WS_KR), (const bf16*)(ws + WS_VB), (bf16*)(ws + WS_YB), nullptr, tid); } }
        { PHASE_ENV(); pg8::Gemm g{(const bf16*)(ws + WS_YA), (const bf16*)(ws + WS_WPA8), TOK, 2048, 512}; pg8::StaticOrder S; S.init(TOK, 2048, G, bx);
          pg8::EpiGate<0> E{(unsigned char*)H, (const unsigned char*)A.out, nullptr, (const unsigned*)(ws + WS_CTL) + CW_WMAX + 1, ACT_MIX / ACT_Y};
          pg8::gemm_phase<pg8::EpiGate<0>, pg8::StaticOrder, true, true, true>(lds, g, S, E, tid); }
        }
        GRID_BAR(4);
    }
    if (IN(5)) {
        { PHASE_ENV(); pg8::Gemm g{(const bf16*)(ws + WS_YB), (const bf16*)(ws + WS_WPB8), TOK, 2048, 512}; pg8::StaticOrder S; S.init(TOK, 2048, G, bx);
        pg8::EpiGate<1> E{(unsigned char*)H, (const unsigned char*)A.out, ws + WS_H8, (const unsigned*)(ws + WS_CTL) + CW_WMAX + 2, ACT_MIX / ACT_Y};
        pg8::gemm_phase<pg8::EpiGate<1>, pg8::StaticOrder, true, true, true>(lds, g, S, E, tid); }
        GRID_BAR(5);
    }
    if (IN(6)) {
        { PHASE_ENV(); pg8::Gemm g{(const bf16*)(ws + WS_H8), (const bf16*)(ws + WS_WO8), TOK, 2048, 1024}; pg8::StaticOrder S; S.init(TOK, 2048, G, bx);
        pg8::EpiWo E{A.x, (bf16*)(ws + WS_U1B), (const float*)(ws + WS_MOD), DN_ALPHA, (const unsigned*)(ws + WS_CTL) + CW_WMAX + 3, 1.0f / ACT_MIX};
        pg8::gemm_phase<pg8::EpiWo, pg8::StaticOrder, true, true, true>(lds, g, S, E, tid); }
        GRID_BAR(6);
    }
    if (IN(7)) { { PHASE_ENV(); p7_ln1(A, lane, gw, NGW); } GRID_BAR(7); }
    if (IN(8)) {
        { PHASE_ENV(); pg8::Gemm g{H, (const bf16*)(ws + WS_WSK), TOK, 2048, 2048}; pg8::StaticOrder S; S.init(TOK, 2048, G, bx);
        pg8::EpiF32 E{(float*)(ws + WS_SCORE), 2048};
        pg8::gemm_phase<pg8::EpiF32, pg8::StaticOrder, true, true>(lds, g, S, E, tid); }
        GRID_BAR(8);
    }
    if (IN(9)) { { PHASE_ENV(); p9a_topk(A, lane, gw, NGW); } GRID_BAR(9); }
    if (IN(10)) { { PHASE_ENV(); p10_udot(A, lane, wave, bx, G); } GRID_BAR(10); }
    if (IN(11)) { { PHASE_ENV(); p11_w(A, lane, gw, NGW); } GRID_BAR(11); }
    if (IN(12)) { { PHASE_ENV(); p12_vslice(A, lds, lane, wave, bx, G); } GRID_BAR(12); }
    if (IN(13)) { PHASE_ENV(); p13_ln2(A, lane, gw, NGW); }
#undef IN
#undef GRID_BAR
#undef PHASE_ENV
}

#ifndef MK_ONE_LAUNCH
#define MK_ONE_LAUNCH 1
#endif
constexpr int N_PHASES = 14;
extern "C" void kernel_launch(void* const* d_in, const int* in_sizes, int n_in, void* d_out, int out_size, void* d_ws, size_t ws_size, hipStream_t stream) {
    static int grid = 0;
    if (grid == 0) {
        if (n_in != 23 || out_size != TOK * DM || ws_size < WS_END) { fprintf(stderr, "kernel_launch: unexpected shapes (n_in %d, out %d, ws %zu); nothing launched\n", n_in, out_size, ws_size); grid = -1; return; }
        int dev = 0, cus = 0, per_cu = 0;
        if (hipGetDevice(&dev) != hipSuccess || hipDeviceGetAttribute(&cus, hipDeviceAttributeMultiprocessorCount, dev) != hipSuccess) { grid = -1; return; }
        if (hipFuncSetAttribute((const void*)fwd, hipFuncAttributeMaxDynamicSharedMemorySize, LDS_BYTES) != hipSuccess) { fprintf(stderr, "kernel_launch: hipFuncSetAttribute failed\n"); grid = -1; return; }
        if (hipOccupancyMaxActiveBlocksPerMultiprocessor(&per_cu, (const void*)fwd, NWAVES * 64, LDS_BYTES) != hipSuccess || per_cu < 1) fprintf(stderr, "kernel_launch: occupancy query reports %d\n", per_cu);
        (void)hipGetLastError();
        grid = cus;
    }
    if (grid < 0) return;
    (void)hipMemsetAsync((char*)d_ws + WS_CTL, 0, CTL_ZERO_BYTES, stream);
    Args a{};
    a.x = (const float*)d_in[0]; a.c = (const float*)d_in[1]; a.positions = (const int*)d_in[2];
    a.w_ada = (const float*)d_in[3]; a.b_ada = (const float*)d_in[4]; a.w_in = (const float*)d_in[5]; a.b_in = (const float*)d_in[6]; a.rel_bias = (const float*)d_in[7];
    a.q_norm_g = (const float*)d_in[8]; a.kv_norm_g = (const float*)d_in[9]; a.w_uq = (const float*)d_in[10]; a.w_ukv = (const float*)d_in[11]; a.w_pa = (const float*)d_in[12];
    a.w_pb = (const float*)d_in[13]; a.w_o = (const float*)d_in[14]; a.ln1_g = (const float*)d_in[15]; a.ln1_b = (const float*)d_in[16]; a.peer_wq = (const float*)d_in[17];
    a.peer_keys = (const float*)d_in[18]; a.peer_u = (const float*)d_in[19]; a.peer_v = (const float*)d_in[20]; a.ln2_g = (const float*)d_in[21]; a.ln2_b = (const float*)d_in[22];
    a.out = (float*)d_out; a.ws = (unsigned char*)d_ws;
#if MK_ONE_LAUNCH
    a.ph_lo = 0; a.ph_hi = N_PHASES;
    hipLaunchKernelGGL(fwd, dim3(grid), dim3(NWAVES * 64), LDS_BYTES, stream, a);
#else
    for (int p = 0; p < N_PHASES; ++p) { a.ph_lo = p; a.ph_hi = p + 1; hipLaunchKernelGGL(fwd, dim3(grid), dim3(NWAVES * 64), LDS_BYTES, stream, a); }
#endif
}
```

```cpp
#include <hip/hip_runtime.h>
#include <cstdio>
#include <cstdint>
#include <cmath>
namespace pg8 {
#define PG8_LAS __attribute__((address_space(3)))
typedef unsigned short bf16_t;
typedef short bf16x8 __attribute__((ext_vector_type(8)));
typedef float f32x4 __attribute__((ext_vector_type(4)));
typedef unsigned u32x4 __attribute__((ext_vector_type(4)));
constexpr int BM = 256, BK = 64, HALF = 128, HTB = HALF * BK * 2  , STAGE_BYTES = 8 * HTB, NXCD = 8, WGM = 4;

__host__ __device__ __forceinline__ int lds_byte(int r, int c) { const int st = (r >> 4) * 2 + (c >> 5), rr = r & 15, cc = c & 31, ob = rr * 64 + cc * 2; return st * 1024 + (ob ^ (((ob >> 9) & 1) << 5)); }
__host__ __device__ __forceinline__ void stage_rc(int b, int& R, int& C) { const int st = b / 1024, sb = b % 1024, swz = sb ^ (((sb >> 9) & 1) << 5); R = (st >> 1) * 16 + swz / 64; C = (st & 1) * 32 + (swz % 64) / 2; }
__host__ __device__ __forceinline__ int perm32(int rho) { const int n = rho >> 4, i = rho & 15; return 8 * (i >> 2) + 4 * n + (i & 3); }

struct Unit { int pm, pn; };
struct Gemm { const bf16_t* A; const bf16_t* Bt; int M, N, K; };

struct StaticOrder {
    int nM, nN, nwg, G, c;
    __host__ __device__ void init(int M, int N, int G_, int c_) { nM = M / BM; nN = N / BM; nwg = nM * nN; G = G_; c = c_; }
    __host__ __device__ bool next(int i, Unit& u) const {
        const long L = (long)i * G + c; if (L >= nwg) return false;
        int wgid = (int)L; { const int q = nwg / NXCD, r = nwg % NXCD, xcd = wgid % NXCD, off = wgid / NXCD; wgid = (xcd < r ? xcd * (q + 1) : r * (q + 1) + (xcd - r) * q) + off; }
        const int nig = WGM * nN, gid = wgid / nig, fm = gid * WGM, gsz = (nM - fm) < WGM ? (nM - fm) : WGM;
        u.pm = fm + ((wgid % nig) % gsz); u.pn = (wgid % nig) / gsz; return true;
    }
    __device__ __forceinline__ void a_ready(const Unit&) const {}
    __device__ __forceinline__ void done(const Unit&) const {}
};

struct PickOrder {
    StaticOrder b; int pick;
    __host__ __device__ void init(int M, int N, int G_, int c_, int pick_) { b.init(M, N, G_, c_); pick = pick_; }
    __host__ __device__ bool next(int i, Unit& u) const { if (pick == -2) return b.next(i, u); if (i == 0 && pick >= 0) { u.pm = pick; u.pn = 0; return true; } return false; }
    __device__ __forceinline__ void a_ready(const Unit&) const {}
    __device__ __forceinline__ void done(const Unit&) const {}
};

typedef float f32x2c_t __attribute__((ext_vector_type(2))); typedef __bf16 bf16x2c_t __attribute__((ext_vector_type(2)));
__device__ __forceinline__ unsigned cvt_pk_bf16(float lo, float hi) { const f32x2c_t v = {lo, hi}; const bf16x2c_t b = __builtin_convertvector(v, bf16x2c_t); return __builtin_bit_cast(unsigned, b); }
typedef float f32x2 __attribute__((ext_vector_type(2)));

constexpr int TOK = 32768;
__device__ __forceinline__ u32x4 pack8(const f32x4& v0, const f32x4& v1) { u32x4 w; w.x = cvt_pk_bf16(v0[0], v0[1]); w.y = cvt_pk_bf16(v0[2], v0[3]); w.z = cvt_pk_bf16(v1[0], v1[1]); w.w = cvt_pk_bf16(v1[2], v1[3]); return w; }
__device__ __forceinline__ float bf_lo(unsigned w) { return __uint_as_float(w << 16); }
__device__ __forceinline__ float bf_hi(unsigned w) { return __uint_as_float(w & 0xffff0000u); }
__device__ __forceinline__ float sigmoidf_fast(float v) { return __builtin_amdgcn_rcpf(1.0f + __builtin_amdgcn_exp2f(-1.4426950408889634f * v)); }

__device__ __forceinline__ unsigned pk4f8(float a, float b, float c, float d) { int w = __builtin_amdgcn_cvt_pk_fp8_f32(a, b, 0, false); w = __builtin_amdgcn_cvt_pk_fp8_f32(c, d, w, true); return (unsigned)w; }
struct EpiF32 {
    static constexpr bool PERM = false, AFTER_DRAIN = false;
    float* C; int ldc;
    __device__ __forceinline__ void operator()(const f32x4 (&acc)[2][2][4][2], const Unit& u, int wr, int wc, int fr, int fq) const {
        const int row0 = u.pm * BM + wr * 64 + fr, col0 = u.pn * BM + wc * 32 + 4 * fq;
#pragma unroll
        for (int ai = 0; ai < 2; ++ai)
#pragma unroll
            for (int m = 0; m < 4; ++m) { float* rowp = C + (size_t)(row0 + ai * HALF + m * 16) * ldc + col0;
#pragma unroll
                for (int bj = 0; bj < 2; ++bj)
#pragma unroll
                    for (int n = 0; n < 2; ++n) *(f32x4*)(rowp + bj * HALF + n * 16) = acc[ai][bj][m][n]; }
    }
};
struct EpiBf16 {
    static constexpr bool PERM = true, AFTER_DRAIN = false;
    bf16_t* C; int ldc;
    __device__ __forceinline__ void operator()(const f32x4 (&acc)[2][2][4][2], const Unit& u, int wr, int wc, int fr, int fq) const {
        const int row0 = u.pm * BM + wr * 64 + fr, col0 = u.pn * BM + wc * 32 + 8 * fq;
#pragma unroll
        for (int ai = 0; ai < 2; ++ai)
#pragma unroll
            for (int m = 0; m < 4; ++m) { bf16_t* rowp = C + (size_t)(row0 + ai * HALF + m * 16) * ldc + col0;
#pragma unroll
                for (int bj = 0; bj < 2; ++bj) *(u32x4*)(rowp + bj * HALF) = pack8(acc[ai][bj][m][0], acc[ai][bj][m][1]); }
    }
};
struct EpiInProj {
    static constexpr bool PERM = true, AFTER_DRAIN = false;
    bf16_t* QKV;
    bf16_t* CQ; bf16_t* CKV;
    bf16_t* SG;
    float* SSQ;
    const float* bias;
    float qscale;
    const float* rowscale;
    const unsigned* wmaxbits;
    __device__ __forceinline__ void operator()(const f32x4 (&acc)[2][2][4][2], const Unit& u, int wr, int wc, int fr, int fq) const {
        const int row0 = u.pm * BM + wr * 64 + fr, cl = wc * 32 + 8 * fq, bcol0 = u.pn * BM + cl;
        f32x4 bv[2][2];
#pragma unroll
        for (int bj = 0; bj < 2; ++bj)
#pragma unroll
            for (int n = 0; n < 2; ++n) bv[bj][n] = *(const f32x4*)(bias + bcol0 + bj * HALF + 4 * n);
        const float wsc = __uint_as_float(*wmaxbits) * (1.0f / 440.0f); float rsc[2][4];
#pragma unroll
        for (int ai = 0; ai < 2; ++ai)
#pragma unroll
            for (int m = 0; m < 4; ++m) rsc[ai][m] = rowscale[row0 + ai * HALF + m * 16] * wsc;
        asm volatile("" :: "v"(bv[0][0]), "v"(bv[0][1]), "v"(bv[1][0]), "v"(bv[1][1]), "v"(rsc[0][0]), "v"(rsc[0][1]), "v"(rsc[0][2]), "v"(rsc[0][3]), "v"(rsc[1][0]), "v"(rsc[1][1]), "v"(rsc[1][2]), "v"(rsc[1][3]));
        if (u.pn < 12) {
            const int t = u.pn >> 2; bf16_t* base = QKV + (size_t)t * TOK * 1024 + (u.pn & 3) * 256 + cl; const float sc = (t == 0) ? qscale : 1.0f;
#pragma unroll
            for (int ai = 0; ai < 2; ++ai)
#pragma unroll
                for (int m = 0; m < 4; ++m) { bf16_t* rowp = base + (size_t)(row0 + ai * HALF + m * 16) * 1024;
#pragma unroll
                    for (int bj = 0; bj < 2; ++bj) { const f32x4 v0 = (acc[ai][bj][m][0] * rsc[ai][m] + bv[bj][0]) * sc, v1 = (acc[ai][bj][m][1] * rsc[ai][m] + bv[bj][1]) * sc; *(u32x4*)(rowp + bj * HALF) = pack8(v0, v1); } }
        } else if (u.pn < 16) {
            const int which = (u.pn - 12) >> 1, tl = (u.pn - 12) & 1; unsigned char* base = (unsigned char*)(which ? CKV : CQ) + tl * 256 + cl; float* sq = SSQ + (size_t)which * TOK * 8 + tl * 4 + wc;
#pragma unroll
            for (int ai = 0; ai < 2; ++ai)
#pragma unroll
                for (int m = 0; m < 4; ++m) { const int row = row0 + ai * HALF + m * 16; unsigned char* rowp = base + (size_t)row * 512; float ss = 0.f;
#pragma unroll
                    for (int bj = 0; bj < 2; ++bj) { const f32x4 v0 = acc[ai][bj][m][0] * rsc[ai][m] + bv[bj][0], v1 = acc[ai][bj][m][1] * rsc[ai][m] + bv[bj][1];
                        typedef unsigned u32x2c __attribute__((ext_vector_type(2))); u32x2c o; o.x = pk4f8(v0[0] * 16.0f, v0[1] * 16.0f, v0[2] * 16.0f, v0[3] * 16.0f); o.y = pk4f8(v1[0] * 16.0f, v1[1] * 16.0f, v1[2] * 16.0f, v1[3] * 16.0f);
                        *(u32x2c*)(rowp + bj * HALF) = o;
                        ss += (v0[0] * v0[0] + v0[1] * v0[1]) + (v0[2] * v0[2] + v0[3] * v0[3]) + (v1[0] * v1[0] + v1[1] * v1[1]) + (v1[2] * v1[2] + v1[3] * v1[3]); }
                    ss += __int_as_float(__builtin_amdgcn_ds_swizzle(__float_as_int(ss), 0x401F));
                    { auto rr_ = __builtin_amdgcn_permlane32_swap(__float_as_uint(ss), __float_as_uint(ss), false, false); ss = __uint_as_float(rr_[0]) + __uint_as_float(rr_[1]); }
                    if (fq == 0) sq[(size_t)row * 8] = ss; }
        } else {
            unsigned char* base = (unsigned char*)SG + (u.pn - 16) * 256 + cl;
#pragma unroll
            for (int ai = 0; ai < 2; ++ai)
#pragma unroll
                for (int m = 0; m < 4; ++m) { unsigned char* rowp = base + (size_t)(row0 + ai * HALF + m * 16) * 4096;
#pragma unroll
                    for (int bj = 0; bj < 2; ++bj) { f32x4 v0 = acc[ai][bj][m][0] * rsc[ai][m] + bv[bj][0], v1 = acc[ai][bj][m][1] * rsc[ai][m] + bv[bj][1];
#pragma unroll
                        for (int j = 0; j < 4; ++j) { v0[j] = sigmoidf_fast(v0[j]); v1[j] = sigmoidf_fast(v1[j]); }
                        typedef unsigned u32x2c __attribute__((ext_vector_type(2))); u32x2c o; o.x = pk4f8(v0[0], v0[1], v0[2], v0[3]); o.y = pk4f8(v1[0], v1[1], v1[2], v1[3]);
                        *(u32x2c*)(rowp + bj * HALF) = o; } }
        }
    }
};
__device__ __forceinline__ float row_rs(const float* ssq_row, float inv_n, float eps) {
    const f32x4 a = *(const f32x4*)ssq_row, b = *(const f32x4*)(ssq_row + 4);
    const float s = ((a[0] + a[1]) + (a[2] + a[3])) + ((b[0] + b[1]) + (b[2] + b[3]));
    return 1.0f / sqrtf(s * inv_n + eps);
}
__device__ __forceinline__ void rope8(f32x4& v0, f32x4& v1, const float* cs) {
    const f32x4 c0 = *(const f32x4*)cs, c1 = *(const f32x4*)(cs + 4);
    f32x4 o0, o1;
    o0[0] = v0[0] * c0[0] - v0[1] * c0[1]; o0[1] = v0[0] * c0[1] + v0[1] * c0[0]; o0[2] = v0[2] * c0[2] - v0[3] * c0[3]; o0[3] = v0[2] * c0[3] + v0[3] * c0[2];
    o1[0] = v1[0] * c1[0] - v1[1] * c1[1]; o1[1] = v1[0] * c1[1] + v1[1] * c1[0]; o1[2] = v1[2] * c1[2] - v1[3] * c1[3]; o1[3] = v1[2] * c1[3] + v1[3] * c1[2];
    v0 = o0; v1 = o1;
}
struct EpiQUp {
    static constexpr bool PERM = true, AFTER_DRAIN = false;
    bf16_t* Qn; bf16_t* Qr; const float* SSQ; const float* CS; float qscale; const unsigned* wmaxbits;
    __device__ __forceinline__ void operator()(const f32x4 (&acc)[2][2][4][2], const Unit& u, int wr, int wc, int fr, int fq) const {
        const int row0 = u.pm * BM + wr * 64 + fr, cl = wc * 32 + 8 * fq;
        float rs[2][4];
#pragma unroll
        for (int ai = 0; ai < 2; ++ai)
#pragma unroll
            for (int m = 0; m < 4; ++m) rs[ai][m] = row_rs(SSQ + (size_t)(row0 + ai * HALF + m * 16) * 8, 1.0f / 512.0f, 1e-6f) * (qscale * (1.0f / (440.0f * 16.0f)) * __uint_as_float(wmaxbits[fq >> 2]));
        asm volatile("" ::: "memory");
        if (u.pn < 4) {
#pragma unroll
            for (int ai = 0; ai < 2; ++ai)
#pragma unroll
                for (int m = 0; m < 4; ++m) { const int row = row0 + ai * HALF + m * 16; bf16_t* rowp = Qn + (size_t)row * 1024 + u.pn * 256 + cl;
#pragma unroll
                    for (int bj = 0; bj < 2; ++bj) *(u32x4*)(rowp + bj * HALF) = pack8(acc[ai][bj][m][0] * rs[ai][m], acc[ai][bj][m][1] * rs[ai][m]); }
        } else { const int rc = (u.pn - 4) * 256 + cl;
#pragma unroll
            for (int ai = 0; ai < 2; ++ai)
#pragma unroll
                for (int m = 0; m < 4; ++m) { const int row = row0 + ai * HALF + m * 16;
#pragma unroll
                    for (int bj = 0; bj < 2; ++bj) { const int c = rc + bj * HALF; f32x4 v0 = acc[ai][bj][m][0] * rs[ai][m], v1 = acc[ai][bj][m][1] * rs[ai][m];
                        rope8(v0, v1, (const float*)((const char*)CS + (unsigned)((row * 32 + ((c & 63) >> 1)) * 8))); *(u32x4*)((char*)Qr + (unsigned)((row * 512 + c) * 2)) = pack8(v0, v1); }
                    if (m & 1) asm volatile("" ::: "memory"); }
        }
    }
};
struct EpiKvUp {
    static constexpr bool PERM = true, AFTER_DRAIN = false;
    bf16_t* Kn; bf16_t* Vb; const float* SSQ; const unsigned* wmaxbits;
    __device__ __forceinline__ void operator()(const f32x4 (&acc)[2][2][4][2], const Unit& u, int wr, int wc, int fr, int fq) const {
        const int row0 = u.pm * BM + wr * 64 + fr, cl = wc * 32 + 8 * fq; bf16_t* base = (u.pn < 4 ? Kn : Vb) + (u.pn & 3) * 256 + cl;
        float rs[2][4];
#pragma unroll
        for (int ai = 0; ai < 2; ++ai)
#pragma unroll
            for (int m = 0; m < 4; ++m) rs[ai][m] = row_rs(SSQ + (size_t)(row0 + ai * HALF + m * 16) * 8, 1.0f / 512.0f, 1e-6f) * ((1.0f / (440.0f * 16.0f)) * __uint_as_float(*wmaxbits));
        asm volatile("" ::: "memory");
#pragma unroll
        for (int ai = 0; ai < 2; ++ai)
#pragma unroll
            for (int m = 0; m < 4; ++m) { const int row = row0 + ai * HALF + m * 16; bf16_t* rowp = base + (size_t)row * 1024;
#pragma unroll
                for (int bj = 0; bj < 2; ++bj) *(u32x4*)(rowp + bj * HALF) = pack8(acc[ai][bj][m][0] * rs[ai][m], acc[ai][bj][m][1] * rs[ai][m]); }
    }
};
struct EpiKr {
    static constexpr bool PERM = true, AFTER_DRAIN = false, NHALF = true;
    bf16_t* KR; const float* bias; const float* CS; const float* rowscale; const unsigned* wmaxbits;
    __device__ __forceinline__ void operator()(const f32x4 (&acc)[2][2][4][2], const Unit& u, int wr, int wc, int fr, int fq) const {
        if (wc >= 2) return;
        const int row0 = u.pm * BM + wr * 64 + fr, cl = wc * 32 + 8 * fq; const float wsc = __uint_as_float(*wmaxbits) * (1.0f / 440.0f);
        const f32x4 b0 = *(const f32x4*)(bias + cl), b1 = *(const f32x4*)(bias + cl + 4);
#pragma unroll
        for (int ai = 0; ai < 2; ++ai)
#pragma unroll
            for (int m = 0; m < 4; ++m) { const int row = row0 + ai * HALF + m * 16; const float rs = rowscale[row] * wsc; f32x4 v0 = acc[ai][0][m][0] * rs + b0, v1 = acc[ai][0][m][1] * rs + b1;
                rope8(v0, v1, CS + ((size_t)row * 32 + (cl >> 1)) * 2); *(u32x4*)(KR + (size_t)row * 64 + cl) = pack8(v0, v1);
                if (m & 1) asm volatile("" ::: "memory"); }
    }
};
__device__ __forceinline__ void unpk8f8(unsigned lo, unsigned hi, f32x4& a, f32x4& b) { typedef float f32x2u __attribute__((ext_vector_type(2)));
    const f32x2u p0 = __builtin_amdgcn_cvt_pk_f32_fp8((int)lo, false), p1 = __builtin_amdgcn_cvt_pk_f32_fp8((int)lo, true), p2 = __builtin_amdgcn_cvt_pk_f32_fp8((int)hi, false), p3 = __builtin_amdgcn_cvt_pk_f32_fp8((int)hi, true);
    a = (f32x4){p0[0], p0[1], p1[0], p1[1]}; b = (f32x4){p2[0], p2[1], p3[0], p3[1]}; }
template <int MODE> struct EpiGate {
    static constexpr bool PERM = true, AFTER_DRAIN = false;
    unsigned char* T8; const unsigned char* SG8; unsigned char* MIX8; const unsigned* wmaxbits; float actmul;
    __device__ __forceinline__ void operator()(const f32x4 (&acc)[2][2][4][2], const Unit& u, int wr, int wc, int fr, int fq) const {
        typedef unsigned u32x2e __attribute__((ext_vector_type(2)));
        const int row0 = u.pm * BM + wr * 64 + fr, col0 = u.pn * BM + wc * 32 + 8 * fq; const float sc = __uint_as_float(*wmaxbits) * (1.0f / 440.0f) * actmul;
#pragma unroll
        for (int ai = 0; ai < 2; ++ai)
#pragma unroll
            for (int m = 0; m < 4; ++m) { const int row = row0 + ai * HALF + m * 16;
#pragma unroll
                for (int bj = 0; bj < 2; ++bj) { const int c = col0 + bj * HALF; const u32x2e g = *(const u32x2e*)(SG8 + (size_t)row * 4096 + MODE * 2048 + c);
                    f32x4 g0, g1; unpk8f8(g.x, g.y, g0, g1);
                    f32x4 v0 = acc[ai][bj][m][0] * sc * g0, v1 = acc[ai][bj][m][1] * sc * g1;
                    if (MODE == 1) { const u32x2e t = *(const u32x2e*)(T8 + (size_t)row * 2048 + c); f32x4 t0, t1; unpk8f8(t.x, t.y, t0, t1); v0 = v0 + t0; v1 = v1 + t1; }
                    u32x2e o; o.x = pk4f8(v0[0], v0[1], v0[2], v0[3]); o.y = pk4f8(v1[0], v1[1], v1[2], v1[3]);
                    *(u32x2e*)((MODE == 0 ? T8 : MIX8) + (size_t)row * 2048 + c) = o; } }
    }
};
struct EpiWo {
    static constexpr bool PERM = true, AFTER_DRAIN = false;
    const float* X; bf16_t* U1; const float* MOD; float alpha; const unsigned* wmaxbits; float actinv;
    __device__ __forceinline__ void operator()(const f32x4 (&acc)[2][2][4][2], const Unit& u, int wr, int wc, int fr, int fq) const {
        const int row0 = u.pm * BM + wr * 64 + fr, col0 = u.pn * BM + wc * 32 + 8 * fq; const int b = (u.pm * BM) >> 12;
        f32x4 gv[2][2];
#pragma unroll
        for (int bj = 0; bj < 2; ++bj)
#pragma unroll
            for (int n = 0; n < 2; ++n) gv[bj][n] = *(const f32x4*)(MOD + ((size_t)b * 6 + 2) * 2048 + col0 + bj * HALF + n * 4) * (__uint_as_float(*wmaxbits) * (1.0f / 440.0f) * actinv);
        f32x4 xb[3][2][2];
#define WO_LD(G_) do { const size_t off_ = (size_t)(row0 + ((G_) >> 2) * HALF + ((G_) & 3) * 16) * 2048 + col0; \
            xb[(G_) % 3][0][0] = *(const f32x4*)(X + off_); xb[(G_) % 3][0][1] = *(const f32x4*)(X + off_ + 4); xb[(G_) % 3][1][0] = *(const f32x4*)(X + off_ + HALF); xb[(G_) % 3][1][1] = *(const f32x4*)(X + off_ + HALF + 4); } while (0)
        WO_LD(0); WO_LD(1);
#pragma unroll
        for (int g = 0; g < 8; ++g) { const int ai = g >> 2, m = g & 3; const size_t off = (size_t)(row0 + ai * HALF + m * 16) * 2048 + col0;
            if (g + 2 < 8) WO_LD(g + 2);
            asm volatile("" ::: "memory");
#pragma unroll
            for (int bj = 0; bj < 2; ++bj) {
                const f32x4 v0 = xb[g % 3][bj][0] * alpha + gv[bj][0] * acc[ai][bj][m][0], v1 = xb[g % 3][bj][1] * alpha + gv[bj][1] * acc[ai][bj][m][1];
                *(u32x4*)(U1 + off + bj * HALF) = pack8(v0, v1); }
            asm volatile("" ::: "memory"); }
#undef WO_LD
    }
};

__device__ __forceinline__ bf16x8 lds_rd16(const PG8_LAS bf16x8* __restrict__ p) { return *p; }
typedef int i32x4g __attribute__((ext_vector_type(4))); typedef int i32x8g __attribute__((ext_vector_type(8)));
template <class E, class = void> struct NHalfOf { static constexpr bool v = false; };
template <class E> struct NHalfOf<E, decltype((void)E::NHALF)> { static constexpr bool v = E::NHALF; };
template <class Epi, class Sched, bool ALIGN_EPI = false, bool SP2 = false, bool F8 = false>
__device__ __forceinline__ void gemm_phase(PG8_LAS unsigned char* lds, const Gemm g, const Sched& S, const Epi& E, const int tid) {
    const int wid = __builtin_amdgcn_readfirstlane(tid >> 6), lane = tid & 63, wr = wid >> 2, wc = wid & 3, fr = lane & 15, fq = lane >> 4;
    const int K = g.K, nt = K / BK;
    constexpr bool NH = NHalfOf<Epi>::v; static_assert(!NH || SP2, "NHALF is wired into the SP2 schedule only");
    unsigned voffA[2], voffB[2];
#pragma unroll
    for (int i = 0; i < 2; ++i) { int R, C; stage_rc(tid * 16 + i * 8192, R, C); const int Rb = Epi::PERM ? ((R & ~31) + perm32(R & 31)) : R;
        voffA[i] = (unsigned)(R * K + C) * 2u; voffB[i] = (unsigned)(Rb * K + C) * 2u; }
    const size_t kstep = (size_t)(BK * 2);
    const size_t hstep = (size_t)HALF * K * 2;
    const size_t tstep = 2 * hstep;
    const unsigned ldsbase_u = (unsigned)(size_t)lds;
    const unsigned ldsw = (unsigned)wid * 1024u;
    const int aoff = lds_byte(wr * 64 + fr, fq * 8), boff = lds_byte(wc * 32 + fr, fq * 8);
#define PG8_SA(b, h) (((b) * 2 + (h)) * HTB)
#define PG8_SB(b, h) ((4 + (b) * 2 + (h)) * HTB)
#define PG8_STAGE(bufoff, gbase, voff) do { _Pragma("unroll") for (int _i = 0; _i < 2; ++_i) { unsigned keep_; \
        asm volatile("s_mov_b32 %0, m0\n\ts_mov_b32 m0, %3\n\ts_nop 0\n\tglobal_load_lds_dwordx4 %1, %2\n\ts_mov_b32 m0, %0" \
                     : "=&s"(keep_) : "v"((voff)[_i]), "s"((const char*)(gbase)), "s"(ldsbase_u + (unsigned)(bufoff) + ldsw + (unsigned)(_i * 8192)) : "memory"); } } while (0)
#define PG8_LDA(dst, b, h) do { _Pragma("unroll") for (int m = 0; m < 4; ++m) _Pragma("unroll") for (int k = 0; k < 2; ++k) dst[m][k] = lds_rd16((const PG8_LAS bf16x8*)(lds + PG8_SA(b, h) + aoff + m * 2048 + k * 1024)); } while (0)
#define PG8_LDB(dst, b, h) do { _Pragma("unroll") for (int n = 0; n < 2; ++n) _Pragma("unroll") for (int k = 0; k < 2; ++k) dst[n][k] = lds_rd16((const PG8_LAS bf16x8*)(lds + PG8_SB(b, h) + boff + n * 2048 + k * 1024)); } while (0)
#define PG8_MMA(ai, bj, At, Bt) do { __builtin_amdgcn_s_setprio(1); _Pragma("unroll") for (int m = 0; m < 4; ++m) _Pragma("unroll") for (int n = 0; n < 2; ++n) { \
        if constexpr (F8) { const i32x8g a8_ = __builtin_shufflevector(__builtin_bit_cast(i32x4g, At[m][0]), __builtin_bit_cast(i32x4g, At[m][1]), 0, 1, 2, 3, 4, 5, 6, 7); \
                            const i32x8g b8_ = __builtin_shufflevector(__builtin_bit_cast(i32x4g, Bt[n][0]), __builtin_bit_cast(i32x4g, Bt[n][1]), 0, 1, 2, 3, 4, 5, 6, 7); \
                            acc[ai][bj][m][n] = __builtin_amdgcn_mfma_scale_f32_16x16x128_f8f6f4(b8_, a8_, acc[ai][bj][m][n], 0, 0, 0, 0x7f7f7f7f, 0, 0x7f7f7f7f); } \
        else { _Pragma("unroll") for (int k = 0; k < 2; ++k) acc[ai][bj][m][n] = __builtin_amdgcn_mfma_f32_16x16x32_bf16(Bt[n][k], At[m][k], acc[ai][bj][m][n], 0, 0, 0); } } \
        __builtin_amdgcn_s_setprio(0); } while (0)
#define PG8_WAIT_V(n) asm volatile("s_waitcnt vmcnt(" #n ")" ::: "memory")
#define PG8_WAIT_L(n) asm volatile("s_waitcnt lgkmcnt(" #n ")" ::: "memory")
#define PG8_BAR __builtin_amdgcn_s_barrier()
#define PG8_SCHED __builtin_amdgcn_sched_barrier(0)
    Unit cur, nxt; int ui = 0;
    if (!S.next(0, cur)) return;
    f32x4 acc[2][2][4][2];
#pragma unroll
    for (int a = 0; a < 2; ++a)
#pragma unroll
        for (int b = 0; b < 2; ++b)
#pragma unroll
            for (int m = 0; m < 4; ++m)
#pragma unroll
                for (int n = 0; n < 2; ++n) acc[a][b][m][n] = (f32x4){0.f, 0.f, 0.f, 0.f};
    bf16x8 At[4][2], B0[2][2], B1[2][2];
    const char* cA = (const char*)g.A + (size_t)cur.pm * tstep; const char* cB = (const char*)g.Bt + (size_t)cur.pn * tstep;
    S.a_ready(cur);
    if constexpr (SP2) {
        PG8_STAGE(PG8_SB(0, 0), cB, voffB); PG8_STAGE(PG8_SB(0, 1), cB + hstep, voffB); PG8_STAGE(PG8_SA(0, 0), cA, voffA); PG8_STAGE(PG8_SA(0, 1), cA + hstep, voffA);
        if (wr == 1) PG8_BAR;
        PG8_WAIT_V(2); PG8_BAR;
        PG8_STAGE(PG8_SB(1, 0), cB + kstep, voffB); PG8_STAGE(PG8_SA(1, 0), cA + kstep, voffA); PG8_STAGE(PG8_SB(1, 1), cB + hstep + kstep, voffB);
        PG8_WAIT_V(6); PG8_BAR;
    } else {
        PG8_STAGE(PG8_SB(0, 0), cB, voffB); PG8_STAGE(PG8_SA(0, 0), cA, voffA); PG8_STAGE(PG8_SB(0, 1), cB + hstep, voffB); PG8_STAGE(PG8_SA(0, 1), cA + hstep, voffA);
        if (wr == 1) PG8_BAR;
        PG8_WAIT_V(4); PG8_BAR;
        PG8_STAGE(PG8_SB(1, 0), cB + kstep, voffB); PG8_STAGE(PG8_SA(1, 0), cA + kstep, voffA); PG8_STAGE(PG8_SB(1, 1), cB + hstep + kstep, voffB);
        PG8_WAIT_V(6); PG8_BAR;
    }
    for (;;) {
        const bool has_next = S.next(ui + 1, nxt);
        const char* nA = has_next ? (const char*)g.A + (size_t)nxt.pm * tstep : cA; const char* nB = has_next ? (const char*)g.Bt + (size_t)nxt.pn * tstep : cB;
#pragma unroll 1
        for (int t = 0; t < nt; t += 2) {
            const bool last = (t == nt - 2);
            const char* a1 = cA + (size_t)(t + 1) * kstep;
            const char* a2 = last ? nA : cA + (size_t)(t + 2) * kstep; const char* b2 = last ? nB : cB + (size_t)(t + 2) * kstep;
            const char* a3 = a2 + kstep; const char* b3 = b2 + kstep;
            if (last && has_next) S.a_ready(nxt);
            if constexpr (SP2) {
            PG8_LDB(B0, 0, 0); if constexpr (!NH) PG8_LDB(B1, 0, 1); PG8_SCHED; PG8_LDA(At, 0, 0); PG8_STAGE(PG8_SA(1, 1), a1 + hstep, voffA);
            PG8_WAIT_V(8); PG8_WAIT_L(0); PG8_BAR; PG8_MMA(0, 0, At, B0); if constexpr (!NH) PG8_MMA(0, 1, At, B1); PG8_BAR; PG8_SCHED;
            PG8_LDA(At, 0, 1); PG8_STAGE(PG8_SB(0, 0), b2, voffB); PG8_STAGE(PG8_SB(0, 1), b2 + hstep, voffB); PG8_STAGE(PG8_SA(0, 0), a2, voffA);
            PG8_WAIT_V(8); PG8_WAIT_L(0); PG8_BAR; PG8_MMA(1, 0, At, B0); if constexpr (!NH) PG8_MMA(1, 1, At, B1); PG8_BAR; PG8_SCHED;
            PG8_LDB(B0, 1, 0); if constexpr (!NH) PG8_LDB(B1, 1, 1); PG8_SCHED; PG8_LDA(At, 1, 0); PG8_STAGE(PG8_SA(0, 1), a2 + hstep, voffA);
            PG8_WAIT_V(8); PG8_WAIT_L(0); PG8_BAR; PG8_MMA(0, 0, At, B0); if constexpr (!NH) PG8_MMA(0, 1, At, B1); PG8_BAR; PG8_SCHED;
            PG8_LDA(At, 1, 1); PG8_STAGE(PG8_SB(1, 0), b3, voffB); PG8_STAGE(PG8_SB(1, 1), b3 + hstep, voffB); PG8_STAGE(PG8_SA(1, 0), a3, voffA);
            PG8_WAIT_V(8); PG8_WAIT_L(0); PG8_BAR; PG8_MMA(1, 0, At, B0); if constexpr (!NH) PG8_MMA(1, 1, At, B1); PG8_BAR; PG8_SCHED;
            } else {
            PG8_LDB(B0, 0, 0); PG8_SCHED; PG8_LDA(At, 0, 0); PG8_STAGE(PG8_SA(1, 1), a1 + hstep, voffA);
            PG8_WAIT_L(8); PG8_BAR; PG8_WAIT_L(0); PG8_MMA(0, 0, At, B0); PG8_BAR; PG8_SCHED;
            PG8_LDB(B1, 0, 1); PG8_STAGE(PG8_SB(0, 0), b2, voffB);
            PG8_BAR; PG8_WAIT_L(0); PG8_MMA(0, 1, At, B1); PG8_BAR;
            PG8_LDA(At, 0, 1); PG8_STAGE(PG8_SA(0, 0), a2, voffA);
            PG8_BAR; PG8_WAIT_L(0); PG8_MMA(1, 0, At, B0); PG8_BAR; PG8_SCHED;
            PG8_STAGE(PG8_SB(0, 1), b2 + hstep, voffB);
            PG8_WAIT_V(6); PG8_BAR; PG8_MMA(1, 1, At, B1); PG8_BAR;
            PG8_LDB(B0, 1, 0); PG8_SCHED; PG8_LDA(At, 1, 0); PG8_STAGE(PG8_SA(0, 1), a2 + hstep, voffA);
            PG8_WAIT_L(8); PG8_BAR; PG8_WAIT_L(0); PG8_MMA(0, 0, At, B0); PG8_BAR; PG8_SCHED;
            PG8_LDB(B1, 1, 1); PG8_STAGE(PG8_SB(1, 0), b3, voffB);
            PG8_BAR; PG8_WAIT_L(0); PG8_MMA(0, 1, At, B1); PG8_BAR;
            PG8_LDA(At, 1, 1); PG8_STAGE(PG8_SA(1, 0), a3, voffA);
            PG8_BAR; PG8_WAIT_L(0); PG8_MMA(1, 0, At, B0); PG8_BAR; PG8_SCHED;
            PG8_STAGE(PG8_SB(1, 1), b3 + hstep, voffB);
            PG8_WAIT_V(6); PG8_BAR; PG8_MMA(1, 1, At, B1); PG8_BAR;
            }
        }
        if constexpr (ALIGN_EPI) { if (wr == 0) PG8_BAR; }
        if constexpr (!Epi::AFTER_DRAIN) { int ln_; asm volatile("v_mbcnt_lo_u32_b32 %0, -1, 0\n\tv_mbcnt_hi_u32_b32 %0, -1, %0" : "=v"(ln_));
            E(acc, cur, wr, wc, ln_ & 15, ln_ >> 4); S.done(cur); }
        if (!has_next) break;
#pragma unroll
        for (int a = 0; a < 2; ++a)
#pragma unroll
            for (int b = 0; b < 2; ++b)
#pragma unroll
                for (int m = 0; m < 4; ++m)
#pragma unroll
                    for (int n = 0; n < 2; ++n) acc[a][b][m][n] = (f32x4){0.f, 0.f, 0.f, 0.f};
        cur = nxt; cA = nA; cB = nB; ++ui;
        if constexpr (ALIGN_EPI) { if (wr == 1) PG8_BAR; }
    }
    PG8_WAIT_V(0);
    if constexpr (!ALIGN_EPI) { if (wr == 0) PG8_BAR; }
    PG8_BAR;
    if constexpr (Epi::AFTER_DRAIN) { E.fused(acc, cur, wr, wc, fr, fq, lds, wid, lane); S.done(cur); }
#undef PG8_SA
#undef PG8_SB
#undef PG8_STAGE
#undef PG8_LDA
#undef PG8_LDB
#undef PG8_MMA
#undef PG8_WAIT_V
#undef PG8_WAIT_L
#undef PG8_BAR
#undef PG8_SCHED
}
}

constexpr int NB = 8, SEQ = 4096, DM = 2048, TOK = NB * SEQ;
constexpr int NWAVES = 8;
constexpr float LN_EPS = 1e-5f;
constexpr float DN_ALPHA = 1.189207115002721f;
constexpr float LOG2E = 1.4426950408889634f;
constexpr float QSCALE_A = 0.08838834764831845f * LOG2E;
constexpr float QSCALE_B = 0.07216878364870322f * LOG2E;

constexpr size_t MiB = 1u << 20;
constexpr size_t WS_CTL = 0, CTL_ZERO_BYTES = 1 * MiB;
constexpr size_t WS_WIN = 1 * MiB;
constexpr size_t WS_WKR = 33 * MiB;
constexpr size_t WS_WUQ = 34 * MiB;
constexpr size_t WS_WUKV = 36 * MiB;
constexpr size_t WS_WPA = 38 * MiB;
constexpr size_t WS_WPB = 42 * MiB;
constexpr size_t WS_WO = 46 * MiB;
constexpr size_t WS_WSK = 54 * MiB;
constexpr size_t WS_MOD = 62 * MiB;
constexpr size_t WS_BIAS = 62 * MiB + 512 * 1024;
constexpr size_t WS_LN1 = 63 * MiB;
constexpr size_t WS_UT = 64 * MiB;
constexpr size_t WS_VT = 96 * MiB;
constexpr size_t WS_TSCALE = 62 * MiB + 768 * 1024;
constexpr size_t WS_W8 = 80 * MiB;
constexpr size_t WS_HSC = 63 * MiB + 512 * 1024;
constexpr size_t WS_WUQ8 = 121 * MiB;
constexpr size_t WS_WUKV8 = 122 * MiB;
constexpr size_t WS_WKR8 = 112 * MiB;
constexpr size_t WS_WPA8 = 113 * MiB;
constexpr size_t WS_WPB8 = 115 * MiB;
constexpr size_t WS_WO8 = 117 * MiB;
constexpr size_t WS_H8 = 128 * MiB;
constexpr size_t WS_H = 192 * MiB;
constexpr size_t WS_QKVA = 320 * MiB;
constexpr size_t WS_SCORE = 320 * MiB;
constexpr size_t WS_CQ = 512 * MiB;
constexpr size_t WS_CKV = 544 * MiB;
constexpr size_t WS_U1B = 576 * MiB;
constexpr size_t WS_QN = 576 * MiB;
constexpr size_t WS_QR = 640 * MiB;
constexpr size_t WS_KN = 672 * MiB;
constexpr size_t WS_VB = 736 * MiB;
constexpr size_t WS_KR = 800 * MiB;
constexpr size_t WS_YA = 804 * MiB;
constexpr size_t WS_YB = 868 * MiB;
constexpr size_t WS_CS = 932 * MiB;
constexpr size_t WS_SSQ = 940 * MiB;
constexpr size_t WS_END = 942 * MiB;
constexpr size_t WS_IDS = 736 * MiB;
constexpr size_t WS_GATES = 744 * MiB;
constexpr size_t WS_W = 760 * MiB;
constexpr size_t WS_WSC = 768 * MiB;
constexpr size_t WS_SX = 776 * MiB;
constexpr size_t WS_S8 = 776 * MiB + 128 * 1024;
constexpr size_t WS_PA = 320 * MiB;
constexpr size_t WS_XH = 804 * MiB;
constexpr size_t WS_XL = 836 * MiB;
constexpr size_t WS_ST2 = 778 * MiB;
constexpr size_t WS_IDT = 780 * MiB;
constexpr size_t UT_SLICE = 2 * MiB;
constexpr int CW_BAR = 4096;
constexpr int CW_WMAX = 8;
constexpr float ACT_C = 16.0f;
constexpr float ACT_Y = 32.0f, ACT_MIX = 64.0f;
constexpr int CW_WMAX0 = 8;

constexpr int RING_BYTES = 131072;
constexpr int MISC_OFF = RING_BYTES + 320;
constexpr int LDS_BYTES = 147456;

#define GAS __attribute__((address_space(1)))
#define LAS __attribute__((address_space(3)))
typedef unsigned short bf16;
typedef unsigned v4u __attribute__((ext_vector_type(4)));
typedef unsigned v2u __attribute__((ext_vector_type(2)));
typedef float f32x4 __attribute__((ext_vector_type(4)));
typedef float f32x16 __attribute__((ext_vector_type(16)));
typedef short bf16x8 __attribute__((ext_vector_type(8)));
typedef short s16x4 __attribute__((ext_vector_type(4)));
typedef __bf16 bf16x2_t __attribute__((ext_vector_type(2)));
#define LDS_WAIT() asm volatile("s_waitcnt lgkmcnt(0)" ::: "memory")
#define VM_WAIT() asm volatile("s_waitcnt vmcnt(0)" ::: "memory")
__device__ __forceinline__ unsigned f2bf(float f) { unsigned u = __builtin_bit_cast(unsigned, f); return (u + 0x7fffu + ((u >> 16) & 1u)) >> 16; }
__device__ __forceinline__ unsigned pk2(float lo, float hi) { return f2bf(lo) | (f2bf(hi) << 16); }
#define WRED_DPP(v, ctrl) __builtin_amdgcn_update_dpp(0, (v), (ctrl), 0xF, 0xF, true)
__device__ __forceinline__ float wave_sum(float v) {
    v += __int_as_float(WRED_DPP(__float_as_int(v), 0xB1)); v += __int_as_float(WRED_DPP(__float_as_int(v), 0x4E));
    v += __int_as_float(WRED_DPP(__float_as_int(v), 0x141)); v += __int_as_float(WRED_DPP(__float_as_int(v), 0x140));
    { const auto r = __builtin_amdgcn_permlane16_swap(__float_as_uint(v), __float_as_uint(v), false, false); v = __uint_as_float(r[0]) + __uint_as_float(r[1]); }
    { const auto r = __builtin_amdgcn_permlane32_swap(__float_as_uint(v), __float_as_uint(v), false, false); v = __uint_as_float(r[0]) + __uint_as_float(r[1]); }
    return v;
}
__device__ __forceinline__ float wave_max(float v) {
    v = fmaxf(v, __int_as_float(WRED_DPP(__float_as_int(v), 0xB1))); v = fmaxf(v, __int_as_float(WRED_DPP(__float_as_int(v), 0x4E)));
    v = fmaxf(v, __int_as_float(WRED_DPP(__float_as_int(v), 0x141))); v = fmaxf(v, __int_as_float(WRED_DPP(__float_as_int(v), 0x140)));
    { const auto r = __builtin_amdgcn_permlane16_swap(__float_as_uint(v), __float_as_uint(v), false, false); v = fmaxf(__uint_as_float(r[0]), __uint_as_float(r[1])); }
    { const auto r = __builtin_amdgcn_permlane32_swap(__float_as_uint(v), __float_as_uint(v), false, false); v = fmaxf(__uint_as_float(r[0]), __uint_as_float(r[1])); }
    return v;
}
__device__ __forceinline__ int wave_sum_int(int v) {
    v += WRED_DPP(v, 0xB1); v += WRED_DPP(v, 0x4E); v += WRED_DPP(v, 0x141); v += WRED_DPP(v, 0x140);
    { const auto r = __builtin_amdgcn_permlane16_swap((unsigned)v, (unsigned)v, false, false); v = (int)(r[0] + r[1]); }
    { const auto r = __builtin_amdgcn_permlane32_swap((unsigned)v, (unsigned)v, false, false); v = (int)(r[0] + r[1]); }
    return v;
}
__device__ __forceinline__ float bflo(unsigned w) { return __uint_as_float(w << 16); }
__device__ __forceinline__ float bfhi(unsigned w) { return __uint_as_float(w & 0xffff0000u); }

#define XB_TMO      128
#define XB_XCNT(j)  (256  + 64 * (j))
#define XB_XSUB(j)  (1280 + 64 * (j))
#define XB_XGEN(j)  (2304 + 64 * (j))
#define XB_TOP      3328
#define XB_TOPGEN   3392
#define XCD_BAR_WORDS 3456
#define XB_SPIN_CAP (1u << 18)

__device__ __forceinline__ unsigned xb_ld(unsigned* p)              { return __hip_atomic_load(p, __ATOMIC_RELAXED, __HIP_MEMORY_SCOPE_AGENT); }
__device__ __forceinline__ unsigned xb_add(unsigned* p, unsigned v) { return __hip_atomic_fetch_add(p, v, __ATOMIC_RELAXED, __HIP_MEMORY_SCOPE_AGENT); }
__device__ __forceinline__ unsigned xb_xcc_id() { return (unsigned)__builtin_amdgcn_s_getreg((3 << 11) | 20) & 0xFu; }
#define XB_SPIN(cond, bar) do { unsigned _sp = 0; while (cond) { __builtin_amdgcn_s_sleep(1); \
    if ((++_sp & 255u) == 0u) { if (xb_ld(&(bar)[XB_TMO])) break; if (_sp > XB_SPIN_CAP) { atomicAdd(&(bar)[XB_TMO], 1u); break; } } } } while (0)

struct XcdBarrier {
    unsigned* bar; unsigned x;
    volatile LAS unsigned* st;
    bool w0;
};
__device__ __forceinline__ bool xb_thread0(bool w0) { return w0 && __builtin_amdgcn_mbcnt_hi(~0u, __builtin_amdgcn_mbcnt_lo(~0u, 0u)) == 0u; }

__device__ __forceinline__ XcdBarrier xcd_barrier_post(unsigned* bar, volatile LAS unsigned* st, bool w0) {
    XcdBarrier b; b.bar = bar; b.x = xb_xcc_id(); b.st = st; b.w0 = w0;
    if (xb_thread0(w0)) (void)xb_add(&bar[XB_XCNT(b.x)], 1u);
    return b;
}
__device__ __forceinline__ void xcd_barrier_complete(unsigned* bar, unsigned x, unsigned& nloc, unsigned& nx) {
    const unsigned G = gridDim.x * gridDim.y * gridDim.z;
    unsigned sum, cnt, mine, sp = 0u;
    for (;;) {
        sum = 0u; cnt = 0u; mine = 0u;
#pragma unroll
        for (unsigned j = 0; j < 16; ++j) { const unsigned c = xb_ld(&bar[XB_XCNT(j)]); sum += c; cnt += (c > 0u) ? 1u : 0u; mine = (j == x) ? c : mine; }
        if (sum == G) break;
        __builtin_amdgcn_s_sleep(1);
        if ((++sp & 255u) == 0u) { if (xb_ld(&bar[XB_TMO])) break; if (sp > XB_SPIN_CAP) { atomicAdd(&bar[XB_TMO], 1u); break; } }
    }
    nloc = mine > 0u ? mine : 1u; nx = cnt > 0u ? cnt : 1u;
}

__device__ __forceinline__ void xcd_barrier(const XcdBarrier& b) {
    asm volatile("s_waitcnt vmcnt(0)" ::: "memory");
    __syncthreads();
    if (xb_thread0(b.w0)) {
        unsigned* bar = b.bar;
        __builtin_amdgcn_s_waitcnt(0);
        unsigned nloc = b.st[0], nx = b.st[1];
        if (nloc == 0u) { xcd_barrier_complete(bar, b.x, nloc, nx); b.st[0] = nloc; b.st[1] = nx; }
        const unsigned old = xb_add(&bar[XB_XSUB(b.x)], 1u);
        const unsigned gen = old / nloc;
        if (old + 1u == (gen + 1u) * nloc) {
            __builtin_amdgcn_fence(__ATOMIC_RELEASE, "agent");
            asm volatile("s_waitcnt vmcnt(0)" ::: "memory");
            const unsigned og = xb_add(&bar[XB_TOP], 1u);
            const unsigned tg = og / nx;
            if (og + 1u == (tg + 1u) * nx) xb_add(&bar[XB_TOPGEN], 1u);
            else XB_SPIN(xb_ld(&bar[XB_TOPGEN]) == tg, bar);
            __builtin_amdgcn_fence(__ATOMIC_ACQUIRE, "agent");
            xb_add(&bar[XB_XGEN(b.x)], 1u);
            asm volatile("s_waitcnt vmcnt(0)" ::: "memory");
        } else {
            XB_SPIN(xb_ld(&bar[XB_XGEN(b.x)]) == gen, bar);
            __builtin_amdgcn_fence(__ATOMIC_ACQUIRE, "agent");
            asm volatile("s_waitcnt vmcnt(0)" ::: "memory");
        }
    }
    __syncthreads();
}

namespace att {
constexpr int SHM_V = 16384, SHM_KN = 16384, SHM_KR = 8192, BUFB = SHM_V + SHM_KN + SHM_KR;
constexpr int OFF_V = 0, OFF_KN = SHM_V, OFF_KR = SHM_V + SHM_KN;
constexpr int NSLOT = 3;
constexpr int OFF_WS = NSLOT * BUFB, OFF_BIAS = OFF_WS + 2048, ATT_LDS = OFF_BIAS + 1280;
static_assert(ATT_LDS <= RING_BYTES, "attention LDS");
#define KSWZ(row, colB) ((row) * 256 + ((colB) ^ (((row) & 15) << 4)))
#define KRSWZ(row, colB) ((row) * 128 + ((colB) ^ ((((row) >> 1) & 7) << 4)))
__device__ __forceinline__ int v_st(int k, int c) { const int kk = (k & ~0xC) | ((k & 4) << 1) | ((k & 8) >> 1); return ((kk >> 3) * 4 + (c >> 5)) * 512 + ((kk & 7) * 32 + (c & 31)) * 2; }
__device__ __forceinline__ int v_rd_base(int lane) { return ((lane & 3) << 3) | (((lane >> 2) & 3) << 6) | (((lane >> 4) & 1) << 5) | (((lane >> 5) & 1) << 8); }
__device__ __forceinline__ int crow(int r, int hi) { return (r & 3) + 8 * (r >> 2) + 4 * hi; }
__device__ __forceinline__ unsigned cvtpk(float lo, float hi) { return pg8::cvt_pk_bf16(lo, hi); }
constexpr float THR = 8.0f;

template <int MODE>
__device__ __forceinline__ void attn_unit(LAS unsigned char* lds, int b, int h, int qb, const bf16* __restrict__ Qn, const bf16* __restrict__ Qr, const bf16* __restrict__ Kn,
                                          const bf16* __restrict__ Kr, const bf16* __restrict__ V, bf16* __restrict__ O, const float* __restrict__ relb, const int tid_in) {
    constexpr int ND = MODE ? 12 : 8;
    int tid = tid_in; asm volatile("" : "+v"(tid));
    const int wid = __builtin_amdgcn_readfirstlane(tid >> 6), lane = tid & 63, r32 = lane & 31, hi = lane >> 5;
    const int tb = b * SEQ, cw = 4 * qb + (wid >> 1);
    const int j_lo = MODE ? 0 : (4 * qb - 8 > 0 ? 4 * qb - 8 : 0), j_hi = 4 * qb + 4, NTL = j_hi - j_lo;
    bf16x8 qr[ND];
    { const size_t qrow = (size_t)(tb + 256 * qb + 32 * wid + r32);
#pragma unroll
      for (int d0 = 0; d0 < 8; ++d0) qr[d0] = *(const bf16x8*)(Qn + qrow * 1024 + h * 128 + d0 * 16 + hi * 8);
      if constexpr (MODE == 1) {
#pragma unroll
          for (int d0 = 0; d0 < 4; ++d0) qr[8 + d0] = *(const bf16x8*)(Qr + qrow * 512 + h * 64 + d0 * 16 + hi * 8); } }
    unsigned gk[2], gv[2], gkr;
#pragma unroll
    for (int i = 0; i < 2; ++i) { const int p = 2 * wid + i; const int row = 4 * p + (lane >> 4), colB = ((lane & 15) << 4) ^ ((row & 15) << 4);
        gk[i] = (unsigned)(row * 2048 + colB);
        const int st = 2 * p + (lane >> 5), kk = (st >> 2) * 8 + ((lane & 31) >> 2), c = (st & 3) * 32 + (lane & 3) * 8, k = (kk & ~0xC) | ((kk & 4) << 1) | ((kk & 8) >> 1);
        gv[i] = (unsigned)(k * 2048 + c * 2); }
    { const int row = 8 * wid + (lane >> 3), colB = ((lane & 7) << 4) ^ (((row >> 1) & 7) << 4); gkr = (unsigned)(row * 128 + colB); }
    const char* Kg = (const char*)(Kn + (size_t)tb * 1024 + h * 128); const char* Vg = (const char*)(V + (size_t)tb * 1024 + h * 128); const char* Krg = (const char*)(Kr + (size_t)tb * 64);
#define ATT_STAGE(j, bo) do { const size_t to_ = (size_t)(j) * (64 * 2048); \
        __builtin_amdgcn_global_load_lds((const unsigned*)(Kg + to_ + gk[0]), (LAS unsigned*)(lds + (bo) + OFF_KN + wid * 2048), 16, 0, 0); \
        __builtin_amdgcn_global_load_lds((const unsigned*)(Kg + to_ + gk[1]), (LAS unsigned*)(lds + (bo) + OFF_KN + wid * 2048 + 1024), 16, 0, 0); \
        __builtin_amdgcn_global_load_lds((const unsigned*)(Vg + to_ + gv[0]), (LAS unsigned*)(lds + (bo) + OFF_V + wid * 2048), 16, 0, 0); \
        __builtin_amdgcn_global_load_lds((const unsigned*)(Vg + to_ + gv[1]), (LAS unsigned*)(lds + (bo) + OFF_V + wid * 2048 + 1024), 16, 0, 0); \
        if constexpr (MODE == 1) __builtin_amdgcn_global_load_lds((const unsigned*)(Krg + (size_t)(j) * (64 * 128) + gkr), (LAS unsigned*)(lds + (bo) + OFF_KR + wid * 1024), 16, 0, 0); } while (0)
    float m_reg = -1e30f, l_reg = 0.f; f32x16 o[4] = {};
    LAS float* li_l = (LAS float*)(lds + OFF_WS) + wid * 64; LAS float* al_l = li_l + 32;
    const LAS float* biasL = (const LAS float*)(lds + OFF_BIAS);
    if constexpr (MODE == 0) { if (tid < 320) ((LAS float*)(lds + OFF_BIAS))[tid] = relb[tid] * LOG2E; }
    int kb[8], krb[4];
#pragma unroll
    for (int dd = 0; dd < 4; ++dd) { kb[dd] = OFF_KN + KSWZ(r32, (dd * 16 + hi * 8) * 2); kb[4 + dd] = OFF_KN + KSWZ(r32, 128 + (dd * 16 + hi * 8) * 2); krb[dd] = OFF_KR + KRSWZ(r32, dd * 32 + hi * 16); }
    const unsigned vb0 = (unsigned)(uintptr_t)lds + OFF_V + v_rd_base(lane);
    constexpr int NDMA = MODE ? 5 : 4;
    ATT_STAGE(j_lo, 0);
    if (NTL > 1) { ATT_STAGE(j_lo + 1, BUFB); asm volatile("s_waitcnt vmcnt(%0)" :: "i"(NDMA) : "memory"); } else VM_WAIT();
    __syncthreads();
    int bo = 0, bo2 = 2 * BUFB;
    for (int t = 0; t < NTL; ++t) {
        const int j = j_lo + t;
        if (t + 2 < NTL) ATT_STAGE(j + 2, bo2);
        const bool act = MODE ? (j <= cw) : (j <= cw && j >= cw - 8);
        if (act) {
            f32x16 p0 = {}, p1 = {};
            { bf16x8 kf[2][2];
              unsigned kad[8], krad[4];
#pragma unroll
              for (int dd = 0; dd < 4; ++dd) { kad[dd] = (unsigned)(uintptr_t)lds + (unsigned)bo + (unsigned)kb[dd]; kad[4 + dd] = (unsigned)(uintptr_t)lds + (unsigned)bo + (unsigned)kb[4 + dd]; krad[dd] = (unsigned)(uintptr_t)lds + (unsigned)bo + (unsigned)krb[dd]; }
#define ATT_KRD(dst, ad, off) asm volatile("ds_read_b128 %0, %1 offset:%2" : "=&v"(dst) : "v"(ad), "i"(off) : "memory")
#define ATT_KLD(d0_, s_) do { if ((d0_) < 8) { ATT_KRD(kf[s_][0], kad[(d0_) & 7], 0); ATT_KRD(kf[s_][1], kad[(d0_) & 7], 32 * 256); } \
                                  else { ATT_KRD(kf[s_][0], krad[((d0_) - 8) & 3], 0); ATT_KRD(kf[s_][1], krad[((d0_) - 8) & 3], 32 * 128); } } while (0)
              ATT_KLD(0, 0);
#pragma unroll
              for (int d0 = 0; d0 < ND; ++d0) {
                  if (d0 + 1 < ND) { ATT_KLD(d0 + 1, (d0 + 1) & 1); asm volatile("s_waitcnt lgkmcnt(2)" ::: "memory"); } else { asm volatile("s_waitcnt lgkmcnt(0)" ::: "memory"); }
                  __builtin_amdgcn_sched_barrier(0);
                  p0 = __builtin_amdgcn_mfma_f32_32x32x16_bf16(kf[d0 & 1][0], qr[d0], p0, 0, 0, 0); p1 = __builtin_amdgcn_mfma_f32_32x32x16_bf16(kf[d0 & 1][1], qr[d0], p1, 0, 0, 0);
                  __builtin_amdgcn_sched_barrier(0); }
#undef ATT_KLD
#undef ATT_KRD
            }
            if constexpr (MODE == 0) {
                const int dc = cw - j;
                if (dc >= 5) { const float bc = biasL[319];
#pragma unroll
                    for (int r = 0; r < 16; ++r) { p0[r] += bc; p1[r] += bc; } }
                else { const int base = 64 * dc + 32 * (wid & 1) + r32 - 4 * hi;
#pragma unroll
                    for (int r = 0; r < 16; ++r) { const int rel0 = base - ((r & 3) + 8 * (r >> 2)); int i0 = rel0 < -63 ? -63 : rel0; i0 = i0 > 256 ? 256 : i0; int i1 = rel0 - 32 < -63 ? -63 : rel0 - 32; i1 = i1 > 256 ? 256 : i1;
                        p0[r] += biasL[i0 + 63]; p1[r] += biasL[i1 + 63]; } }
            }
            float pmax = p0[0];
#pragma unroll
            for (int r = 1; r < 16; ++r) pmax = fmaxf(pmax, p0[r]);
#pragma unroll
            for (int r = 0; r < 16; ++r) pmax = fmaxf(pmax, p1[r]);
            { auto rr = __builtin_amdgcn_permlane32_swap(__float_as_uint(pmax), __float_as_uint(pmax), false, false); pmax = fmaxf(__uint_as_float(rr[0]), __uint_as_float(rr[1])); }
            float mn, alpha;
            if (__all((pmax - m_reg) <= THR)) { mn = m_reg; alpha = 1.f; }
            else { mn = fmaxf(m_reg, pmax); alpha = __builtin_amdgcn_exp2f(m_reg - mn); m_reg = mn; }
#pragma unroll
            for (int r = 0; r < 16; ++r) { p0[r] = __builtin_amdgcn_exp2f(p0[r] - mn); p1[r] = __builtin_amdgcn_exp2f(p1[r] - mn); }
            float ps = 0.f;
#pragma unroll
            for (int r = 0; r < 16; ++r) ps += p0[r];
#pragma unroll
            for (int r = 0; r < 16; ++r) ps += p1[r];
            { auto rr = __builtin_amdgcn_permlane32_swap(__float_as_uint(ps), __float_as_uint(ps), false, false); ps = __uint_as_float(rr[0]) + __uint_as_float(rr[1]); }
            l_reg = l_reg * alpha + ps;
            bf16x8 pa0, pa1, pa2, pa3;
#define ATT_PK4(P, B_, OUT) do { unsigned a0 = cvtpk(P[B_+0], P[B_+1]), a1 = cvtpk(P[B_+2], P[B_+3]); unsigned b0 = cvtpk(P[B_+4], P[B_+5]), b1 = cvtpk(P[B_+6], P[B_+7]); \
        auto r0 = __builtin_amdgcn_permlane32_swap(a0, b0, false, false); auto r1 = __builtin_amdgcn_permlane32_swap(a1, b1, false, false); \
        v4u w = {r0[0], r1[0], r0[1], r1[1]}; OUT = __builtin_bit_cast(bf16x8, w); } while (0)
            ATT_PK4(p0, 0, pa0); ATT_PK4(p0, 8, pa1); ATT_PK4(p1, 0, pa2); ATT_PK4(p1, 8, pa3);
#undef ATT_PK4
            if (__any(alpha < 1.f)) { if (hi == 0) al_l[r32] = alpha; LDS_WAIT();
#pragma unroll
                for (int r = 0; r < 16; ++r) { const float a = al_l[crow(r, hi)];
#pragma unroll
                    for (int d = 0; d < 4; ++d) o[d][r] *= a; } }
            const unsigned vb = vb0 + (unsigned)bo;
#define ATT_TRRD(dst, off) asm volatile("ds_read_b64_tr_b16 %0, %1 offset:%2" : "=&v"(dst) : "v"(vb), "i"(off) : "memory")
#define ATT_VLD(d0, L) do { constexpr int b_ = (d0) * 512; ATT_TRRD(L[0], b_); ATT_TRRD(L[4], b_ + 2048); ATT_TRRD(L[1], b_ + 4096); ATT_TRRD(L[5], b_ + 6144); ATT_TRRD(L[2], b_ + 8192); ATT_TRRD(L[6], b_ + 10240); ATT_TRRD(L[3], b_ + 12288); ATT_TRRD(L[7], b_ + 14336); } while (0)
#define ATT_PVM(d0, L) do { \
        o[d0] = __builtin_amdgcn_mfma_f32_32x32x16_bf16(pa0, (bf16x8){L[0][0], L[0][1], L[0][2], L[0][3], L[4][0], L[4][1], L[4][2], L[4][3]}, o[d0], 0, 0, 0); \
        o[d0] = __builtin_amdgcn_mfma_f32_32x32x16_bf16(pa1, (bf16x8){L[1][0], L[1][1], L[1][2], L[1][3], L[5][0], L[5][1], L[5][2], L[5][3]}, o[d0], 0, 0, 0); \
        o[d0] = __builtin_amdgcn_mfma_f32_32x32x16_bf16(pa2, (bf16x8){L[2][0], L[2][1], L[2][2], L[2][3], L[6][0], L[6][1], L[6][2], L[6][3]}, o[d0], 0, 0, 0); \
        o[d0] = __builtin_amdgcn_mfma_f32_32x32x16_bf16(pa3, (bf16x8){L[3][0], L[3][1], L[3][2], L[3][3], L[7][0], L[7][1], L[7][2], L[7][3]}, o[d0], 0, 0, 0); } while (0)
            { s16x4 va[8], vb_[8];
              ATT_VLD(0, va);
              ATT_VLD(1, vb_); asm volatile("s_waitcnt lgkmcnt(8)" ::: "memory"); __builtin_amdgcn_sched_barrier(0); ATT_PVM(0, va); __builtin_amdgcn_sched_barrier(0);
              ATT_VLD(2, va);  asm volatile("s_waitcnt lgkmcnt(8)" ::: "memory"); __builtin_amdgcn_sched_barrier(0); ATT_PVM(1, vb_); __builtin_amdgcn_sched_barrier(0);
              ATT_VLD(3, vb_); asm volatile("s_waitcnt lgkmcnt(8)" ::: "memory"); __builtin_amdgcn_sched_barrier(0); ATT_PVM(2, va); __builtin_amdgcn_sched_barrier(0);
              asm volatile("s_waitcnt lgkmcnt(0)" ::: "memory"); __builtin_amdgcn_sched_barrier(0); ATT_PVM(3, vb_); }
#undef ATT_VLD
#undef ATT_PVM
#undef ATT_TRRD
        }
        if (t + 2 < NTL) asm volatile("s_waitcnt vmcnt(%0)" :: "i"(NDMA) : "memory"); else VM_WAIT();
        asm volatile("s_waitcnt lgkmcnt(0)" ::: "memory"); __builtin_amdgcn_s_barrier(); asm volatile("" ::: "memory");
        bo = (bo == 2 * BUFB) ? 0 : bo + BUFB; bo2 = (bo2 == 2 * BUFB) ? 0 : bo2 + BUFB;
    }
    if (hi == 0) li_l[r32] = l_reg; LDS_WAIT();
    { LAS unsigned char* ost = lds + wid * 4096;
#pragma unroll
      for (int r = 0; r < 16; ++r) { const int orow = crow(r, hi); const float rl = __builtin_amdgcn_rcpf(li_l[orow]) * ACT_Y;
#pragma unroll
          for (int d0 = 0; d0 < 4; ++d0) { const float v = o[d0][r] * rl; ost[orow * 128 + d0 * 32 + r32] = (unsigned char)(__builtin_amdgcn_cvt_pk_fp8_f32(v, v, 0, false) & 0xff); } }
      LDS_WAIT();
      unsigned char* Ow = (unsigned char*)O + (size_t)(tb + 256 * qb + 32 * wid) * 1024 + h * 128;
#pragma unroll
      for (int k = 0; k < 4; ++k) { const int idx = lane + 64 * k, row = idx >> 3, ch = idx & 7;
          const v4u val = *(const LAS v4u*)(lds + wid * 4096 + row * 128 + ch * 16);
          *(v4u*)(Ow + (size_t)row * 1024 + ch * 16) = val; } }
    __syncthreads();
#undef ATT_STAGE
}
#undef KSWZ
#undef KRSWZ
}


struct Args {
    const float *x, *c; const int* positions;
    const float *w_ada, *b_ada, *w_in, *b_in, *rel_bias, *q_norm_g, *kv_norm_g, *w_uq, *w_ukv, *w_pa, *w_pb, *w_o, *ln1_g, *ln1_b, *peer_wq, *peer_keys, *peer_u, *peer_v, *ln2_g, *ln2_b;
    float* out; unsigned char* ws; int ph_lo, ph_hi;
};

template <class SrcCol>
__device__ __forceinline__ void transpose_item(const float* __restrict__ W, int K, int N, bf16* __restrict__ WT, int nblk, LAS float* scr, int item, int lane, SrcCol srccol, const float* __restrict__ kscale, float* amax = nullptr) {
    const int kb = item / nblk, nb = item % nblk, k0 = 64 * kb, n0 = 32 * nb;
    const int scol = srccol(n0 + (lane & 31));
    float am = 0.f, vv[32];
    { const float* wp = W + (size_t)(k0 + (lane >> 5)) * N + scol;
#pragma unroll
      for (int i = 0; i < 32; ++i) vv[i] = __builtin_nontemporal_load(wp + (size_t)(2 * i) * N); }
#pragma unroll
    for (int i = 0; i < 32; ++i) { const int kk = 2 * i + (lane >> 5); float v = vv[i]; if (kscale) v *= kscale[k0 + kk]; scr[kk * 33 + (lane & 31)] = v; am = fmaxf(am, fabsf(v)); }
    if (amax) *amax = fmaxf(*amax, am);
    LDS_WAIT(); asm volatile("" ::: "memory");
    const int c = lane & 7;
#pragma unroll
    for (int j = 0; j < 4; ++j) { const int n = (lane >> 3) + 8 * j; const LAS float* s = scr + (8 * c) * 33 + n;
        v4u o; o.x = pk2(s[0 * 33], s[1 * 33]); o.y = pk2(s[2 * 33], s[3 * 33]); o.z = pk2(s[4 * 33], s[5 * 33]); o.w = pk2(s[6 * 33], s[7 * 33]);
        *(v4u*)(WT + (size_t)(n0 + n) * K + k0 + 8 * c) = o; }
    LDS_WAIT(); asm volatile("" ::: "memory");
}
struct ColIn { __device__ int operator()(int n) const { return n < 4096 ? n : n + 64; } };
struct ColKr { __device__ int operator()(int n) const { return 4096 + (n >> 1) + 32 * (n & 1); } };
struct ColUq { __device__ int operator()(int n) const { if (n < 1024) return (n >> 7) * 192 + (n & 127); const int r = n - 1024, hh = r >> 6, o = r & 63; return hh * 192 + 128 + (o >> 1) + 32 * (o & 1); } };
struct ColUkv { __device__ int operator()(int n) const { return n < 1024 ? (n >> 7) * 256 + (n & 127) : ((n - 1024) >> 7) * 256 + 128 + (n & 127); } };
struct ColId { __device__ int operator()(int n) const { return n; } };

__device__ __forceinline__ void p0_prologue(const Args& A, LAS unsigned char* lds, int tid, int lane, int wave, int vcu, int G) {
    unsigned char* ws = A.ws;
    {
        LAS float* sl = (LAS float*)lds;
        LAS float* red = (LAS float*)(lds + 65536);
        for (int i = tid; i < NB * DM; i += NWAVES * 64) { const int b = i >> 11, k = i & 2047; const float v = A.c[i]; sl[k * 8 + b] = v / (1.0f + __expf(-v)); }
        __syncthreads();
        float* mod = (float*)(ws + WS_MOD);
        for (int cb = blockIdx.x; cb < 256; cb += G) {
            const int r = lane / 12, c4 = lane % 12; const int col = cb * 48 + c4 * 4;
            float acc[8][4];
#pragma unroll
            for (int b = 0; b < 8; ++b)
#pragma unroll
                for (int i = 0; i < 4; ++i) acc[b][i] = 0.f;
            if (r < 5) {
#pragma unroll 4
                for (int kk = r; kk < 256; kk += 5) { const int k = wave * 256 + kk;
                    const f32x4 wv = __builtin_nontemporal_load((const f32x4*)(A.w_ada + (size_t)k * (6 * DM) + col));
                    const f32x4 s0 = *(const LAS f32x4*)(sl + k * 8), s1 = *(const LAS f32x4*)(sl + k * 8 + 4);
#pragma unroll
                    for (int i = 0; i < 4; ++i) { acc[0][i] += s0[0] * wv[i]; acc[1][i] += s0[1] * wv[i]; acc[2][i] += s0[2] * wv[i]; acc[3][i] += s0[3] * wv[i];
                                                  acc[4][i] += s1[0] * wv[i]; acc[5][i] += s1[1] * wv[i]; acc[6][i] += s1[2] * wv[i]; acc[7][i] += s1[3] * wv[i]; } }
#pragma unroll
                for (int i = 0; i < 4; ++i)
#pragma unroll
                    for (int b = 0; b < 8; ++b) red[((wave * 5 + r) * 48 + c4 * 4 + i) * 8 + b] = acc[b][i];
            }
            __syncthreads();
            if (tid < 384) { const int cc = tid >> 3, b = tid & 7; float s = 0.f;
                for (int p = 0; p < 40; ++p) s += red[(p * 48 + cc) * 8 + b];
                const int col2 = cb * 48 + cc; mod[(size_t)b * (6 * DM) + col2] = s + A.b_ada[col2]; }
            __syncthreads();
        }
    }
    const int gw = vcu * NWAVES + wave, NGW = G * NWAVES;
    {
        LAS float* scr = (LAS float*)(lds + wave * 16384);
        constexpr int I_IN = 32 * 256, I_KR = 32 * 2, I_UQ = 8 * 48, I_UKV = 8 * 64, I_PA = 16 * 64, I_PB = 16 * 64, I_O = 32 * 64;
        constexpr int NITEMS = I_IN + I_KR + I_UQ + I_UKV + I_PA + I_PB + I_O;
        float amx[6] = {0.f, 0.f, 0.f, 0.f, 0.f, 0.f};
        for (int it = gw; it < NITEMS; it += NGW) {
            int r = it;
            if (r < I_IN) { transpose_item(A.w_in, 2048, 8256, (bf16*)(ws + WS_WIN), 256, scr, r, lane, ColIn(), nullptr, &amx[0]); continue; } r -= I_IN;
            if (r < I_KR) { transpose_item(A.w_in, 2048, 8256, (bf16*)(ws + WS_WKR), 2, scr, r, lane, ColKr(), nullptr); continue; } r -= I_KR;
            if (r < I_UQ) { transpose_item(A.w_uq, 512, 1536, (bf16*)(ws + WS_WUQ), 48, scr, r, lane, ColUq(), A.q_norm_g, &amx[4]); continue; } r -= I_UQ;
            if (r < I_UKV) { transpose_item(A.w_ukv, 512, 2048, (bf16*)(ws + WS_WUKV), 64, scr, r, lane, ColUkv(), A.kv_norm_g, &amx[5]); continue; } r -= I_UKV;
            if (r < I_PA) { transpose_item(A.w_pa, 1024, 2048, (bf16*)(ws + WS_WPA), 64, scr, r, lane, ColId(), nullptr, &amx[1]); continue; } r -= I_PA;
            if (r < I_PB) { transpose_item(A.w_pb, 1024, 2048, (bf16*)(ws + WS_WPB), 64, scr, r, lane, ColId(), nullptr, &amx[2]); continue; } r -= I_PB;
            transpose_item(A.w_o, 2048, 2048, (bf16*)(ws + WS_WO), 64, scr, r, lane, ColId(), nullptr, &amx[3]);
        }
        { v4u* z = (v4u*)(ws + WS_WKR + (size_t)64 * 2048 * 2); const int n16 = 192 * 2048 * 2 / 16;
          for (int i = blockIdx.x * (NWAVES * 64) + tid; i < n16; i += G * NWAVES * 64) z[i] = (v4u){0u, 0u, 0u, 0u}; }
#pragma unroll
        for (int m = 0; m < 6; ++m) {
            amx[m] = wave_max(amx[m]); }
        if (lane == 0) {
#pragma unroll
            for (int m = 0; m < 6; ++m) scr[2112 + m] = amx[m]; }
    }
    __syncthreads();
    if (tid < 6) { float am = 0.f;
#pragma unroll
        for (int w = 0; w < NWAVES; ++w) am = fmaxf(am, ((LAS float*)(lds + w * 16384))[2112 + tid]);
        atomicMax((unsigned*)(ws + WS_CTL) + CW_WMAX + tid, __float_as_uint(am)); }
    __syncthreads();
    {
        bf16* wsk = (bf16*)(ws + WS_WSK);
        const int m16 = lane & 15, kq = lane >> 4;
        for (int it = gw; it < 16 * 128; it += NGW) {
            const int hp = it >> 7, k0 = (it & 127) * 16;
            bf16x8 af[4];
#pragma unroll
            for (int ks = 0; ks < 4; ++ks) { const float* p = A.peer_wq + (size_t)(k0 + m16) * 2048 + hp * 128 + 32 * ks + 8 * kq; const f32x4 x0 = *(const f32x4*)p, x1 = *(const f32x4*)(p + 4);
                const v4u w = {pg8::cvt_pk_bf16(x0[0], x0[1]), pg8::cvt_pk_bf16(x0[2], x0[3]), pg8::cvt_pk_bf16(x1[0], x1[1]), pg8::cvt_pk_bf16(x1[2], x1[3])}; af[ks] = __builtin_bit_cast(bf16x8, w); }
#pragma unroll 2
            for (int nb = 0; nb < 8; ++nb) { f32x4 acc = {0.f, 0.f, 0.f, 0.f};
#pragma unroll
                for (int ks = 0; ks < 4; ++ks) { const float* p = A.peer_keys + (size_t)hp * 16384 + (size_t)(nb * 16 + m16) * 128 + 32 * ks + 8 * kq; const f32x4 x0 = *(const f32x4*)p, x1 = *(const f32x4*)(p + 4);
                    const v4u w = {pg8::cvt_pk_bf16(x0[0], x0[1]), pg8::cvt_pk_bf16(x0[2], x0[3]), pg8::cvt_pk_bf16(x1[0], x1[1]), pg8::cvt_pk_bf16(x1[2], x1[3])};
                    acc = __builtin_amdgcn_mfma_f32_16x16x32_bf16(af[ks], __builtin_bit_cast(bf16x8, w), acc, 0, 0, 0); }
                v2u o; o.x = pk2(acc[0], acc[1]); o.y = pk2(acc[2], acc[3]);
                *(v2u*)(wsk + (size_t)(hp * 128 + nb * 16 + m16) * 2048 + k0 + 4 * kq) = o; }
        }
    }
#pragma unroll 2
    for (int rw = gw; rw < 2 * 16384; rw += NGW) {
        const float* src = (rw < 16384 ? A.peer_u : A.peer_v) + (size_t)(rw & 16383) * 2048;
        unsigned char* dst = ws + (rw < 16384 ? WS_UT : WS_VT) + (size_t)(rw & 16383) * 1024;
        f32x4 v[8]; float am = 0.f;
#pragma unroll
        for (int q = 0; q < 8; ++q) { v[q] = __builtin_nontemporal_load((const f32x4*)(src + q * 256 + lane * 4)); am = fmaxf(am, fmaxf(fmaxf(fabsf(v[q][0]), fabsf(v[q][1])), fmaxf(fabsf(v[q][2]), fabsf(v[q][3])))); }
        if (rw < 16384) {
            float ss = 0.f;
#pragma unroll
            for (int q = 0; q < 8; ++q) ss += (v[q][0] * v[q][0] + v[q][1] * v[q][1]) + (v[q][2] * v[q][2] + v[q][3] * v[q][3]);
            ss = wave_sum(ss);
            const float step = 0.3352f * sqrtf(ss * (1.0f / 2048.0f)), inv = ss > 0.f ? 1.0f / step : 0.f;
            if (lane == 0) ((float*)(ws + WS_TSCALE))[rw] = step;
#pragma unroll
            for (int q = 0; q < 8; ++q) { unsigned h = 0u;
#pragma unroll
                for (int m = 0; m < 4; ++m) { int qi = (int)floorf(v[q][m] * inv); qi = qi < -8 ? -8 : (qi > 7 ? 7 : qi); h |= ((unsigned)qi & 15u) << (4 * m); }
                *(unsigned short*)(ws + WS_UT + (size_t)q * UT_SLICE + (size_t)rw * 128 + lane * 2) = (unsigned short)h; }
            continue;
        }
        am = wave_max(am);
        const float sc = am > 0.f ? 6.0f / am : 1.0f;
        if (lane == 0) ((float*)(ws + WS_TSCALE))[rw] = am > 0.f ? am / 6.0f : 1.0f;
        v4u o;
#pragma unroll
        for (int k = 0; k < 4; ++k) { const f32x4 f0 = v[2 * k] * sc, f1 = v[2 * k + 1] * sc; unsigned w = 0u;
            w = __builtin_amdgcn_cvt_scalef32_pk_fp4_f32(w, f0[0], f0[1], 1.0f, 0); w = __builtin_amdgcn_cvt_scalef32_pk_fp4_f32(w, f0[2], f0[3], 1.0f, 1);
            w = __builtin_amdgcn_cvt_scalef32_pk_fp4_f32(w, f1[0], f1[1], 1.0f, 2); w = __builtin_amdgcn_cvt_scalef32_pk_fp4_f32(w, f1[2], f1[3], 1.0f, 3); o[k] = w; }
#pragma unroll
        for (int k = 0; k < 4; ++k) {
            *(unsigned short*)(ws + WS_VT + (size_t)(2 * k) * UT_SLICE + (size_t)(rw & 16383) * 128 + lane * 2) = (unsigned short)(o[k] & 0xffffu);
            *(unsigned short*)(ws + WS_VT + (size_t)(2 * k + 1) * UT_SLICE + (size_t)(rw & 16383) * 128 + lane * 2) = (unsigned short)(o[k] >> 16); }
    }
    {
        float* cs = (float*)(ws + WS_CS);
        const float inv = powf(10000.0f, -(float)(2 * (tid & 31)) / 64.0f);
        for (int i = blockIdx.x * (NWAVES * 64) + tid; i < TOK * 32; i += G * NWAVES * 64) { const int t = i >> 5;
            const float ang = (float)A.positions[t] * inv; float sn, cn; sincosf(ang, &sn, &cn);
            *(pg8::f32x2*)(cs + (size_t)i * 2) = (pg8::f32x2){cn, sn}; }
        float* bs = (float*)(ws + WS_BIAS);
        for (int i = blockIdx.x * (NWAVES * 64) + tid; i < 8192 + 64; i += G * NWAVES * 64) bs[i] = i < 8192 ? A.b_in[i < 4096 ? i : i + 64] : A.b_in[4096 + ((i - 8192) >> 1) + 32 * ((i - 8192) & 1)];
    }
}

__device__ __forceinline__ unsigned pk4_fp8(float a, float b, float c, float d) { int w = __builtin_amdgcn_cvt_pk_fp8_f32(a, b, 0, false); w = __builtin_amdgcn_cvt_pk_fp8_f32(c, d, w, true); return (unsigned)w; }
__device__ __forceinline__ void p1_w8(const unsigned char* srcb, unsigned char* dstb, int n8, float wq, int lane, int gw, int NGW) {
    const v4u* src = (const v4u*)srcb; v2u* dst = (v2u*)dstb;
    for (int i = gw * 64 + lane; i < n8; i += NGW * 64) { const v4u w = src[i]; v2u o;
        o.x = pk4_fp8(bflo(w.x) * wq, bfhi(w.x) * wq, bflo(w.y) * wq, bfhi(w.y) * wq); o.y = pk4_fp8(bflo(w.z) * wq, bfhi(w.z) * wq, bflo(w.w) * wq, bfhi(w.w) * wq); dst[i] = o; }
}
__device__ __forceinline__ void p1_modulate(const Args& A, int lane, int gw, int NGW) {
    const float* mod = (const float*)(A.ws + WS_MOD); unsigned* H8 = (unsigned*)(A.ws + WS_H8); float* hsc = (float*)(A.ws + WS_HSC);
    constexpr int R = 4;
    for (int t0 = gw * R; t0 < TOK; t0 += NGW * R) { const int b = t0 >> 12; const float* sh = mod + (size_t)b * (6 * DM); const float* sc = sh + DM;
        f32x4 hv[R][8];
#pragma unroll
        for (int r = 0; r < R; ++r)
#pragma unroll
            for (int j = 0; j < 8; ++j) hv[r][j] = __builtin_nontemporal_load((const f32x4*)(A.x + (size_t)(t0 + r) * DM + j * 256 + lane * 4));
        float am[R];
#pragma unroll
        for (int r = 0; r < R; ++r) am[r] = 0.f;
#pragma unroll
        for (int j = 0; j < 8; ++j) { const int c = j * 256 + lane * 4; const f32x4 s1 = *(const f32x4*)(sc + c) + 1.0f, s0 = *(const f32x4*)(sh + c);
#pragma unroll
            for (int r = 0; r < R; ++r) { hv[r][j] = hv[r][j] * s1 + s0; am[r] = fmaxf(am[r], fmaxf(fmaxf(fabsf(hv[r][j][0]), fabsf(hv[r][j][1])), fmaxf(fabsf(hv[r][j][2]), fabsf(hv[r][j][3])))); } }
#pragma unroll
        for (int r = 0; r < R; ++r) {
            am[r] = wave_max(am[r]);
            const float q = am[r] > 0.f ? 440.0f / am[r] : 1.0f;
            if (lane == 0) hsc[t0 + r] = am[r] > 0.f ? am[r] * (1.0f / 440.0f) : 1.0f;
#pragma unroll
            for (int j = 0; j < 8; ++j) { const int c = j * 256 + lane * 4; H8[((size_t)(t0 + r) * DM + c) >> 2] = pk4_fp8(hv[r][j][0] * q, hv[r][j][1] * q, hv[r][j][2] * q, hv[r][j][3] * q); } } }
    { const unsigned* wm = (const unsigned*)(A.ws + WS_CTL) + CW_WMAX;
      p1_w8(A.ws + WS_WIN, A.ws + WS_W8, 8192 * 2048 / 8, 440.0f / __uint_as_float(wm[0]), lane, gw, NGW);
      p1_w8(A.ws + WS_WKR, A.ws + WS_WKR8, 256 * 2048 / 8, 440.0f / __uint_as_float(wm[0]), lane, gw, NGW);
      p1_w8(A.ws + WS_WPA, A.ws + WS_WPA8, 2048 * 1024 / 8, 440.0f / __uint_as_float(wm[1]), lane, gw, NGW);
      p1_w8(A.ws + WS_WPB, A.ws + WS_WPB8, 2048 * 1024 / 8, 440.0f / __uint_as_float(wm[2]), lane, gw, NGW);
      p1_w8(A.ws + WS_WO, A.ws + WS_WO8, 2048 * 2048 / 8, 440.0f / __uint_as_float(wm[3]), lane, gw, NGW);
      p1_w8(A.ws + WS_WUQ, A.ws + WS_WUQ8, 1536 * 512 / 8, 440.0f / __uint_as_float(wm[4]), lane, gw, NGW);
      p1_w8(A.ws + WS_WUKV, A.ws + WS_WUKV8, 2048 * 512 / 8, 440.0f / __uint_as_float(wm[5]), lane, gw, NGW); }
}
__device__ __forceinline__ void p7_ln1(const Args& A, int lane, int gw, int NGW) {
    const float* mod = (const float*)(A.ws + WS_MOD); bf16* H = (bf16*)(A.ws + WS_H); float* st = (float*)(A.ws + WS_LN1);
    constexpr int R = 4;
    for (int t0 = gw * R; t0 < TOK; t0 += NGW * R) { const int b = t0 >> 12; const float* sh = mod + ((size_t)b * 6 + 3) * DM; const float* sc = sh + DM;
        f32x4 v[R][8];
#pragma unroll
        for (int r = 0; r < R; ++r)
#pragma unroll
            for (int j = 0; j < 4; ++j) { const v4u w = *(const v4u*)((const bf16*)(A.ws + WS_U1B) + (size_t)(t0 + r) * DM + j * 512 + lane * 8);
                v[r][2 * j] = (f32x4){bflo(w.x), bfhi(w.x), bflo(w.y), bfhi(w.y)}; v[r][2 * j + 1] = (f32x4){bflo(w.z), bfhi(w.z), bflo(w.w), bfhi(w.w)}; }
        float rstd[R], am[R];
#pragma unroll
        for (int r = 0; r < R; ++r) am[r] = 0.f;
#pragma unroll
        for (int r = 0; r < R; ++r) { float s = 0.f;
#pragma unroll
            for (int j = 0; j < 8; ++j) s += (v[r][j][0] + v[r][j][1]) + (v[r][j][2] + v[r][j][3]);
            const float mean = wave_sum(s) * (1.0f / DM); float q = 0.f;
#pragma unroll
            for (int j = 0; j < 8; ++j) { v[r][j] = v[r][j] - mean; q += (v[r][j][0] * v[r][j][0] + v[r][j][1] * v[r][j][1]) + (v[r][j][2] * v[r][j][2] + v[r][j][3] * v[r][j][3]); }
            rstd[r] = 1.0f / sqrtf(wave_sum(q) * (1.0f / DM) + LN_EPS);
            if (lane == 0) { st[(size_t)(t0 + r) * 2] = mean; st[(size_t)(t0 + r) * 2 + 1] = rstd[r]; } }
#pragma unroll
        for (int j = 0; j < 4; ++j) { const int c = j * 512 + lane * 8;
            const f32x4 g0 = *(const f32x4*)(A.ln1_g + c), g1 = *(const f32x4*)(A.ln1_g + c + 4), bb0 = *(const f32x4*)(A.ln1_b + c), bb1 = *(const f32x4*)(A.ln1_b + c + 4);
            const f32x4 s10 = *(const f32x4*)(sc + c), s11 = *(const f32x4*)(sc + c + 4), s00 = *(const f32x4*)(sh + c), s01 = *(const f32x4*)(sh + c + 4);
#pragma unroll
            for (int r = 0; r < R; ++r) { const f32x4 h0 = (v[r][2 * j] * rstd[r] * g0 + bb0) * (s10 + 1.0f) + s00, h1 = (v[r][2 * j + 1] * rstd[r] * g1 + bb1) * (s11 + 1.0f) + s01;
                *(v4u*)(H + (size_t)(t0 + r) * DM + c) = (v4u){pk2(h0[0], h0[1]), pk2(h0[2], h0[3]), pk2(h1[0], h1[1]), pk2(h1[2], h1[3])};
                v[r][2 * j] = h0; v[r][2 * j + 1] = h1;
                am[r] = fmaxf(am[r], fmaxf(fmaxf(fmaxf(fabsf(h0[0]), fabsf(h0[1])), fmaxf(fabsf(h0[2]), fabsf(h0[3]))), fmaxf(fmaxf(fabsf(h1[0]), fabsf(h1[1])), fmaxf(fabsf(h1[2]), fabsf(h1[3]))))); } }
#pragma unroll
        for (int r = 0; r < R; ++r) {
            am[r] = wave_max(am[r]);
            const float inv = am[r] > 0.f ? 119.0f / am[r] : 0.f; int ssum = 0;
#pragma unroll
            for (int j = 0; j < 4; ++j) { unsigned hh = 0u, ll = 0u;
#pragma unroll
                for (int m = 0; m < 8; ++m) { const int x8 = (int)rintf(v[r][2 * j + (m >> 2)][m & 3] * inv); const int lo = ((x8 + 8) & 15) - 8, hi = (x8 - lo) >> 4; ssum += x8; hh |= ((unsigned)hi & 15u) << (4 * m); ll |= ((unsigned)lo & 15u) << (4 * m); }
                *(unsigned*)(A.ws + WS_XH + (size_t)(t0 + r) * 1024 + j * 256 + lane * 4) = hh;
                *(unsigned*)(A.ws + WS_XL + (size_t)(t0 + r) * 1024 + j * 256 + lane * 4) = ll; }
            ssum = wave_sum_int(ssum);
            if (lane == 0) { ((float*)(A.ws + WS_SX))[t0 + r] = am[r] * (1.0f / 119.0f); ((int*)(A.ws + WS_S8))[t0 + r] = ssum; } } }
}


__device__ __forceinline__ float max2f(float a, float b) { float r; asm("v_max_f32_e32 %0, %1, %2" : "=v"(r) : "v"(a), "v"(b)); return r; }
__device__ __forceinline__ float min2f(float a, float b) { float r; asm("v_min_f32_e32 %0, %1, %2" : "=v"(r) : "v"(a), "v"(b)); return r; }
#define INS16(L, x) do { _Pragma("unroll") for (int k_ = 0; k_ < 16; ++k_) { const float h_ = max2f(L[k_], x); x = min2f(L[k_], x); L[k_] = h_; } } while (0)
#define CE_DESC(a, b) do { const float h_ = max2f(a, b), l_ = min2f(a, b); a = h_; b = l_; } while (0)
__device__ __forceinline__ void sort16_desc(float (&a)[16]) {
#pragma unroll
    for (int k = 2; k <= 16; k <<= 1)
#pragma unroll
        for (int j = k >> 1; j > 0; j >>= 1)
#pragma unroll
            for (int i = 0; i < 16; ++i) { const int l = i ^ j; if (l > i) { if ((i & k) == 0) CE_DESC(a[i], a[l]); else CE_DESC(a[l], a[i]); } }
}
__device__ __forceinline__ void merge16_desc(float (&L)[16], const float (&G)[16]) {
#pragma unroll
    for (int i = 0; i < 16; ++i) L[i] = max2f(L[i], G[15 - i]);
#pragma unroll
    for (int j = 8; j > 0; j >>= 1)
#pragma unroll
        for (int i = 0; i < 16; ++i) { const int l = i ^ j; if (l > i) CE_DESC(L[i], L[l]); }
}
__device__ __forceinline__ void topk16_128(const bf16* __restrict__ src, float (&L)[16]) {
#pragma unroll 1
    for (int c = 0; c < 8; ++c) { float G[16];
#pragma unroll
        for (int i = 0; i < 2; ++i) { const v4u v = *(const v4u*)(src + 16 * c + 8 * i);
#pragma unroll
            for (int e = 0; e < 4; ++e) { G[8 * i + 2 * e] = __uint_as_float((v[e] << 16) | (unsigned)(16 * c + 8 * i + 2 * e)); G[8 * i + 2 * e + 1] = __uint_as_float((v[e] & 0xffff0000u) | (unsigned)(16 * c + 8 * i + 2 * e + 1)); } }
        sort16_desc(G);
        if (c == 0) {
#pragma unroll
            for (int i = 0; i < 16; ++i) L[i] = G[i]; }
        else merge16_desc(L, G); }
}
__device__ __forceinline__ float dot2bf(unsigned a, unsigned b, float acc) { return __builtin_amdgcn_fdot2_f32_bf16(__builtin_bit_cast(bf16x2_t, a), __builtin_bit_cast(bf16x2_t, b), acc, false); }
__device__ __forceinline__ float dot8(const v4u a, const v4u b, float acc) {
    const unsigned a0 = a[0], a1 = a[1], a2 = a[2], a3 = a[3], b0 = b[0], b1 = b[1], b2 = b[2], b3 = b[3];
    acc = dot2bf(a0, b0, acc); acc = dot2bf(a1, b1, acc); acc = dot2bf(a2, b2, acc); acc = dot2bf(a3, b3, acc);
    return acc;
}

constexpr int RB = 8;
typedef float f32x2g __attribute__((ext_vector_type(2)));
#define P9_LOAD(BUF, TAB, EV, L0) do { _Pragma("unroll") for (int i_ = 0; i_ < RB; ++i_) { const int id_ = __builtin_amdgcn_readlane((EV), (L0) + i_); \
        BUF[i_] = ((const v4u*)((TAB) + (size_t)id_ * 1024))[lane]; } } while (0)
__device__ __forceinline__ float gelu_as(float v) {
    const float av = fabsf(v), t = __builtin_amdgcn_rcpf(av * 0.2316418882f + 1.0f);
    float q = t * 0.5307027145f + (-0.7265760135f); q = q * t + 0.7107068705f; q = q * t + (-0.142248368f); q = q * t + 0.127414796f; q = q * t;
    const float e = __builtin_amdgcn_exp2f((v * v) * (-0.72134752044f)); const float m = v * (q * e);
    return v < 0.f ? m : v - m;
}
typedef __bf16 bf16x2p __attribute__((ext_vector_type(2)));
__device__ __forceinline__ float p9_dot(const v4u d, const v2u (&xq)[8]) {
    float s0 = 0.f, s1 = 0.f;
#pragma unroll
    for (int k = 0; k < 4; ++k) { const unsigned w = d[k]; const unsigned x0 = xq[2 * k][0], x1 = xq[2 * k][1], x2 = xq[2 * k + 1][0], x3 = xq[2 * k + 1][1];
        s0 = __builtin_amdgcn_fdot2_f32_bf16(__builtin_amdgcn_cvt_scalef32_pk_bf16_fp4(w, 1.0f, 0), __builtin_bit_cast(bf16x2p, x0), s0, false);
        s1 = __builtin_amdgcn_fdot2_f32_bf16(__builtin_amdgcn_cvt_scalef32_pk_bf16_fp4(w, 1.0f, 1), __builtin_bit_cast(bf16x2p, x1), s1, false);
        s0 = __builtin_amdgcn_fdot2_f32_bf16(__builtin_amdgcn_cvt_scalef32_pk_bf16_fp4(w, 1.0f, 2), __builtin_bit_cast(bf16x2p, x2), s0, false);
        s1 = __builtin_amdgcn_fdot2_f32_bf16(__builtin_amdgcn_cvt_scalef32_pk_bf16_fp4(w, 1.0f, 3), __builtin_bit_cast(bf16x2p, x3), s1, false); }
    return s0 + s1;
}
__device__ __forceinline__ void p9_axpy(const v4u d, float wgt, f32x2g (&acc)[16]) {
    const f32x2g w2 = {wgt, wgt};
#pragma unroll
    for (int k = 0; k < 4; ++k) { const unsigned w = d[k];
        acc[4 * k]     = __builtin_elementwise_fma(__builtin_amdgcn_cvt_scalef32_pk_f32_fp4(w, 1.0f, 0), w2, acc[4 * k]);
        acc[4 * k + 1] = __builtin_elementwise_fma(__builtin_amdgcn_cvt_scalef32_pk_f32_fp4(w, 1.0f, 1), w2, acc[4 * k + 1]);
        acc[4 * k + 2] = __builtin_elementwise_fma(__builtin_amdgcn_cvt_scalef32_pk_f32_fp4(w, 1.0f, 2), w2, acc[4 * k + 2]);
        acc[4 * k + 3] = __builtin_elementwise_fma(__builtin_amdgcn_cvt_scalef32_pk_f32_fp4(w, 1.0f, 3), w2, acc[4 * k + 3]); }
}
__device__ __forceinline__ float p9_reduce8(const float (&p)[8], int lane) {
    const bool b5 = (lane & 32) != 0, b4 = (lane & 16) != 0, b3 = (lane & 8) != 0; float r[4], s[2];
#pragma unroll
    for (int k = 0; k < 4; ++k) { const float keep = b5 ? p[k + 4] : p[k], send = b5 ? p[k] : p[k + 4]; r[k] = keep + __shfl_xor(send, 32); }
#pragma unroll
    for (int k = 0; k < 2; ++k) { const float keep = b4 ? r[k + 2] : r[k], send = b4 ? r[k] : r[k + 2]; s[k] = keep + __shfl_xor(send, 16); }
    float t; { const float keep = b3 ? s[1] : s[0], send = b3 ? s[0] : s[1]; t = keep + __shfl_xor(send, 8); }
    t += __shfl_xor(t, 4); t += __shfl_xor(t, 2); t += __shfl_xor(t, 1);
    return t;
}
__device__ __forceinline__ void p9a_topk(const Args& A, int lane_in, int gw, int NGW) {
    unsigned char* ws = A.ws; const bf16* SC = (const bf16*)(ws + WS_SCORE);
    for (int task = gw; task < TOK / 8; task += NGW) {
        int lane = lane_in; asm volatile("" : "+v"(lane));
        const int tl = lane >> 3, hd = lane & 7; const bf16* srow = SC + (size_t)(task * 8 + tl) * 2048 + hd * 256;
        float L0[16], L1[16], R[16];
        topk16_128(srow, L0); topk16_128(srow + 128, L1);
#define P9_CAND(I, J) __uint_as_float((__float_as_uint(L0[I] + L1[J]) & ~255u) | (unsigned)((I) * 16 + (J)))
        { float C[16];
#pragma unroll
          for (int j = 0; j < 16; ++j) R[j] = P9_CAND(0, j);
          sort16_desc(R);
          { int n = 0;
#pragma unroll
            for (int j = 0; j < 8; ++j) C[n++] = P9_CAND(1, j);
#pragma unroll
            for (int j = 0; j < 5; ++j) C[n++] = P9_CAND(2, j);
            C[13] = -INFINITY; C[14] = -INFINITY; C[15] = -INFINITY; }
          sort16_desc(C); merge16_desc(R, C);
          { C[0] = P9_CAND(3, 0); C[1] = P9_CAND(3, 1); C[2] = P9_CAND(3, 2); C[3] = P9_CAND(3, 3); C[4] = P9_CAND(4, 0); C[5] = P9_CAND(4, 1); C[6] = P9_CAND(4, 2);
            C[7] = P9_CAND(5, 0); C[8] = P9_CAND(5, 1); C[9] = P9_CAND(6, 0); C[10] = P9_CAND(6, 1); C[11] = P9_CAND(7, 0); C[12] = P9_CAND(7, 1); C[13] = -INFINITY; C[14] = -INFINITY; C[15] = -INFINITY; }
          sort16_desc(C); merge16_desc(R, C);
#pragma unroll
          for (int i = 0; i < 8; ++i) { C[i] = P9_CAND(8 + i, 0); C[8 + i] = -INFINITY; }
          sort16_desc(C); merge16_desc(R, C); }
#undef P9_CAND
        const float mx = __uint_as_float(__float_as_uint(R[0]) & ~255u); float ex[16], es = 0.f;
#pragma unroll
        for (int r = 0; r < 16; ++r) { ex[r] = __expf(__uint_as_float(__float_as_uint(R[r]) & ~255u) - mx); es += ex[r]; }
        const float inv = 1.0f / es;
        unsigned idp[8];
#pragma unroll
        for (int r = 0; r < 16; ++r) { const unsigned code = __float_as_uint(R[r]) & 255u, ci = code >> 4, cj = code & 15u; unsigned e1 = 0u, e2 = 0u;
#pragma unroll
            for (int k = 0; k < 16; ++k) { e1 = (ci == (unsigned)k) ? (__float_as_uint(L0[k]) & 127u) : e1; e2 = (cj == (unsigned)k) ? (__float_as_uint(L1[k]) & 127u) : e2; }
            const unsigned e = e1 * 128u + e2; if (r & 1) idp[r >> 1] |= e << 16; else idp[r >> 1] = e; ex[r] *= inv; __builtin_amdgcn_sched_barrier(0); }
        const size_t slot0 = (size_t)(task * 8 + tl) * 128 + hd * 16;
        v4u* ip = (v4u*)(ws + WS_IDS + slot0 * 2); ip[0] = (v4u){idp[0], idp[1], idp[2], idp[3]}; ip[1] = (v4u){idp[4], idp[5], idp[6], idp[7]};
        { unsigned* tp = (unsigned*)(ws + WS_IDT + (size_t)(task * 8 + tl) * 256 + hd * 4);
#pragma unroll
          for (int g = 0; g < 8; ++g) { const unsigned lo = (idp[g >> 1] >> (16 * (g & 1))) & 0xffffu, hi = (idp[4 + (g >> 1)] >> (16 * (g & 1))) & 0xffffu; tp[g * 8] = lo | (hi << 16); } }
        f32x4* gp = (f32x4*)(ws + WS_GATES + slot0 * 4);
#pragma unroll
        for (int k = 0; k < 4; ++k) gp[k] = (f32x4){ex[4 * k], ex[4 * k + 1], ex[4 * k + 2], ex[4 * k + 3]};
    }
}

typedef int v2i __attribute__((ext_vector_type(2)));
__device__ __forceinline__ int dpp_add8(int v) {
    v += __builtin_amdgcn_update_dpp(0, v, 0xB1, 0xF, 0xF, true);
    v += __builtin_amdgcn_update_dpp(0, v, 0x4E, 0xF, 0xF, true);
    v += __builtin_amdgcn_update_dpp(0, v, 0x141, 0xF, 0xF, true);
    return v;
}
#define P10_IDS(IDW, JP) __builtin_amdgcn_ds_swizzle((int)(IDW), 0x18 | ((JP) << 5))
#define P10_LOAD1(BUF, IDW, HALF, JP) do { const unsigned pr_ = (unsigned)P10_IDS(IDW, (HALF) * 4 + (JP)); \
        BUF[2 * (JP)] = *(const v4u*)(UTx + ((pr_ & 0xffffu) * 128u + s16)); BUF[2 * (JP) + 1] = *(const v4u*)(UTx + ((pr_ >> 16) * 128u + s16)); } while (0)
#define P10_LOAD(BUF, IDW, HALF) do { P10_LOAD1(BUF, IDW, HALF, 0); P10_LOAD1(BUF, IDW, HALF, 1); P10_LOAD1(BUF, IDW, HALF, 2); P10_LOAD1(BUF, IDW, HALF, 3); } while (0)
#define P10_DOTS(BUF, HALF, XH_, XL_) do { _Pragma("unroll") for (int i_ = 0; i_ < 8; ++i_) { int d1_ = 0, d2_ = 0; \
        _Pragma("unroll") for (int k_ = 0; k_ < 4; ++k_) { d1_ = __builtin_amdgcn_sdot8((int)BUF[i_][k_], (int)XH_[k_], d1_, false); d2_ = __builtin_amdgcn_sdot8((int)BUF[i_][k_], (int)XL_[k_], d2_, false); } \
        res[(HALF) * 8 + i_] = dpp_add8(d1_ * 16 + d2_); } } while (0)
#define P10_STORE(T_) do { int r0 = res[0], r1 = res[1]; \
        _Pragma("unroll") for (int k = 1; k < 8; ++k) { const bool m = (lane & 7) == k; r0 = m ? res[2 * k] : r0; r1 = m ? res[2 * k + 1] : r1; } \
        *(v2i*)(PA + (size_t)(T_) * 128 + 2 * lane) = (v2i){r0, r1}; } while (0)
#define P10_SB __builtin_amdgcn_sched_barrier(0)
__device__ __forceinline__ void p10_udot(const Args& A, int lane_in, int wave, int bx, int G) {
    unsigned char* ws = A.ws;
    const int x = bx & 7, nblk = (G - x + 7) >> 3, stride = nblk * NWAVES;
    const unsigned char* UTx = ws + WS_UT + (size_t)x * UT_SLICE;
    int lane = lane_in; asm volatile("" : "+v"(lane));
    const unsigned s16 = (unsigned)(lane & 7) * 16u;
    const unsigned* IDS32 = (const unsigned*)(ws + WS_IDS);
    int* PA = (int*)(ws + WS_PA) + (size_t)x * TOK * 128;
    int t = (bx >> 3) * NWAVES + wave; if (t >= TOK) return;
    v4u bufA[8], bufB[8], bufC[8], bufD[8];
#define P10_CL(T_) (((T_) < TOK) ? (T_) : t)
#define P10_XH(T_) (*(const v4u*)(ws + WS_XH + (size_t)(T_) * 1024 + x * 128 + s16))
#define P10_XL(T_) (*(const v4u*)(ws + WS_XL + (size_t)(T_) * 1024 + x * 128 + s16))
    const unsigned idw0 = IDS32[(size_t)t * 64 + lane], idw1 = IDS32[(size_t)P10_CL(t + stride) * 64 + lane];
    unsigned idw2 = IDS32[(size_t)P10_CL(t + 2 * stride) * 64 + lane], idw3 = IDS32[(size_t)P10_CL(t + 3 * stride) * 64 + lane];
    v4u xh0 = P10_XH(t), xl0 = P10_XL(t), xh1 = P10_XH(P10_CL(t + stride)), xl1 = P10_XL(P10_CL(t + stride));
    asm volatile("s_waitcnt vmcnt(0)" : "+v"(xh0), "+v"(xl0), "+v"(xh1), "+v"(xl1), "+v"(idw2), "+v"(idw3) :: "memory");
    P10_SB;
    P10_LOAD(bufA, idw0, 0); P10_LOAD(bufB, idw0, 1); P10_LOAD(bufC, idw1, 0); P10_LOAD(bufD, idw1, 1);
    P10_SB;
#pragma unroll 1
    for (;;) {
        const int ta = P10_CL(t + 2 * stride), tb = P10_CL(t + 3 * stride), tc = P10_CL(t + 4 * stride), td = P10_CL(t + 5 * stride);
        const unsigned idw4 = IDS32[(size_t)tc * 64 + lane], idw5 = IDS32[(size_t)td * 64 + lane];
        const v4u xh2 = P10_XH(ta), xl2 = P10_XL(ta), xh3 = P10_XH(tb), xl3 = P10_XL(tb);
        int res[16];
        P10_SB; P10_DOTS(bufA, 0, xh0, xl0); P10_SB; P10_LOAD(bufA, idw2, 0); P10_SB; P10_DOTS(bufB, 1, xh0, xl0); P10_SB; P10_LOAD(bufB, idw2, 1); P10_SB;
        P10_STORE(t);
        if (t + stride >= TOK) break;
        P10_SB; P10_DOTS(bufC, 0, xh1, xl1); P10_SB; P10_LOAD(bufC, idw3, 0); P10_SB; P10_DOTS(bufD, 1, xh1, xl1); P10_SB; P10_LOAD(bufD, idw3, 1); P10_SB;
        P10_STORE(t + stride);
        if (t + 2 * stride >= TOK) break;
        t += 2 * stride; idw2 = idw4; idw3 = idw5; xh0 = xh2; xl0 = xl2; xh1 = xh3; xl1 = xl3;
    }
#undef P10_CL
#undef P10_XH
#undef P10_XL
}
#undef P10_STORE
#undef P10_SB
#undef P10_IDS
#undef P10_LOAD
#undef P10_LOAD1
#undef P10_DOTS

__device__ __forceinline__ void p11_w(const Args& A, int lane, int gw, int NGW) {
    unsigned char* ws = A.ws; const unsigned* IDS32 = (const unsigned*)(ws + WS_IDS); const int* PA = (const int*)(ws + WS_PA);
    const float* SU = (const float*)(ws + WS_TSCALE); const float* SV = SU + 16384; const float* SX = (const float*)(ws + WS_SX); const int* S8 = (const int*)(ws + WS_S8);
    for (int t = gw; t < TOK; t += NGW) {
        const unsigned idw = IDS32[(size_t)t * 64 + lane]; const int id0 = (int)(idw & 0xffffu), id1 = (int)(idw >> 16);
        int s0 = 0, s1 = 0;
#pragma unroll
        for (int x = 0; x < 8; ++x) { const v2i p = *(const v2i*)(PA + ((size_t)x * TOK + t) * 128 + 2 * lane); s0 += p.x; s1 += p.y; }
        const float sxt = SX[t], half = 0.5f * (float)S8[t];
        const float a0 = SU[id0] * sxt * ((float)s0 + half), a1 = SU[id1] * sxt * ((float)s1 + half);
        const f32x2g gt = *(const f32x2g*)(ws + WS_GATES + ((size_t)t * 128 + 2 * lane) * 4);
        f32x2g w; w.x = gt.x * SV[id0] * gelu_as(a0); w.y = gt.y * SV[id1] * gelu_as(a1);
        float am = fmaxf(fabsf(w.x), fabsf(w.y));
        am = wave_max(am);
        const float sc = am > 0.f ? 224.0f / am : 0.f;
        const int ph = __builtin_amdgcn_cvt_pk_fp8_f32(w.x * sc, w.y * sc, 0, false); const f32x2g bk = __builtin_amdgcn_cvt_pk_f32_fp8(ph, false);
        const int pl = __builtin_amdgcn_cvt_pk_fp8_f32(w.x * sc - bk.x, w.y * sc - bk.y, 0, false);
        *(unsigned short*)(ws + WS_W + (size_t)t * 256 + 2 * lane) = (unsigned short)(ph & 0xffff); *(unsigned short*)(ws + WS_W + (size_t)t * 256 + 128 + 2 * lane) = (unsigned short)(pl & 0xffff);
        if (lane == 0) ((float*)(ws + WS_WSC))[t] = am > 0.f ? am * (1.0f / 224.0f) : 0.f;
    }
}

typedef int i32x8v __attribute__((ext_vector_type(8)));
#define P12_TRRD(dst, ad, off) asm volatile("ds_read_b64_tr_b4 %0, %1 offset:%2" : "=&v"(dst) : "v"(ad), "i"(off) : "memory")
#define P12_DMA(IA, IB) do { _Pragma("unroll") for (int q_ = 0; q_ < 16; ++q_) { const unsigned wd_ = (q_ < 8) ? IA[(q_ & 7) >> 1] : IB[(q_ & 7) >> 1]; const unsigned id_ = (q_ & 1) ? (wd_ >> 16) : (wd_ & 0xffffu); \
        __builtin_amdgcn_global_load_lds((const unsigned*)(VTx + (id_ * 128u + ((q_ & 1) ? cs_odd : cs_even))), (LAS unsigned*)(ldsp + q_ * 1024), 16, 0, 0); } } while (0)
#define P12_RD(J, R) do { \
        P12_TRRD(R[0], tra[(J) >> 1], 8 * ((J) & 1)); P12_TRRD(R[1], tra[(J) >> 1], 2048 + 8 * ((J) & 1)); \
        P12_TRRD(R[2], tra[2 + ((J) >> 1)], 8 * ((J) & 1)); P12_TRRD(R[3], tra[2 + ((J) >> 1)], 2048 + 8 * ((J) & 1)); \
        P12_TRRD(R[4], tra[4 + ((J) >> 1)], 8 * ((J) & 1)); P12_TRRD(R[5], tra[4 + ((J) >> 1)], 2048 + 8 * ((J) & 1)); \
        P12_TRRD(R[6], tra[6 + ((J) >> 1)], 8 * ((J) & 1)); P12_TRRD(R[7], tra[6 + ((J) >> 1)], 2048 + 8 * ((J) & 1)); } while (0)
#define P12_MF1(I, R, W) do { asm volatile("s_waitcnt lgkmcnt(" #W ")" : "+v"(R[2 * (I)]), "+v"(R[2 * (I) + 1])); \
        acc[I] = __builtin_amdgcn_mfma_scale_f32_16x16x128_f8f6f4(aj_, (i32x8v){(int)R[2 * (I)][0], (int)R[2 * (I)][1], (int)R[2 * (I) + 1][0], (int)R[2 * (I) + 1][1], 0, 0, 0, 0}, acc[I], 0, 4, 0, 0x7f7f7f7f, 0, 0x7f7f7f7f); } while (0)
#define P12_AJ(J) do { const bool on_ = avalid && (jl == (J)); aj_[0] = on_ ? (int)a0[0] : 0; aj_[1] = on_ ? (int)a0[1] : 0; aj_[2] = on_ ? (int)a0[2] : 0; aj_[3] = on_ ? (int)a0[3] : 0; \
        aj_[4] = on_ ? (int)a1[0] : 0; aj_[5] = on_ ? (int)a1[1] : 0; aj_[6] = on_ ? (int)a1[2] : 0; aj_[7] = on_ ? (int)a1[3] : 0; } while (0)
#define P12_MMA() do { v2u ra_[8], rb_[8], rc_[8]; i32x8v aj_; \
        P12_RD(0, ra_); P12_RD(1, rb_); \
        P12_AJ(0); P12_MF1(0, ra_, 14); P12_MF1(1, ra_, 12); P12_MF1(2, ra_, 10); P12_MF1(3, ra_, 8); \
        P12_RD(2, rc_); \
        P12_AJ(1); P12_MF1(0, rb_, 14); P12_MF1(1, rb_, 12); P12_MF1(2, rb_, 10); P12_MF1(3, rb_, 8); \
        P12_RD(3, ra_); \
        P12_AJ(2); P12_MF1(0, rc_, 14); P12_MF1(1, rc_, 12); P12_MF1(2, rc_, 10); P12_MF1(3, rc_, 8); \
        P12_AJ(3); P12_MF1(0, ra_, 6); P12_MF1(1, ra_, 4); P12_MF1(2, ra_, 2); P12_MF1(3, ra_, 0); } while (0)
__device__ __forceinline__ float wave_sum_dpp(float v) {
    v += __int_as_float(__builtin_amdgcn_update_dpp(0, __float_as_int(v), 0xB1, 0xF, 0xF, true));
    v += __int_as_float(__builtin_amdgcn_update_dpp(0, __float_as_int(v), 0x4E, 0xF, 0xF, true));
    v += __int_as_float(__builtin_amdgcn_update_dpp(0, __float_as_int(v), 0x141, 0xF, 0xF, true));
    v += __int_as_float(__builtin_amdgcn_update_dpp(0, __float_as_int(v), 0x140, 0xF, 0xF, true));
    { const auto r = __builtin_amdgcn_permlane16_swap(__float_as_uint(v), __float_as_uint(v), false, false); v = __uint_as_float(r[0]) + __uint_as_float(r[1]); }
    { const auto r = __builtin_amdgcn_permlane32_swap(__float_as_uint(v), __float_as_uint(v), false, false); v = __uint_as_float(r[0]) + __uint_as_float(r[1]); }
    return v;
}
__device__ __forceinline__ void p12_vslice(const Args& A, LAS unsigned char* lds, int lane_in, int wave, int bx, int G) {
    unsigned char* ws = A.ws;
    const int x = bx & 7, nblk = (G - x + 7) >> 3, stride = nblk * NWAVES;
    const unsigned char* VTx = ws + WS_VT + (size_t)x * UT_SLICE;
    int lane = lane_in; asm volatile("" : "+v"(lane));
    LAS unsigned char* ldsp = lds + wave * 16384;
    const int gq = lane >> 3, sq = lane & 7;
    const unsigned cs_even = 16u * (unsigned)(sq ^ (gq >> 1)), cs_odd = 16u * (unsigned)(sq ^ (4 + (gq >> 1)));
    const unsigned idoff = (unsigned)gq * 32u;
    const int i16 = lane & 15, kq = lane >> 4;
    unsigned tra[8];
    { const unsigned rowb = (unsigned)(uintptr_t)ldsp + (unsigned)(32 * kq + i16) * 128u, sw = (unsigned)(i16 >> 1) & 7u;
#pragma unroll
      for (int c = 0; c < 8; ++c) tra[c] = rowb + (((unsigned)c ^ sw) << 4); }
    const bool avalid = (i16 & 3) < 2; const int jl = i16 >> 2;
    const unsigned aoff = (unsigned)(i16 & 1) * 128u + (unsigned)kq * 16u;
    const unsigned char* IDT = ws + WS_IDT; const unsigned char* WQ8 = ws + WS_W; const float* WSC = (const float*)(ws + WS_WSC);
    const float* st1 = (const float*)(ws + WS_LN1); const float* mod = (const float*)(ws + WS_MOD); const bf16* U1B = (const bf16*)(ws + WS_U1B); bf16* U2 = (bf16*)(ws + WS_H);
    f32x2g* ST2 = (f32x2g*)(ws + WS_ST2) + (size_t)x * TOK;
    const int c0 = x * 256 + lane;
    float g1[4], b1[4];
#pragma unroll
    for (int i = 0; i < 4; ++i) { g1[i] = A.ln1_g[c0 + 64 * i]; b1[i] = A.ln1_b[c0 + 64 * i]; }
    int t = (bx >> 3) * NWAVES + wave; if (t >= TOK) return;
    v4u ia = *(const v4u*)(IDT + (size_t)t * 256 + idoff), ib = *(const v4u*)(IDT + (size_t)t * 256 + idoff + 16);
    const int t1_ = (t + stride < TOK) ? t + stride : t;
    v4u ia1 = *(const v4u*)(IDT + (size_t)t1_ * 256 + idoff), ib1 = *(const v4u*)(IDT + (size_t)t1_ * 256 + idoff + 16);
    v4u a0 = *(const v4u*)(WQ8 + (size_t)t * 256 + aoff), a1 = *(const v4u*)(WQ8 + (size_t)t * 256 + aoff + 64);
    unsigned uh[4]; float gg[4];
#pragma unroll
    for (int i = 0; i < 4; ++i) { uh[i] = (unsigned)U1B[(size_t)t * DM + c0 + 64 * i]; gg[i] = mod[((size_t)(t >> 12) * 6 + 5) * DM + c0 + 64 * i]; }
    float mean1 = st1[(size_t)t * 2], rstd1 = st1[(size_t)t * 2 + 1], wsc = WSC[t];
    P12_DMA(ia, ib);
#pragma unroll 1
    for (;;) {
        const int tn = t + stride; const bool more = tn < TOK;
        asm volatile("s_waitcnt vmcnt(0)" ::: "memory"); __builtin_amdgcn_sched_barrier(0);
        v4u ia2 = ia1, ib2 = ib1, n0 = a0, n1 = a1; unsigned uhn[4]; float ggn[4], mean1n = mean1, rstd1n = rstd1, wscn = wsc;
        if (tn + stride < TOK) { ia2 = *(const v4u*)(IDT + (size_t)(tn + stride) * 256 + idoff); ib2 = *(const v4u*)(IDT + (size_t)(tn + stride) * 256 + idoff + 16); }
#pragma unroll
        for (int i = 0; i < 4; ++i) { uhn[i] = uh[i]; ggn[i] = gg[i]; }
        if (more) { n0 = *(const v4u*)(WQ8 + (size_t)tn * 256 + aoff); n1 = *(const v4u*)(WQ8 + (size_t)tn * 256 + aoff + 64);
#pragma unroll
                    for (int i = 0; i < 4; ++i) { uhn[i] = (unsigned)U1B[(size_t)tn * DM + c0 + 64 * i]; ggn[i] = mod[((size_t)(tn >> 12) * 6 + 5) * DM + c0 + 64 * i]; }
                    mean1n = st1[(size_t)tn * 2]; rstd1n = st1[(size_t)tn * 2 + 1]; wscn = WSC[tn]; }
        f32x4 acc[4];
#pragma unroll
        for (int i = 0; i < 4; ++i) acc[i] = (f32x4){0.f, 0.f, 0.f, 0.f};
        __builtin_amdgcn_sched_barrier(0);
        P12_MMA();
        __builtin_amdgcn_sched_barrier(0);
        if (more) P12_DMA(ia1, ib1);
        __builtin_amdgcn_sched_barrier(0);
        float s1 = 0.f, s2 = 0.f;
#pragma unroll
        for (int i = 0; i < 4; ++i) { const float p = (acc[i][0] + acc[i][1]) * wsc; const float u = __uint_as_float(uh[i] << 16);
            const float x1 = (u - mean1) * rstd1 * g1[i] + b1[i]; const float u2 = DN_ALPHA * x1 + gg[i] * p; s1 += u2; s2 += u2 * u2;
            U2[(size_t)t * DM + c0 + 64 * i] = (bf16)f2bf(u2); }
        s1 = wave_sum_dpp(s1); s2 = wave_sum_dpp(s2);
        if (lane == 0) ST2[t] = (f32x2g){s1, s2};
        if (!more) break;
        t = tn; ia1 = ia2; ib1 = ib2; a0 = n0; a1 = n1; mean1 = mean1n; rstd1 = rstd1n; wsc = wscn;
#pragma unroll
        for (int i = 0; i < 4; ++i) { uh[i] = uhn[i]; gg[i] = ggn[i]; }
    }
}
#undef P12_TRRD
#undef P12_DMA
#undef P12_MMA
#undef P12_RD
#undef P12_MF1
#undef P12_AJ

__device__ __forceinline__ void p13_ln2(const Args& A, int lane, int gw, int NGW) {
    unsigned char* ws = A.ws; const bf16* U2 = (const bf16*)(ws + WS_H); const f32x2g* ST2 = (const f32x2g*)(ws + WS_ST2);
    constexpr int R = 4;
    for (int t0 = gw * R; t0 < TOK; t0 += NGW * R) {
        v2u u[R][8]; float mean[R], rstd[R];
#pragma unroll
        for (int r = 0; r < R; ++r)
#pragma unroll
            for (int q = 0; q < 8; ++q) u[r][q] = *(const v2u*)(U2 + (size_t)(t0 + r) * DM + q * 256 + lane * 4);
#pragma unroll
        for (int r = 0; r < R; ++r) { float s1 = 0.f, s2 = 0.f;
#pragma unroll
            for (int x = 0; x < 8; ++x) { const f32x2g pp = ST2[(size_t)x * TOK + t0 + r]; s1 += pp.x; s2 += pp.y; }
            mean[r] = s1 * (1.0f / DM); const float var = fmaxf(s2 * (1.0f / DM) - mean[r] * mean[r], 0.f); rstd[r] = 1.0f / sqrtf(var + LN_EPS); }
#pragma unroll
        for (int q = 0; q < 8; ++q) { const int c = q * 256 + lane * 4; const f32x4 g = *(const f32x4*)(A.ln2_g + c), bb = *(const f32x4*)(A.ln2_b + c);
#pragma unroll
            for (int r = 0; r < R; ++r) { const f32x4 v = (f32x4){bflo(u[r][q].x), bfhi(u[r][q].x), bflo(u[r][q].y), bfhi(u[r][q].y)};
                __builtin_nontemporal_store((v - mean[r]) * rstd[r] * g + bb, (f32x4*)(A.out + (size_t)(t0 + r) * DM + c)); } }
    }
}


struct ArgsG {
    const GAS float *x, *c; const GAS int* positions;
    const GAS float *w_ada, *b_ada, *w_in, *b_in, *rel_bias, *q_norm_g, *kv_norm_g, *w_uq, *w_ukv, *w_pa, *w_pb, *w_o, *ln1_g, *ln1_b, *peer_wq, *peer_keys, *peer_u, *peer_v, *ln2_g, *ln2_b;
    GAS float* out; GAS unsigned char* ws; int ph_lo, ph_hi;
};
static_assert(sizeof(ArgsG) == sizeof(Args), "ArgsG mirrors Args");
#define CAS __attribute__((address_space(4)))
__device__ __forceinline__ Args load_args(const CAS ArgsG* p) {
    Args a;
    a.x = (const float*)p->x; a.c = (const float*)p->c; a.positions = (const int*)p->positions; a.w_ada = (const float*)p->w_ada; a.b_ada = (const float*)p->b_ada; a.w_in = (const float*)p->w_in; a.b_in = (const float*)p->b_in;
    a.rel_bias = (const float*)p->rel_bias; a.q_norm_g = (const float*)p->q_norm_g; a.kv_norm_g = (const float*)p->kv_norm_g; a.w_uq = (const float*)p->w_uq; a.w_ukv = (const float*)p->w_ukv; a.w_pa = (const float*)p->w_pa;
    a.w_pb = (const float*)p->w_pb; a.w_o = (const float*)p->w_o; a.ln1_g = (const float*)p->ln1_g; a.ln1_b = (const float*)p->ln1_b; a.peer_wq = (const float*)p->peer_wq; a.peer_keys = (const float*)p->peer_keys;
    a.peer_u = (const float*)p->peer_u; a.peer_v = (const float*)p->peer_v; a.ln2_g = (const float*)p->ln2_g; a.ln2_b = (const float*)p->ln2_b; a.out = (float*)p->out; a.ws = (unsigned char*)p->ws;
    a.ph_lo = p->ph_lo; a.ph_hi = p->ph_hi; return a;
}
__global__ void __launch_bounds__(NWAVES * 64, 2) fwd(Args A_) {
    extern __shared__ __attribute__((aligned(16))) unsigned char lds_raw[];
    LAS unsigned char* lds = (LAS unsigned char*)lds_raw;
    const CAS Args* Ap0 = (const CAS Args*)__builtin_amdgcn_kernarg_segment_ptr();
#define PHASE_ENV() const CAS Args* Ap = Ap0; asm volatile("" : "+s"(Ap)); const Args A = load_args((const CAS ArgsG*)Ap); \
    int wave = wave_s; asm volatile("" : "+s"(wave)); int lane; asm volatile("v_mbcnt_lo_u32_b32 %0, -1, 0\n\tv_mbcnt_hi_u32_b32 %0, -1, %0" : "=v"(lane)); const int tid = wave * 64 + lane; \
    const int G = gridDim.x, bx = blockIdx.x, vcu = (G % 8 == 0) ? (bx % 8) * (G / 8) + bx / 8 : bx, gw = vcu * NWAVES + wave, NGW = G * NWAVES; \
    unsigned char* const ws = A.ws; bf16* const H = (bf16*)(ws + WS_H); (void)lane; (void)gw; (void)NGW; (void)H; (void)vcu
    const int wave_s = __builtin_amdgcn_readfirstlane(threadIdx.x >> 6);
    for (int u = threadIdx.x; u < (LDS_BYTES - RING_BYTES) / 4; u += NWAVES * 64) ((LAS unsigned*)(lds + RING_BYTES))[u] = 0u;
    __syncthreads();
    const int lo = A_.ph_lo, hi = A_.ph_hi; const bool multi = (hi - lo) > 1;
    volatile LAS unsigned* MISC = (volatile LAS unsigned*)(lds + MISC_OFF);
    XcdBarrier bar; bar.bar = (unsigned*)(A_.ws + WS_CTL) + CW_BAR; bar.x = 0; bar.st = MISC + 8; bar.w0 = (wave_s == 0);
    if (multi) bar = xcd_barrier_post((unsigned*)(A_.ws + WS_CTL) + CW_BAR, MISC + 8, wave_s == 0);
#ifdef DBG_PHASE
#define IN(k) ((k) == DBG_PHASE)
#else
#define IN(k) (lo <= (k) && (k) < hi)
#endif
#define GRID_BAR(k) do { if (IN(k) && IN((k) + 1)) xcd_barrier(bar); } while (0)
    if (IN(0)) { { PHASE_ENV(); p0_prologue(A, lds, tid, lane, wave, vcu, G); } GRID_BAR(0); }
    if (IN(1)) { { PHASE_ENV(); p1_modulate(A, lane, gw, NGW); } GRID_BAR(1); }
    if (IN(2)) {
        { PHASE_ENV();
        pg8::Gemm g{(const bf16*)(ws + WS_H8), (const bf16*)(ws + WS_W8), TOK, 8192, 1024}; pg8::StaticOrder S; S.init(TOK, 8192, G, bx);
        pg8::EpiInProj E{(bf16*)(ws + WS_QKVA), (bf16*)(ws + WS_CQ), (bf16*)(ws + WS_CKV), (bf16*)A.out, (float*)(ws + WS_SSQ), (const float*)(ws + WS_BIAS), QSCALE_A, (const float*)(ws + WS_HSC), (const unsigned*)(ws + WS_CTL) + CW_WMAX};
        pg8::gemm_phase<pg8::EpiInProj, pg8::StaticOrder, true, true, true>(lds, g, S, E, tid); }
        GRID_BAR(2);
    }
    if (IN(3)) {
        {
        { PHASE_ENV(); pg8::Gemm g{(const bf16*)(ws + WS_CQ), (const bf16*)(ws + WS_WUQ8), TOK, 1536, 256}; pg8::StaticOrder S; S.init(TOK, 1536, G, bx);
          pg8::EpiQUp E{(bf16*)(ws + WS_QN), (bf16*)(ws + WS_QR), (const float*)(ws + WS_SSQ), (const float*)(ws + WS_CS), QSCALE_B, (const unsigned*)(ws + WS_CTL) + CW_WMAX + 4};
          pg8::gemm_phase<pg8::EpiQUp, pg8::StaticOrder, true, true, true>(lds, g, S, E, tid); }
        { PHASE_ENV(); pg8::Gemm g{(const bf16*)(ws + WS_CKV), (const bf16*)(ws + WS_WUKV8), TOK, 2048, 256}; pg8::StaticOrder S; S.init(TOK, 2048, G, bx);
          pg8::EpiKvUp E{(bf16*)(ws + WS_KN), (bf16*)(ws + WS_VB), (const float*)(ws + WS_SSQ) + (size_t)TOK * 8, (const unsigned*)(ws + WS_CTL) + CW_WMAX + 5};
          pg8::gemm_phase<pg8::EpiKvUp, pg8::StaticOrder, true, true, true>(lds, g, S, E, tid); }
        { PHASE_ENV(); pg8::Gemm g{(const bf16*)(ws + WS_H8), (const bf16*)(ws + WS_WKR8), TOK, 256, 1024}; const int j16 = vcu & 15;
          pg8::PickOrder S; S.init(TOK, 256, G, bx, G == 256 ? ((j16 & 2) == 0 ? (vcu >> 4) * 8 + (j16 >> 2) * 2 + (j16 & 1) : -1) : -2);
          pg8::EpiKr E{(bf16*)(ws + WS_KR), (const float*)(ws + WS_BIAS) + 8192, (const float*)(ws + WS_CS), (const float*)(ws + WS_HSC), (const unsigned*)(ws + WS_CTL) + CW_WMAX};
          pg8::gemm_phase<pg8::EpiKr, pg8::PickOrder, true, true, true>(lds, g, S, E, tid); }
        { PHASE_ENV(); const bf16* Q = (const bf16*)(ws + WS_QKVA); const bf16* K = Q + (size_t)TOK * 1024; const bf16* V = K + (size_t)TOK * 1024;
          if (G == 256) {
              for (int k = 0; k < 4; ++k) { const int bh = (vcu >> 4) + 16 * k, qb = ((vcu & 15) + 4 * k) & 15;
                  att::attn_unit<0>(lds, bh >> 3, bh & 7, qb, Q, nullptr, K, nullptr, V, (bf16*)(ws + WS_YA), A.rel_bias + (bh & 7) * 320, tid); } }
          else for (int u = vcu; u < 1024; u += G) { const int bh = u >> 4, qb = u & 15;
              att::attn_unit<0>(lds, bh >> 3, bh & 7, qb, Q, nullptr, K, nullptr, V, (bf16*)(ws + WS_YA), A.rel_bias + (bh & 7) * 320, tid); } }
        }
        GRID_BAR(3);
    }
    if (IN(4)) {
        {
        { PHASE_ENV();
        for (int s2 = 0; vcu + G * (s2 >> 1) < 512; ++s2) { const int it = vcu + G * (s2 >> 1), bh = it >> 3, x = it & 7, qb = (s2 & 1) ? 15 - x : x;
            att::attn_unit<1>(lds, bh >> 3, bh & 7, qb, (const bf16*)(ws + WS_QN), (const bf16*)(ws + WS_QR), (const bf16*)(ws + WS_KN), (const bf16*)(ws + WS_KR), (const bf16*)(ws + WS_VB), (bf16*)(ws + WS_YB), nullptr, tid); } }
        { PHASE_ENV(); pg8::Gemm g{(const bf16*)(ws + WS_YA), (const bf16*)(ws + WS_WPA8), TOK, 2048, 512}; pg8::StaticOrder S; S.init(TOK, 2048, G, bx);
          pg8::EpiGate<0> E{(unsigned char*)H, (const unsigned char*)A.out, nullptr, (const unsigned*)(ws + WS_CTL) + CW_WMAX + 1, ACT_MIX / ACT_Y};
          pg8::gemm_phase<pg8::EpiGate<0>, pg8::StaticOrder, true, true, true>(lds, g, S, E, tid); }
        }
        GRID_BAR(4);
    }
    if (IN(5)) {
        { PHASE_ENV(); pg8::Gemm g{(const bf16*)(ws + WS_YB), (const bf16*)(ws + WS_WPB8), TOK, 2048, 512}; pg8::StaticOrder S; S.init(TOK, 2048, G, bx);
        pg8::EpiGate<1> E{(unsigned char*)H, (const unsigned char*)A.out, ws + WS_H8, (const unsigned*)(ws + WS_CTL) + CW_WMAX + 2, ACT_MIX / ACT_Y};
        pg8::gemm_phase<pg8::EpiGate<1>, pg8::StaticOrder, true, true, true>(lds, g, S, E, tid); }
        GRID_BAR(5);
    }
    if (IN(6)) {
        { PHASE_ENV(); pg8::Gemm g{(const bf16*)(ws + WS_H8), (const bf16*)(ws + WS_WO8), TOK, 2048, 1024}; pg8::StaticOrder S; S.init(TOK, 2048, G, bx);
        pg8::EpiWo E{A.x, (bf16*)(ws + WS_U1B), (const float*)(ws + WS_MOD), DN_ALPHA, (const unsigned*)(ws + WS_CTL) + CW_WMAX + 3, 1.0f / ACT_MIX};
        pg8::gemm_phase<pg8::EpiWo, pg8::StaticOrder, true, true, true>(lds, g, S, E, tid); }
        GRID_BAR(6);
    }
    if (IN(7)) { { PHASE_ENV(); p7_ln1(A, lane, gw, NGW); } GRID_BAR(7); }
    if (IN(8)) {
        { PHASE_ENV(); pg8::Gemm g{H, (const bf16*)(ws + WS_WSK), TOK, 2048, 2048}; pg8::StaticOrder S; S.init(TOK, 2048, G, bx);
        pg8::EpiBf16 E{(pg8::bf16_t*)(ws + WS_SCORE), 2048};
        pg8::gemm_phase<pg8::EpiBf16, pg8::StaticOrder, true, true>(lds, g, S, E, tid); }
        GRID_BAR(8);
    }
    if (IN(9)) { { PHASE_ENV(); p9a_topk(A, lane, gw, NGW); } GRID_BAR(9); }
    if (IN(10)) { { PHASE_ENV(); p10_udot(A, lane, wave, bx, G); } GRID_BAR(10); }
    if (IN(11)) { { PHASE_ENV(); p11_w(A, lane, gw, NGW); } GRID_BAR(11); }
    if (IN(12)) { { PHASE_ENV(); p12_vslice(A, lds, lane, wave, bx, G); } GRID_BAR(12); }
    if (IN(13)) { PHASE_ENV(); p13_ln2(A, lane, gw, NGW); }
#undef IN
#undef GRID_BAR
#undef PHASE_ENV
}

#ifndef MK_ONE_LAUNCH
#define MK_ONE_LAUNCH 1
#endif
constexpr int N_PHASES = 14;
extern "C" void kernel_launch(void* const* d_in, const int* in_sizes, int n_in, void* d_out, int out_size, void* d_ws, size_t ws_size, hipStream_t stream) {
    static int grid = 0;
    if (grid == 0) {
        if (n_in != 23 || out_size != TOK * DM || ws_size < WS_END) { fprintf(stderr, "kernel_launch: unexpected shapes (n_in %d, out %d, ws %zu); nothing launched\n", n_in, out_size, ws_size); grid = -1; return; }
        int dev = 0, cus = 0, per_cu = 0;
        if (hipGetDevice(&dev) != hipSuccess || hipDeviceGetAttribute(&cus, hipDeviceAttributeMultiprocessorCount, dev) != hipSuccess) { grid = -1; return; }
        if (hipFuncSetAttribute((const void*)fwd, hipFuncAttributeMaxDynamicSharedMemorySize, LDS_BYTES) != hipSuccess) { fprintf(stderr, "kernel_launch: hipFuncSetAttribute failed\n"); grid = -1; return; }
        if (hipOccupancyMaxActiveBlocksPerMultiprocessor(&per_cu, (const void*)fwd, NWAVES * 64, LDS_BYTES) != hipSuccess || per_cu < 1) fprintf(stderr, "kernel_launch: occupancy query reports %d\n", per_cu);
        (void)hipGetLastError();
        grid = cus;
    }
    if (grid < 0) return;
    (void)hipMemsetAsync((char*)d_ws + WS_CTL, 0, CTL_ZERO_BYTES, stream);
    Args a{};
    a.x = (const float*)d_in[0]; a.c = (const float*)d_in[1]; a.positions = (const int*)d_in[2];
    a.w_ada = (const float*)d_in[3]; a.b_ada = (const float*)d_in[4]; a.w_in = (const float*)d_in[5]; a.b_in = (const float*)d_in[6]; a.rel_bias = (const float*)d_in[7];
    a.q_norm_g = (const float*)d_in[8]; a.kv_norm_g = (const float*)d_in[9]; a.w_uq = (const float*)d_in[10]; a.w_ukv = (const float*)d_in[11]; a.w_pa = (const float*)d_in[12];
    a.w_pb = (const float*)d_in[13]; a.w_o = (const float*)d_in[14]; a.ln1_g = (const float*)d_in[15]; a.ln1_b = (const float*)d_in[16]; a.peer_wq = (const float*)d_in[17];
    a.peer_keys = (const float*)d_in[18]; a.peer_u = (const float*)d_in[19]; a.peer_v = (const float*)d_in[20]; a.ln2_g = (const float*)d_in[21]; a.ln2_b = (const float*)d_in[22];
    a.out = (float*)d_out; a.ws = (unsigned char*)d_ws;
#if MK_ONE_LAUNCH
    a.ph_lo = 0; a.ph_hi = N_PHASES;
    hipLaunchKernelGGL(fwd, dim3(grid), dim3(NWAVES * 64), LDS_BYTES, stream, a);
#else
    for (int p = 0; p < N_PHASES; ++p) { a.ph_lo = p; a.ph_hi = p + 1; hipLaunchKernelGGL(fwd, dim3(grid), dim3(NWAVES * 64), LDS_BYTES, stream, a); }
#endif
}
```
